# Optimizing an MI355X kernel written in HIP

```python
import math
import jax
import jax.numpy as jnp
from jax import lax
import numpy as np

D_MODEL = 1024
BATCH = 16
SEQ = 2048
DEPTH = 1

D_MIX = D_MODEL
DA_HEADS = 4
DA_HEAD_DIM = D_MIX // 16
DA_V_DIM = 2 * DA_HEAD_DIM
DA_WIDTH = DA_HEADS * DA_V_DIM
ML_HEADS = 4
ML_WIDTH = D_MIX - DA_WIDTH
ML_HEAD_DIM = ML_WIDTH // ML_HEADS
ML_CHUNK = 128
CONV_K = 4
ROPE_THETA = 10000.0
Q_BLOCK = 128
RMS_EPS = 1e-6
N_GROUPS = 4
EXPERTS_PER_GROUP = 8
N_EXPERTS = N_GROUPS * EXPERTS_PER_GROUP
TOP_K = 2
D_EXPERT = D_MODEL // 2
MOE_BLOCK = 128
COL_WIDTHS = (DA_HEADS * 2 * DA_HEAD_DIM, DA_HEADS * 2 * DA_HEAD_DIM, DA_WIDTH,
              ML_WIDTH, ML_WIDTH, ML_WIDTH, ML_WIDTH, ML_HEADS, ML_HEADS)
D_IN = sum(COL_WIDTHS)

kernel_name = 'hybrid_diffattn_mlstm_hmoe_layer'


def rmsnorm(x, g):
    xf = x.astype(jnp.float32)
    y = xf * lax.rsqrt(jnp.mean(xf * xf, axis=-1, keepdims=True) + RMS_EPS)
    return (y * g.astype(jnp.float32)).astype(x.dtype)


def split_cols(t):
    out, off = [], 0
    for w in COL_WIDTHS:
        out.append(t[..., off:off + w])
        off += w
    return out


def rope_tables(seq, dim):
    inv = 1.0 / (ROPE_THETA ** (jnp.arange(0, dim, 2, dtype=jnp.float32) / dim))
    ang = jnp.arange(seq, dtype=jnp.float32)[:, None] * inv[None, :]
    return jnp.cos(ang), jnp.sin(ang)


def apply_rope(x, cos, sin):
    x1, x2 = jnp.split(x, 2, axis=-1)
    c = cos.astype(x.dtype)
    s = sin.astype(x.dtype)
    return jnp.concatenate([x1 * c - x2 * s, x1 * s + x2 * c], axis=-1)


def diff_attention(q, k, v, lam):
    B, H, _, S, dh = q.shape
    nb = S // Q_BLOCK
    scale = dh ** -0.5
    qb = q.reshape(B, H, 2, nb, Q_BLOCK, dh).transpose(3, 0, 1, 2, 4, 5)
    key_pos = jnp.arange(S)

    def block(args):
        qi, bi = args
        s = jnp.einsum('bhcqd,bhckd->bhcqk', qi, k).astype(jnp.float32) * scale
        q_pos = bi * Q_BLOCK + jnp.arange(Q_BLOCK)
        mask = key_pos[None, :] <= q_pos[:, None]
        p = jax.nn.softmax(jnp.where(mask, s, -jnp.inf), axis=-1)
        a = p[:, :, 0] - lam * p[:, :, 1]
        return jnp.einsum('bhqk,bhkd->bhqd', a.astype(v.dtype), v)

    o = lax.map(block, (qb, jnp.arange(nb)))
    return o.transpose(1, 2, 0, 3, 4).reshape(B, H, S, v.shape[-1])


def causal_conv(x, w, b):
    S = x.shape[1]
    xp = jnp.pad(x, ((0, 0), (CONV_K - 1, 0), (0, 0)))
    y = b
    for j in range(CONV_K):
        y = y + xp[:, j:j + S] * w[j]
    return y


def mlstm_chunkwise(q, k, v, i_pre, f_pre):
    dtype = q.dtype
    f32 = jnp.float32
    B, H, S, d = q.shape
    L = ML_CHUNK
    nc = S // L
    q = q.astype(f32)
    k = k.astype(f32) * (d ** -0.5)
    v = v.astype(f32)
    log_f = jax.nn.log_sigmoid(f_pre.astype(f32))
    log_i = i_pre.astype(f32)

    def to_chunks(t):
        return jnp.moveaxis(t.reshape(B, H, nc, L, *t.shape[3:]), 2, 0)

    xs = (to_chunks(q), to_chunks(k), to_chunks(v), to_chunks(log_f), to_chunks(log_i))
    causal = jnp.tril(jnp.ones((L, L), dtype=bool))

    def step(carry, inp):
        C, n, m = carry
        qj, kj, vj, lf, li = inp
        b = jnp.cumsum(lf, axis=-1)
        Dm = jnp.where(causal, b[..., :, None] - b[..., None, :] + li[..., None, :], -jnp.inf)
        inter = b + m[..., None]
        m_row = jnp.maximum(inter, jnp.max(Dm, axis=-1))
        Sm = jnp.exp(Dm - m_row[..., None]) * jnp.einsum('bhld,bhsd->bhls', qj, kj)
        sc_in = jnp.exp(inter - m_row)
        num = jnp.einsum('bhls,bhsd->bhld', Sm, vj) + sc_in[..., None] * jnp.einsum('bhvk,bhlk->bhlv', C, qj)
        den = jnp.sum(Sm, axis=-1) + sc_in * jnp.einsum('bhk,bhlk->bhl', n, qj)
        h = num / jnp.maximum(jnp.abs(den), jnp.exp(-m_row))[..., None]
        bL = b[..., -1]
        dec = bL[..., None] - b + li
        m_new = jnp.maximum(bL + m, jnp.max(dec, axis=-1))
        ws = jnp.exp(dec - m_new[..., None])
        sc = jnp.exp(bL + m - m_new)
        C_new = sc[..., None, None] * C + jnp.einsum('bhs,bhsv,bhsk->bhvk', ws, vj, kj)
        n_new = sc[..., None] * n + jnp.einsum('bhs,bhsk->bhk', ws, kj)
        return (C_new, n_new, m_new), h

    init = (jnp.zeros((B, H, d, d), f32), jnp.zeros((B, H, d), f32), jnp.zeros((B, H), f32))
    _, h = lax.scan(step, init, xs)
    return jnp.moveaxis(h, 0, 2).reshape(B, H, S, d).astype(dtype)


def hier_moe(x, w_grp, b_grp, w_erouter, b_erouter, w1, w3, w2):
    T, D = x.shape
    g_logits = (x @ w_grp).astype(jnp.float32) + b_grp
    g_prob = jax.nn.softmax(g_logits, axis=-1)
    g_sel = jnp.argmax(g_logits, axis=-1).astype(jnp.int32)
    g_w = jnp.take_along_axis(g_prob, g_sel[:, None], axis=-1)[:, 0]
    e_all = jnp.einsum('td,gde->tge', x, w_erouter).astype(jnp.float32) + b_erouter
    e_logits = jnp.take_along_axis(e_all, g_sel[:, None, None], axis=1)[:, 0]
    top_v, top_i = lax.top_k(e_logits, TOP_K)
    e_w = jax.nn.softmax(top_v, axis=-1) * g_w[:, None]
    e_id = g_sel[:, None] * EXPERTS_PER_GROUP + top_i.astype(jnp.int32)

    A = T * TOP_K
    flat_e = e_id.reshape(A)
    flat_tok = jnp.repeat(jnp.arange(T, dtype=jnp.int32), TOP_K)
    flat_w = e_w.reshape(A)
    order = jnp.argsort(flat_e)
    se, stok, sw = flat_e[order], flat_tok[order], flat_w[order]
    counts = jnp.bincount(flat_e, length=N_EXPERTS).astype(jnp.int32)
    starts = jnp.cumsum(counts) - counts
    pcounts = (counts + MOE_BLOCK - 1) // MOE_BLOCK * MOE_BLOCK
    pend = jnp.cumsum(pcounts)
    pstart = pend - pcounts
    dest = pstart[se] + (jnp.arange(A, dtype=jnp.int32) - starts[se])
    P = A + N_EXPERTS * MOE_BLOCK
    nb = P // MOE_BLOCK
    tok_buf = jnp.zeros((P,), jnp.int32).at[dest].set(stok)
    w_buf = jnp.zeros((P,), x.dtype).at[dest].set(sw.astype(x.dtype))
    blk_e = jnp.minimum(jnp.searchsorted(pend, jnp.arange(nb, dtype=jnp.int32) * MOE_BLOCK, side='right'),
                        N_EXPERTS - 1)
    xb = x[tok_buf].reshape(nb, MOE_BLOCK, D)

    def expert_block(args):
        xi, e = args
        hdn = jax.nn.silu(xi @ w1[e]) * (xi @ w3[e])
        return hdn @ w2[e]

    yb = lax.map(expert_block, (xb, blk_e)).reshape(P, D)
    return jnp.zeros_like(x).at[tok_buf].add(yb * w_buf[:, None])


def setup_inputs(seed: int = 0) -> dict:
    key = jax.random.key(seed)
    ks = jax.random.split(key, 24)
    f32 = jnp.float32

    def nrm(k, shape, s):
        return jax.random.normal(k, shape, f32) * s

    x = nrm(ks[0], (BATCH, SEQ, D_MODEL), 1.0)
    w_in = nrm(ks[1], (DEPTH, D_MODEL, D_IN), D_MODEL ** -0.5)
    conv_w = nrm(ks[2], (DEPTH, CONV_K, 2 * ML_WIDTH), CONV_K ** -0.5)
    conv_b = nrm(ks[3], (DEPTH, 2 * ML_WIDTH), 0.01)
    i_b = nrm(ks[4], (DEPTH, 1, ML_HEADS), 0.1)
    f_b = 3.0 + 3.0 * jax.random.uniform(ks[5], (DEPTH, 1, ML_HEADS), f32)
    gate_b = jnp.concatenate([i_b, f_b], axis=1)
    lam_qk = nrm(ks[6], (DEPTH, 4, DA_HEAD_DIM), 0.1)
    subln_g = 1.0 + nrm(ks[7], (DEPTH, DA_V_DIM), 0.02)
    mhnorm_g = 1.0 + nrm(ks[8], (DEPTH, ML_HEADS, ML_HEAD_DIM), 0.02)
    w_out = nrm(ks[9], (DEPTH, D_MIX, D_MODEL), D_MIX ** -0.5)
    g_mix = 1.0 + nrm(ks[10], (DEPTH, D_MODEL), 0.02)
    g_ffn = 1.0 + nrm(ks[11], (DEPTH, D_MODEL), 0.02)
    w_grp = nrm(ks[12], (DEPTH, D_MODEL, N_GROUPS), D_MODEL ** -0.5)
    b_grp = nrm(ks[13], (DEPTH, N_GROUPS), 0.01)
    w_erouter = nrm(ks[14], (DEPTH, N_GROUPS, D_MODEL, EXPERTS_PER_GROUP), D_MODEL ** -0.5)
    b_erouter = nrm(ks[15], (DEPTH, N_GROUPS, EXPERTS_PER_GROUP), 0.01)
    w1 = nrm(ks[16], (DEPTH, N_EXPERTS, D_MODEL, D_EXPERT), D_MODEL ** -0.5)
    w3 = nrm(ks[17], (DEPTH, N_EXPERTS, D_MODEL, D_EXPERT), D_MODEL ** -0.5)
    w2 = nrm(ks[18], (DEPTH, N_EXPERTS, D_EXPERT, D_MODEL), D_EXPERT ** -0.5)
    g_final = 1.0 + nrm(ks[19], (D_MODEL,), 0.02)
    return {'x': x, 'w_in': w_in, 'conv_w': conv_w, 'conv_b': conv_b, 'gate_b': gate_b,
            'lam_qk': lam_qk, 'subln_g': subln_g, 'mhnorm_g': mhnorm_g, 'w_out': w_out,
            'g_mix': g_mix, 'g_ffn': g_ffn, 'w_grp': w_grp, 'b_grp': b_grp,
            'w_erouter': w_erouter, 'b_erouter': b_erouter, 'w1': w1, 'w3': w3, 'w2': w2,
            'g_final': g_final}


def reference(x, w_in, conv_w, conv_b, gate_b, lam_qk, subln_g, mhnorm_g, w_out,
              g_mix, g_ffn, w_grp, b_grp, w_erouter, b_erouter, w1, w3, w2, g_final):
    B, S, D = x.shape
    cos, sin = rope_tables(S, DA_HEAD_DIM)
    for l in range(DEPTH):
        h = rmsnorm(x, g_mix[l])
        proj = h @ w_in[l]
        qa, ka, va, qm, km, vm, om, ig, fg = split_cols(proj)

        lambda_init = 0.8 - 0.6 * math.exp(-0.3 * l)
        lq = lam_qk[l].astype(jnp.float32)
        lam = jnp.exp(jnp.sum(lq[0] * lq[1])) - jnp.exp(jnp.sum(lq[2] * lq[3])) + lambda_init
        qa = apply_rope(qa.reshape(B, S, DA_HEADS, 2, DA_HEAD_DIM).transpose(0, 2, 3, 1, 4), cos, sin)
        ka = apply_rope(ka.reshape(B, S, DA_HEADS, 2, DA_HEAD_DIM).transpose(0, 2, 3, 1, 4), cos, sin)
        va = va.reshape(B, S, DA_HEADS, DA_V_DIM).transpose(0, 2, 1, 3)
        oa = diff_attention(qa, ka, va, lam)
        oa = rmsnorm(oa, subln_g[l]) * (1.0 - lambda_init)
        oa = oa.transpose(0, 2, 1, 3).reshape(B, S, DA_WIDTH)

        qk = jax.nn.silu(causal_conv(jnp.concatenate([qm, km], axis=-1), conv_w[l], conv_b[l]))
        qm, km = qk[..., :ML_WIDTH], qk[..., ML_WIDTH:]

        def heads(t):
            return t.reshape(B, S, ML_HEADS, ML_HEAD_DIM).transpose(0, 2, 1, 3)

        i_pre = (ig + gate_b[l, 0]).transpose(0, 2, 1)
        f_pre = (fg + gate_b[l, 1]).transpose(0, 2, 1)
        hm = mlstm_chunkwise(heads(qm), heads(km), heads(vm), i_pre, f_pre)
        hm = hm.transpose(0, 2, 1, 3) * jax.nn.sigmoid(om.reshape(B, S, ML_HEADS, ML_HEAD_DIM))
        hm = rmsnorm(hm, mhnorm_g[l]).reshape(B, S, ML_WIDTH)

        x = x + jnp.concatenate([oa, hm], axis=-1) @ w_out[l]

        hn = rmsnorm(x, g_ffn[l]).reshape(B * S, D)
        y = hier_moe(hn, w_grp[l], b_grp[l], w_erouter[l], b_erouter[l], w1[l], w3[l], w2[l])
        x = x + y.reshape(B, S, D)
    return rmsnorm(x, g_final)
```

```cpp
#include <hip/hip_runtime.h>
#include <cstdio>
#include <cstdint>

constexpr int BATCH = 16, SEQ = 2048, D = 1024, T = BATCH * SEQ;
constexpr int DIN = 3592, NPROJ = 3584;
constexpr int C_QA = 0, C_KA = 512, C_VA = 1024, C_QM = 1536, C_KM = 2048, C_VM = 2560, C_OM = 3072, C_IG = 3584, C_FG = 3588;
constexpr int NE = 32, EPG = 8, DE = 512;
constexpr float RMS_EPS = 1e-6f;
constexpr float LAMBDA_INIT = 0.2f;
constexpr float C2Q = 0.125f * 1.4426950408889634f;
constexpr int LIST_CAP = T;

constexpr size_t MiB = 1u << 20;
constexpr size_t WS_CTL = 0, CTL_ZERO_BYTES = 1 * MiB;
constexpr size_t WS_ROPE = 1 * MiB;
constexpr size_t WS_TOKW = 2 * MiB;
constexpr size_t WS_RSTD = 2 * MiB + 512 * 1024;
constexpr size_t WS_LIST = 4 * MiB;
constexpr size_t WS_GATES = 8 * MiB;
constexpr size_t WS_WIN = 10 * MiB;
constexpr size_t WS_WOUT = 17 * MiB;
constexpr size_t WS_W13 = 20 * MiB;
constexpr size_t WS_W2 = 84 * MiB;
constexpr size_t WS_PROJ = 116 * MiB;
constexpr size_t WS_MIX = 340 * MiB;
constexpr size_t WS_X1B = 404 * MiB;
constexpr size_t WS_HB = 404 * MiB;
constexpr size_t WS_HD = 116 * MiB;
constexpr size_t WS_Y = 188 * MiB;
constexpr size_t WS_END = 468 * MiB;
constexpr int CW_CNT = 1024;

typedef unsigned short bf16_t;
typedef short bf16x8 __attribute__((ext_vector_type(8)));
typedef float f32x4 __attribute__((ext_vector_type(4)));
typedef unsigned u32x4 __attribute__((ext_vector_type(4)));
typedef unsigned u32x2 __attribute__((ext_vector_type(2)));

__device__ __forceinline__ unsigned f2bf(float f) { unsigned u = __float_as_uint(f); return (u + 0x7fffu + ((u >> 16) & 1u)) >> 16; }
__device__ __forceinline__ unsigned pk2(float lo, float hi) { return f2bf(lo) | (f2bf(hi) << 16); }
__device__ __forceinline__ float bf2f(unsigned b) { return __uint_as_float(b << 16); }
__device__ __forceinline__ float wave_sum(float v) {
#pragma unroll
    for (int o = 1; o < 64; o <<= 1) v += __shfl_xor(v, o);
    return v;
}
__device__ __forceinline__ float sigmoidf_(float x) { return 1.f / (1.f + __expf(-x)); }

struct MapId { __device__ __forceinline__ int operator()(int n) const { return n; } };
struct MapRope {
    __device__ __forceinline__ int operator()(int c) const { if (c >= 1024) return c; const int g = c & ~63, d = c & 63; return g + 8 * ((d & 31) >> 2) + 4 * (d >> 5) + (d & 3); } };
struct MapW1 { __device__ __forceinline__ int operator()(int c) const { return 256 * (c >> 7) + (c & 127); } };
struct MapW3 { __device__ __forceinline__ int operator()(int c) const { return 256 * (c >> 7) + 128 + (c & 127); } };
template <class Map>
__device__ __forceinline__ void transpose_item(const float* W, int ldw, bf16_t* WT, int K, int k0, int n0, const Map& map, const float* kscale, float* scr, int lane) {
#pragma unroll 8
    for (int i = 0; i < 32; ++i) { const int kk = 2 * i + (lane >> 5); scr[kk * 33 + (lane & 31)] = W[(size_t)(k0 + kk) * ldw + n0 + (lane & 31)]; }
    asm volatile("s_waitcnt vmcnt(0) lgkmcnt(0)" ::: "memory");
    const int c = lane & 7;
    float ks[8];
#pragma unroll
    for (int i = 0; i < 8; ++i) ks[i] = kscale ? kscale[k0 + 8 * c + i] : 1.f;
#pragma unroll
    for (int j = 0; j < 4; ++j) { const int n = (lane >> 3) + 8 * j; const float* s = scr + (8 * c) * 33 + n;
        u32x4 o; o.x = pk2(s[0 * 33] * ks[0], s[1 * 33] * ks[1]); o.y = pk2(s[2 * 33] * ks[2], s[3 * 33] * ks[3]); o.z = pk2(s[4 * 33] * ks[4], s[5 * 33] * ks[5]); o.w = pk2(s[6 * 33] * ks[6], s[7 * 33] * ks[7]);
        *(u32x4*)(WT + (size_t)map(n0 + n) * K + k0 + 8 * c) = o; }
    asm volatile("s_waitcnt lgkmcnt(0)" ::: "memory");
}

struct Ptrs {
    const float *x, *w_in, *conv_w, *conv_b, *gate_b, *lam_qk, *subln_g, *mhnorm_g, *w_out, *g_mix, *g_ffn, *w_grp, *b_grp, *w_er, *b_er, *w1, *w3, *w2, *g_final;
    float* out; unsigned char* ws;
};

__global__ void __launch_bounds__(512) k_prologue(Ptrs p) {
    __shared__ float scr_all[8 * 64 * 33];
    __shared__ float gw[1024 * 8];
    const int tid = threadIdx.x, lane = tid & 63, wave = tid >> 6;
    const int gw_id = blockIdx.x * 8 + wave, NGW = gridDim.x * 8;
    float* scr = scr_all + wave * 64 * 33;
    bf16_t* WIN = (bf16_t*)(p.ws + WS_WIN); bf16_t* WOUT = (bf16_t*)(p.ws + WS_WOUT); bf16_t* W13 = (bf16_t*)(p.ws + WS_W13); bf16_t* W2 = (bf16_t*)(p.ws + WS_W2);
    for (int i = tid; i < 1024 * 8; i += 512) gw[i] = p.w_in[(size_t)(i >> 3) * DIN + C_IG + (i & 7)];
    __syncthreads();
    constexpr int I_IN = 16 * 112, I_OUT = 16 * 32, I_13 = 16 * 16 * 32, I_2 = 8 * 32 * 32;
    constexpr int NITEMS = I_IN + I_OUT + 2 * I_13 + I_2;
    for (int it = gw_id; it < NITEMS; it += NGW) {
        int r = it;
        if (r < I_IN) { const int kb = r / 112, nb = r % 112; transpose_item(p.w_in, DIN, WIN, 1024, 64 * kb, 32 * nb, MapRope(), nullptr, scr, lane); continue; } r -= I_IN;
        if (r < I_OUT) { const int kb = r / 32, nb = r % 32; transpose_item(p.w_out, 1024, WOUT, 1024, 64 * kb, 32 * nb, MapId(), nullptr, scr, lane); continue; } r -= I_OUT;
        if (r < I_13) { const int e = r / 256, q = r % 256, kb = q / 16, nb = q % 16; transpose_item(p.w1 + (size_t)e * 1024 * 512, 512, W13 + (size_t)e * 1024 * 1024, 1024, 64 * kb, 32 * nb, MapW1(), p.g_ffn, scr, lane); continue; } r -= I_13;
        if (r < I_13) { const int e = r / 256, q = r % 256, kb = q / 16, nb = q % 16; transpose_item(p.w3 + (size_t)e * 1024 * 512, 512, W13 + (size_t)e * 1024 * 1024, 1024, 64 * kb, 32 * nb, MapW3(), p.g_ffn, scr, lane); continue; } r -= I_13;
        { const int e = r / 256, q = r % 256, kb = q / 32, nb = q % 32; transpose_item(p.w2 + (size_t)e * 512 * 1024, 1024, W2 + (size_t)e * 1024 * 512, 512, 64 * kb, 32 * nb, MapId(), nullptr, scr, lane); }
    }
    { float* cs = (float*)(p.ws + WS_ROPE); float* sn = cs + 2048 * 32;
      for (int i = blockIdx.x * 512 + tid; i < 2048 * 32; i += gridDim.x * 512) { const int pos = i >> 5, j = i & 31;
          const float inv = 1.0f / exp2f((float)(2 * j) * (1.f / 64.f) * 13.287712379549449f);
          const float ang = (float)pos * inv; const double rev = (double)ang * 0.15915494309189535; const float fr = (float)(rev - rint(rev));
          cs[i] = __builtin_amdgcn_cosf(fr); sn[i] = __builtin_amdgcn_sinf(fr); } }
    bf16_t* HB = (bf16_t*)(p.ws + WS_HB); float* GATES = (float*)(p.ws + WS_GATES);
    for (int m = gw_id; m < T; m += NGW) {
        const f32x4* xr = (const f32x4*)(p.x + (size_t)m * D) + lane; const f32x4* gr = (const f32x4*)p.g_mix + lane;
        f32x4 v[4]; float s = 0.f;
#pragma unroll
        for (int j = 0; j < 4; ++j) { v[j] = xr[64 * j]; s += (v[j].x * v[j].x + v[j].y * v[j].y) + (v[j].z * v[j].z + v[j].w * v[j].w); }
        const float rstd = 1.f / sqrtf(wave_sum(s) * (1.f / D) + RMS_EPS);
        float ga[8];
#pragma unroll
        for (int e = 0; e < 8; ++e) ga[e] = 0.f;
        unsigned long long* o8 = (unsigned long long*)(HB + (size_t)m * D) + lane;
#pragma unroll
        for (int j = 0; j < 4; ++j) { const f32x4 g = gr[64 * j]; f32x4 h = v[j] * rstd * g;
            o8[64 * j] = (unsigned long long)pk2(h.x, h.y) | ((unsigned long long)pk2(h.z, h.w) << 32);
            const int k0 = 256 * j + 4 * lane;
#pragma unroll
            for (int q = 0; q < 4; ++q) { const float hv = h[q]; const float* w = gw + (k0 + q) * 8;
#pragma unroll
                for (int e = 0; e < 8; ++e) ga[e] += hv * w[e]; } }
#pragma unroll
        for (int e = 0; e < 8; ++e) ga[e] = wave_sum(ga[e]);
        if (lane < 8) { float gv = 0.f;
#pragma unroll
            for (int e = 0; e < 8; ++e) gv = (lane == e) ? ga[e] : gv;
            gv += p.gate_b[lane];
            if (lane >= 4) gv = fminf(gv, 0.f) - log1pf(__expf(-fabsf(gv)));
            GATES[(size_t)m * 8 + lane] = gv; }
    }
}

template <class P> __global__ void __launch_bounds__(256) k_simple_gemm(P p) {
    const int wave = threadIdx.x >> 6, lane = threadIdx.x & 63, r16 = lane & 15, kg = lane >> 4;
    const int rowtile = blockIdx.y * 4 + wave, strip = blockIdx.x;
    if (!p.valid(rowtile)) return;
    const bf16_t* arow = p.arow(rowtile, r16);
    const bf16_t* brow[4];
#pragma unroll
    for (int t = 0; t < 4; ++t) brow[t] = p.brow(rowtile, strip, t, r16);
    f32x4 acc[4];
#pragma unroll
    for (int t = 0; t < 4; ++t) acc[t] = (f32x4){0.f, 0.f, 0.f, 0.f};
    for (int k0 = 0; k0 < P::K; k0 += 32) {
        const bf16x8 a = *(const bf16x8*)(arow + k0 + 8 * kg);
#pragma unroll
        for (int t = 0; t < 4; ++t) { const bf16x8 b = *(const bf16x8*)(brow[t] + k0 + 8 * kg); acc[t] = __builtin_amdgcn_mfma_f32_16x16x32_bf16(a, b, acc[t], 0, 0, 0); }
    }
    p.epi(rowtile, strip, r16, kg, acc);
}

struct PG1 {
    static constexpr int K = 1024;
    const bf16_t* A; const bf16_t* Bt; bf16_t* O; const float* cs; const float* sn;
    __device__ bool valid(int) const { return true; }
    __device__ const bf16_t* arow(int rt, int r) const { return A + (size_t)(rt * 16 + r) * K; }
    __device__ const bf16_t* brow(int, int s, int t, int r) const { const int c = 64 * s + 16 * t + r; return Bt + (size_t)MapRope()(c) * K; }
    __device__ void epi(int rt, int s, int r16, int kg, const f32x4 (&acc)[4]) const {
#pragma unroll
        for (int reg = 0; reg < 4; ++reg) { const int row = rt * 16 + 4 * kg + reg; bf16_t* o = O + (size_t)row * NPROJ + 64 * s;
            if (s < 16) { const int pos = row & (SEQ - 1); const float sc = (s < 8) ? C2Q : 1.f;
#pragma unroll
                for (int t = 0; t < 2; ++t) { const int i = 16 * t + r16; const float c = cs[pos * 32 + i], sv = sn[pos * 32 + i]; const float x1 = acc[t][reg], x2 = acc[t + 2][reg];
                    o[i] = (bf16_t)f2bf((x1 * c - x2 * sv) * sc); o[i + 32] = (bf16_t)f2bf((x1 * sv + x2 * c) * sc); } }
            else {
#pragma unroll
                for (int t = 0; t < 4; ++t) o[16 * t + r16] = (bf16_t)f2bf(acc[t][reg]); } }
    }
};
struct PGOut {
    static constexpr int K = 1024;
    const bf16_t* A; const bf16_t* Bt; const float* x; float* X1; bf16_t* X1B;
    __device__ bool valid(int) const { return true; }
    __device__ const bf16_t* arow(int rt, int r) const { return A + (size_t)(rt * 16 + r) * K; }
    __device__ const bf16_t* brow(int, int s, int t, int r) const { return Bt + (size_t)(64 * s + 16 * t + r) * K; }
    __device__ void epi(int rt, int s, int r16, int kg, const f32x4 (&acc)[4]) const {
#pragma unroll
        for (int reg = 0; reg < 4; ++reg) { const size_t row = rt * 16 + 4 * kg + reg;
#pragma unroll
            for (int t = 0; t < 4; ++t) { const size_t o = row * D + 64 * s + 16 * t + r16; const float v = x[o] + acc[t][reg]; X1[o] = v; X1B[o] = (bf16_t)f2bf(v); } }
    }
};
struct MoeRows {
    const unsigned* ctl; const int* list;
    __device__ int cnt(int e) const { return (int)ctl[CW_CNT + 64 * e]; }
    __device__ int pstart(int e) const { int s = 0; for (int j = 0; j < e; ++j) s += (cnt(j) + 255) & ~255; return s; }
};
struct PGUp {
    static constexpr int K = 1024;
    MoeRows R; const bf16_t* X1B; const bf16_t* W13; const float* rstd; bf16_t* HD;
    __device__ bool valid(int rt) const { const int e = rt >> 11, lt = rt & 2047; return lt * 16 < R.cnt(e); }
    __device__ int tok(int e, int s) const { return (s < R.cnt(e)) ? (R.list[(size_t)e * LIST_CAP + s] >> 1) : 0; }
    __device__ const bf16_t* arow(int rt, int r) const { const int e = rt >> 11, lt = rt & 2047; return X1B + (size_t)tok(e, lt * 16 + r) * K; }
    __device__ const bf16_t* brow(int rt, int s, int t, int r) const { const int e = rt >> 11, c = 32 * s + 16 * (t & 1) + r; const int wrow = (t < 2) ? MapW1()(c) : MapW3()(c); return W13 + ((size_t)e * 1024 + wrow) * K; }
    __device__ void epi(int rt, int s, int r16, int kg, const f32x4 (&acc)[4]) const {
        const int e = rt >> 11, lt = rt & 2047, ps = R.pstart(e), n = R.cnt(e);
#pragma unroll
        for (int reg = 0; reg < 4; ++reg) { const int sl = lt * 16 + 4 * kg + reg; if (sl >= n) continue; const float rs = rstd[tok(e, sl)];
#pragma unroll
            for (int t = 0; t < 2; ++t) { const float a = acc[t][reg] * rs, b = acc[t + 2][reg] * rs; HD[(size_t)(ps + sl) * DE + 32 * s + 16 * t + r16] = (bf16_t)f2bf(a * sigmoidf_(a) * b); } }
    }
};
struct PGDown {
    static constexpr int K = 512;
    MoeRows R; const bf16_t* HD; const bf16_t* W2; const float* tokw; bf16_t* Y; int ps_[1];
    __device__ bool valid(int rt) const { const int e = rt >> 11, lt = rt & 2047; return lt * 16 < R.cnt(e); }
    __device__ const bf16_t* arow(int rt, int r) const { const int e = rt >> 11, lt = rt & 2047; return HD + (size_t)(R.pstart(e) + lt * 16 + r) * K; }
    __device__ const bf16_t* brow(int rt, int s, int t, int r) const { const int e = rt >> 11; return W2 + ((size_t)e * 1024 + 64 * s + 16 * t + r) * K; }
    __device__ void epi(int rt, int s, int r16, int kg, const f32x4 (&acc)[4]) const {
        const int e = rt >> 11, lt = rt & 2047, n = R.cnt(e);
#pragma unroll
        for (int reg = 0; reg < 4; ++reg) { const int sl = lt * 16 + 4 * kg + reg; if (sl >= n) continue; const int a = R.list[(size_t)e * LIST_CAP + sl]; const float w = tokw[a];
#pragma unroll
            for (int t = 0; t < 4; ++t) Y[(size_t)a * D + 64 * s + 16 * t + r16] = (bf16_t)f2bf(acc[t][reg] * w); }
    }
};

__global__ void __launch_bounds__(256) k_attn_ref(const bf16_t* PROJ, float* OC) {
    const int idx = blockIdx.x * 256 + threadIdx.x; const int q = idx & (SEQ - 1), c = (idx >> 11) & 1, h = (idx >> 12) & 3, b = idx >> 14;
    const int qmax = __builtin_amdgcn_readfirstlane(q | 63);
    const size_t rowb = (size_t)b * SEQ;
    float qv[64];
    { const bf16_t* qp = PROJ + (rowb + q) * NPROJ + C_QA + h * 128 + c * 64;
#pragma unroll
      for (int d = 0; d < 64; ++d) qv[d] = bf2f(qp[d]); }
    float o[128];
#pragma unroll
    for (int d = 0; d < 128; ++d) o[d] = 0.f;
    float m = -INFINITY, l = 0.f;
    for (int j = 0; j <= qmax; ++j) {
        const bf16_t* kp = PROJ + (rowb + j) * NPROJ + C_KA + h * 128 + c * 64; const bf16_t* vp = PROJ + (rowb + j) * NPROJ + C_VA + h * 128;
        float s = 0.f;
#pragma unroll
        for (int d = 0; d < 64; ++d) s += qv[d] * bf2f(kp[d]);
        if (j <= q) { const float mn = fmaxf(m, s), sc = exp2f(m - mn), pr = exp2f(s - mn); l = l * sc + pr; m = mn;
#pragma unroll
            for (int d = 0; d < 128; ++d) o[d] = o[d] * sc + pr * bf2f(vp[d]); }
    }
    const float rl = 1.f / l; float* op = OC + ((size_t)c * T + rowb + q) * 512 + h * 128;
#pragma unroll
    for (int d = 0; d < 128; ++d) op[d] = o[d] * rl;
}
__global__ void __launch_bounds__(256) k_attn_combine(const float* OC, const float* lam_qk, const float* subln_g, bf16_t* MIX) {
    const int lane = threadIdx.x & 63; const int w = blockIdx.x * 4 + (threadIdx.x >> 6); const int row = w >> 2, h = w & 3;
    const float lam = __expf(wave_sum(lam_qk[lane] * lam_qk[64 + lane])) - __expf(wave_sum(lam_qk[128 + lane] * lam_qk[192 + lane])) + LAMBDA_INIT;
    const float* o1 = OC + (size_t)row * 512 + h * 128; const float* o2 = OC + ((size_t)T + row) * 512 + h * 128;
    const float v0 = o1[lane] - lam * o2[lane], v1 = o1[lane + 64] - lam * o2[lane + 64];
    const float rs = 1.f / sqrtf(wave_sum(v0 * v0 + v1 * v1) * (1.f / 128.f) + RMS_EPS) * (1.f - LAMBDA_INIT);
    bf16_t* o = MIX + (size_t)row * D + h * 128;
    o[lane] = (bf16_t)f2bf(v0 * rs * subln_g[lane]); o[lane + 64] = (bf16_t)f2bf(v1 * rs * subln_g[lane + 64]);
}

__global__ void __launch_bounds__(1024) k_mlstm_ref(const bf16_t* PROJ, const float* GATES, const float* conv_w, const float* conv_b, const float* mhnorm_g, bf16_t* MIX) {
    __shared__ float sq[128], sk[128], sv[128], so[128], sh[128];
    const int tid = threadIdx.x, v = tid >> 3, kg = tid & 7; const int b = blockIdx.x >> 2, h = blockIdx.x & 3;
    float C[16], n[16];
#pragma unroll
    for (int i = 0; i < 16; ++i) { C[i] = 0.f; n[i] = 0.f; }
    float m = 0.f;
    for (int t = 0; t < SEQ; ++t) {
        const size_t row = (size_t)b * SEQ + t;
        if (tid < 256) { const int cc = (tid < 128) ? h * 128 + tid : 512 + h * 128 + (tid - 128);
            float y = conv_b[cc];
#pragma unroll
            for (int j = 0; j < 4; ++j) { const int tt = t - 3 + j; if (tt >= 0) y += conv_w[j * 1024 + cc] * bf2f(PROJ[((size_t)b * SEQ + tt) * NPROJ + C_QM + cc]); }
            const float sl = y * sigmoidf_(y);
            if (tid < 128) sq[tid] = sl; else sk[tid - 128] = sl * 0.08838834764831845f; }
        else if (tid < 384) sv[tid - 256] = bf2f(PROJ[row * NPROJ + C_VM + h * 128 + (tid - 256)]);
        else if (tid < 512) so[tid - 384] = bf2f(PROJ[row * NPROJ + C_OM + h * 128 + (tid - 384)]);
        __syncthreads();
        const float li = GATES[row * 8 + h], lf = GATES[row * 8 + 4 + h];
        const float mn = fmaxf(lf + m, li), fd = __expf(lf + m - mn), ii = __expf(li - mn);
        float pn = 0.f, pd = 0.f; const float vv = sv[v] * ii;
#pragma unroll
        for (int i = 0; i < 16; ++i) { const float kk = sk[kg * 16 + i], qq = sq[kg * 16 + i]; C[i] = fd * C[i] + vv * kk; n[i] = fd * n[i] + ii * kk; pn += C[i] * qq; pd += n[i] * qq; }
        pn += __shfl_xor(pn, 1); pn += __shfl_xor(pn, 2); pn += __shfl_xor(pn, 4);
        pd += __shfl_xor(pd, 1); pd += __shfl_xor(pd, 2); pd += __shfl_xor(pd, 4);
        const float hv = pn / fmaxf(fabsf(pd), __expf(-mn));
        if (kg == 0) sh[v] = hv * sigmoidf_(so[v]);
        m = mn;
        __syncthreads();
        if (tid < 128) { float ss = 0.f;
            for (int i = 0; i < 128; ++i) ss += sh[i] * sh[i];
            MIX[row * D + 512 + h * 128 + tid] = (bf16_t)f2bf(sh[tid] * (1.f / sqrtf(ss * (1.f / 128.f) + RMS_EPS)) * mhnorm_g[h * 128 + tid]); }
        __syncthreads();
    }
}

__global__ void __launch_bounds__(256) k_router_ref(Ptrs p) {
    const int lane = threadIdx.x & 63; const int tok = blockIdx.x * 4 + (threadIdx.x >> 6);
    const float* X1 = p.out; unsigned* ctl = (unsigned*)(p.ws + WS_CTL); int* list = (int*)(p.ws + WS_LIST); float* tokw = (float*)(p.ws + WS_TOKW); float* rstd_o = (float*)(p.ws + WS_RSTD);
    float hv[16]; float s = 0.f;
#pragma unroll
    for (int j = 0; j < 4; ++j) { const f32x4 v = ((const f32x4*)(X1 + (size_t)tok * D))[lane + 64 * j]; hv[4 * j] = v.x; hv[4 * j + 1] = v.y; hv[4 * j + 2] = v.z; hv[4 * j + 3] = v.w; s += (v.x * v.x + v.y * v.y) + (v.z * v.z + v.w * v.w); }
    const float rstd = 1.f / sqrtf(wave_sum(s) * (1.f / D) + RMS_EPS);
#pragma unroll
    for (int j = 0; j < 4; ++j)
#pragma unroll
        for (int q = 0; q < 4; ++q) hv[4 * j + q] *= rstd * p.g_ffn[256 * j + 4 * lane + q];
    float gl[4];
#pragma unroll
    for (int g = 0; g < 4; ++g) { float a = 0.f;
#pragma unroll
        for (int j = 0; j < 4; ++j)
#pragma unroll
            for (int q = 0; q < 4; ++q) a += hv[4 * j + q] * p.w_grp[(size_t)(256 * j + 4 * lane + q) * 4 + g];
        gl[g] = wave_sum(a) + p.b_grp[g]; }
    int gs = 0; float gm = gl[0];
#pragma unroll
    for (int g = 1; g < 4; ++g) if (gl[g] > gm) { gm = gl[g]; gs = g; }
    float gsum = 0.f;
#pragma unroll
    for (int g = 0; g < 4; ++g) gsum += __expf(gl[g] - gm);
    const float gwt = 1.f / gsum;
    float el[8];
#pragma unroll
    for (int e = 0; e < 8; ++e) { float a = 0.f;
#pragma unroll
        for (int j = 0; j < 4; ++j)
#pragma unroll
            for (int q = 0; q < 4; ++q) a += hv[4 * j + q] * p.w_er[((size_t)gs * 1024 + 256 * j + 4 * lane + q) * 8 + e];
        el[e] = wave_sum(a) + p.b_er[gs * 8 + e]; }
    int i0 = 0; float v0 = el[0];
#pragma unroll
    for (int e = 1; e < 8; ++e) if (el[e] > v0) { v0 = el[e]; i0 = e; }
    int i1 = -1; float v1 = -INFINITY;
#pragma unroll
    for (int e = 0; e < 8; ++e) if (e != i0 && el[e] > v1) { v1 = el[e]; i1 = e; }
    const float e1 = __expf(v1 - v0), w0 = gwt / (1.f + e1), w1 = gwt * e1 / (1.f + e1);
    if (lane == 0) {
        const int ea = gs * 8 + i0, eb = gs * 8 + i1;
        const unsigned sa = atomicAdd(&ctl[CW_CNT + 64 * ea], 1u); list[(size_t)ea * LIST_CAP + sa] = tok * 2;
        const unsigned sb = atomicAdd(&ctl[CW_CNT + 64 * eb], 1u); list[(size_t)eb * LIST_CAP + sb] = tok * 2 + 1;
        tokw[tok * 2] = w0; tokw[tok * 2 + 1] = w1; rstd_o[tok] = rstd; }
}
__global__ void __launch_bounds__(256) k_final(Ptrs p) {
    const int lane = threadIdx.x & 63; const size_t tok = blockIdx.x * 4 + (threadIdx.x >> 6);
    float* X1 = p.out; const bf16_t* Y = (const bf16_t*)(p.ws + WS_Y);
    f32x4 v[4]; float s = 0.f;
#pragma unroll
    for (int j = 0; j < 4; ++j) { v[j] = ((const f32x4*)(X1 + tok * D))[lane + 64 * j];
        const u32x2 a = ((const u32x2*)(Y + (2 * tok) * D))[lane + 64 * j], b = ((const u32x2*)(Y + (2 * tok + 1) * D))[lane + 64 * j];
        v[j].x += bf2f(a.x & 0xffffu) + bf2f(b.x & 0xffffu); v[j].y += bf2f(a.x >> 16) + bf2f(b.x >> 16); v[j].z += bf2f(a.y & 0xffffu) + bf2f(b.y & 0xffffu); v[j].w += bf2f(a.y >> 16) + bf2f(b.y >> 16);
        s += (v[j].x * v[j].x + v[j].y * v[j].y) + (v[j].z * v[j].z + v[j].w * v[j].w); }
    const float rstd = 1.f / sqrtf(wave_sum(s) * (1.f / D) + RMS_EPS);
#pragma unroll
    for (int j = 0; j < 4; ++j) { const f32x4 g = ((const f32x4*)p.g_final)[lane + 64 * j]; ((f32x4*)(X1 + tok * D))[lane + 64 * j] = v[j] * rstd * g; }
}

extern "C" void kernel_launch(void* const* d_in, const int* in_sizes, int n_in, void* d_out, int out_size, void* d_ws, size_t ws_size, hipStream_t stream) {
    if (n_in != 19 || out_size != T * D || ws_size < WS_END) { fprintf(stderr, "kernel_launch: unexpected shapes (n_in %d out %d ws %zu)\n", n_in, out_size, ws_size); return; }
    Ptrs p{};
    p.x = (const float*)d_in[0]; p.w_in = (const float*)d_in[1]; p.conv_w = (const float*)d_in[2]; p.conv_b = (const float*)d_in[3]; p.gate_b = (const float*)d_in[4];
    p.lam_qk = (const float*)d_in[5]; p.subln_g = (const float*)d_in[6]; p.mhnorm_g = (const float*)d_in[7]; p.w_out = (const float*)d_in[8]; p.g_mix = (const float*)d_in[9];
    p.g_ffn = (const float*)d_in[10]; p.w_grp = (const float*)d_in[11]; p.b_grp = (const float*)d_in[12]; p.w_er = (const float*)d_in[13]; p.b_er = (const float*)d_in[14];
    p.w1 = (const float*)d_in[15]; p.w3 = (const float*)d_in[16]; p.w2 = (const float*)d_in[17]; p.g_final = (const float*)d_in[18];
    p.out = (float*)d_out; p.ws = (unsigned char*)d_ws;
    unsigned char* ws = p.ws;
    hipMemsetAsync(ws + WS_CTL, 0, CTL_ZERO_BYTES, stream);
    k_prologue<<<256, 512, 0, stream>>>(p);
    const float* cs = (const float*)(ws + WS_ROPE);
    { PG1 g{(const bf16_t*)(ws + WS_HB), (const bf16_t*)(ws + WS_WIN), (bf16_t*)(ws + WS_PROJ), cs, cs + 2048 * 32};
      k_simple_gemm<PG1><<<dim3(NPROJ / 64, T / 64), 256, 0, stream>>>(g); }
    k_attn_ref<<<BATCH * 4 * 2 * SEQ / 256, 256, 0, stream>>>((const bf16_t*)(ws + WS_PROJ), (float*)d_out);
    k_attn_combine<<<T * 4 / 4, 256, 0, stream>>>((const float*)d_out, p.lam_qk, p.subln_g, (bf16_t*)(ws + WS_MIX));
    k_mlstm_ref<<<BATCH * 4, 1024, 0, stream>>>((const bf16_t*)(ws + WS_PROJ), (const float*)(ws + WS_GATES), p.conv_w, p.conv_b, p.mhnorm_g, (bf16_t*)(ws + WS_MIX));
    { PGOut g{(const bf16_t*)(ws + WS_MIX), (const bf16_t*)(ws + WS_WOUT), p.x, (float*)d_out, (bf16_t*)(ws + WS_X1B)};
      k_simple_gemm<PGOut><<<dim3(D / 64, T / 64), 256, 0, stream>>>(g); }
    k_router_ref<<<T / 4, 256, 0, stream>>>(p);
    MoeRows R{(const unsigned*)(ws + WS_CTL), (const int*)(ws + WS_LIST)};
    { PGUp g{R, (const bf16_t*)(ws + WS_X1B), (const bf16_t*)(ws + WS_W13), (const float*)(ws + WS_RSTD), (bf16_t*)(ws + WS_HD)};
      k_simple_gemm<PGUp><<<dim3(DE / 32, NE * 2048 / 4), 256, 0, stream>>>(g); }
    { PGDown g{R, (const bf16_t*)(ws + WS_HD), (const bf16_t*)(ws + WS_W2), (const float*)(ws + WS_TOKW), (bf16_t*)(ws + WS_Y), {0}};
      k_simple_gemm<PGDown><<<dim3(D / 64, NE * 2048 / 4), 256, 0, stream>>>(g); }
    k_final<<<T / 4, 256, 0, stream>>>(p);
}
```

```cpp
#include <hip/hip_runtime.h>
#include <cstdio>
#include <cstdint>

constexpr int BATCH = 16, SEQ = 2048, D = 1024, T = BATCH * SEQ;
constexpr int DIN = 3592, NPROJ = 3584;
constexpr int C_QA = 0, C_KA = 512, C_VA = 1024, C_QM = 1536, C_KM = 2048, C_VM = 2560, C_OM = 3072, C_IG = 3584, C_FG = 3588;
constexpr int NE = 32, EPG = 8, DE = 512;
constexpr float RMS_EPS = 1e-6f;
constexpr float LAMBDA_INIT = 0.2f;
constexpr float C2Q = 0.125f * 1.4426950408889634f;
constexpr int LIST_CAP = T;

constexpr size_t MiB = 1u << 20;
constexpr size_t WS_CTL = 0, CTL_ZERO_BYTES = 1 * MiB;
constexpr size_t WS_ROPE = 1 * MiB;
constexpr size_t WS_TOKW = 2 * MiB;
constexpr size_t WS_RSTD = 2 * MiB + 512 * 1024;
constexpr size_t WS_LIST = 4 * MiB;
constexpr size_t WS_GATES = 8 * MiB;
constexpr size_t WS_WIN = 10 * MiB;
constexpr size_t WS_WOUT = 17 * MiB;
constexpr size_t WS_W13 = 20 * MiB;
constexpr size_t WS_W2 = 84 * MiB;
constexpr size_t WS_PROJ = 116 * MiB;
constexpr size_t WS_MIX = 340 * MiB;
constexpr size_t WS_X1B = 404 * MiB;
constexpr size_t WS_HB = 404 * MiB;
constexpr size_t WS_HD = 116 * MiB;
constexpr size_t WS_Y = 188 * MiB;
constexpr size_t WS_END = 468 * MiB;
constexpr int CW_TMO = 0, CW_CODE = 1;
constexpr int CW_CNT = 1024;
constexpr int CW_BAR = 4096;
constexpr int CW_QATT = 8192;

#define LAS __attribute__((address_space(3)))
typedef unsigned short bf16_t;
typedef short bf16x8 __attribute__((ext_vector_type(8)));
typedef float f32x4 __attribute__((ext_vector_type(4)));
typedef unsigned u32x4 __attribute__((ext_vector_type(4)));
typedef unsigned u32x2 __attribute__((ext_vector_type(2)));

__device__ __forceinline__ unsigned f2bf(float f) { unsigned u = __float_as_uint(f); return (u + 0x7fffu + ((u >> 16) & 1u)) >> 16; }
__device__ __forceinline__ unsigned pk2(float lo, float hi) { return f2bf(lo) | (f2bf(hi) << 16); }
__device__ __forceinline__ float bf2f(unsigned b) { return __uint_as_float(b << 16); }
__device__ __forceinline__ float wave_sum(float v) {
#pragma unroll
    for (int o = 1; o < 64; o <<= 1) v += __shfl_xor(v, o);
    return v;
}
__device__ __forceinline__ float sigmoidf_(float x) { return 1.f / (1.f + __expf(-x)); }

struct MapId { __device__ __forceinline__ int operator()(int n) const { return n; } };
struct MapRope {
    __device__ __forceinline__ int operator()(int c) const { if (c >= 1024) return c; const int g = c & ~63, d = c & 63; return g + 8 * ((d & 31) >> 2) + 4 * (d >> 5) + (d & 3); } };
struct MapW1 { __device__ __forceinline__ int operator()(int c) const { return 256 * (c >> 7) + (c & 127); } };
struct MapW3 { __device__ __forceinline__ int operator()(int c) const { return 256 * (c >> 7) + 128 + (c & 127); } };
template <class Map>
__device__ __forceinline__ void transpose_item(const float* W, int ldw, bf16_t* WT, int K, int k0, int n0, const Map& map, const float* kscale, LAS float* scr, int lane) {
#pragma unroll 8
    for (int i = 0; i < 32; ++i) { const int kk = 2 * i + (lane >> 5); scr[kk * 33 + (lane & 31)] = W[(size_t)(k0 + kk) * ldw + n0 + (lane & 31)]; }
    asm volatile("s_waitcnt vmcnt(0) lgkmcnt(0)" ::: "memory");
    const int c = lane & 7;
    float ks[8];
#pragma unroll
    for (int i = 0; i < 8; ++i) ks[i] = kscale ? kscale[k0 + 8 * c + i] : 1.f;
#pragma unroll
    for (int j = 0; j < 4; ++j) { const int n = (lane >> 3) + 8 * j; const LAS float* s = scr + (8 * c) * 33 + n;
        u32x4 o; o.x = pk2(s[0 * 33] * ks[0], s[1 * 33] * ks[1]); o.y = pk2(s[2 * 33] * ks[2], s[3 * 33] * ks[3]); o.z = pk2(s[4 * 33] * ks[4], s[5 * 33] * ks[5]); o.w = pk2(s[6 * 33] * ks[6], s[7 * 33] * ks[7]);
        *(u32x4*)(WT + (size_t)map(n0 + n) * K + k0 + 8 * c) = o; }
    asm volatile("s_waitcnt lgkmcnt(0)" ::: "memory");
}

struct Ptrs {
    const float *x, *w_in, *conv_w, *conv_b, *gate_b, *lam_qk, *subln_g, *mhnorm_g, *w_out, *g_mix, *g_ffn, *w_grp, *b_grp, *w_er, *b_er, *w1, *w3, *w2, *g_final;
    float* out; unsigned char* ws;
};


namespace pg8 {
#define PG8_LAS __attribute__((address_space(3)))
constexpr int BM = 256, BK = 64, HALF = 128, HTB = HALF * BK * 2, STAGE_BYTES = 8 * HTB, NXCD = 8, WGM = 8;
__host__ __device__ __forceinline__ int lds_byte(int r, int c) { const int st = (r >> 4) * 2 + (c >> 5), rr = r & 15, cc = c & 31, ob = rr * 64 + cc * 2; return st * 1024 + (ob ^ (((ob >> 9) & 1) << 5)); }
__host__ __device__ __forceinline__ void stage_rc(int b, int& R, int& C) { const int st = b / 1024, sb = b % 1024, swz = sb ^ (((sb >> 9) & 1) << 5); R = (st >> 1) * 16 + swz / 64; C = (st & 1) * 32 + (swz % 64) / 2; }
__host__ __device__ __forceinline__ int perm32(int rho) { const int n = rho >> 4, i = rho & 15; return 8 * (i >> 2) + 4 * n + (i & 3); }

struct Unit { int pm, pn; const char* a; const char* b; int e, cnt, ps; };

struct StaticOrder {
    int nM, nN, nwg, G, c; const char* A; const char* Bt; size_t tstep;
    __device__ void init(const void* A_, const void* Bt_, int M, int N, int K, int G_, int c_) { A = (const char*)A_; Bt = (const char*)Bt_; nM = M / BM; nN = N / BM; nwg = nM * nN; G = G_; c = c_; tstep = (size_t)BM * K * 2; }
    __device__ bool next(int i, Unit& u) const {
        const long L = (long)i * G + c; if (L >= nwg) return false;
        int wgid = (int)L; { const int q = nwg / NXCD, r = nwg % NXCD, xcd = wgid % NXCD, off = wgid / NXCD; wgid = (xcd < r ? xcd * (q + 1) : r * (q + 1) + (xcd - r) * q) + off; }
        const int nig = WGM * nN, gid = wgid / nig, fm = gid * WGM, gsz = (nM - fm) < WGM ? (nM - fm) : WGM;
        u.pm = fm + ((wgid % nig) % gsz); u.pn = (wgid % nig) / gsz; u.a = A + (size_t)u.pm * tstep; u.b = Bt + (size_t)u.pn * tstep; u.e = 0; u.cnt = 0; u.ps = 0; return true;
    }
    __device__ __forceinline__ unsigned row_off(const Unit&, int) const { return 0u; }
};
struct MoeOrder {
    const PG8_LAS int* tab; int G, vcu; const char* A; const char* Bt; size_t bstep_e, bstep_n, astep; bool gather; const int* list; int K;
    __device__ bool next(int i, Unit& u) const {
        const int L = i * G + vcu; if (L >= tab[32]) return false;
        int e = 0;
#pragma unroll 1
        for (int j = 1; j < 32; ++j) e = (L >= tab[j]) ? j : e;
        const int loc = L - tab[e]; u.e = e; u.pn = loc & 3; u.pm = loc >> 2; u.cnt = tab[128 + e]; u.ps = tab[64 + e];
        u.b = Bt + (size_t)e * bstep_e + (size_t)u.pn * bstep_n;
        u.a = gather ? A : A + (size_t)(u.ps + u.pm * BM) * astep;
        return true;
    }
    __device__ __forceinline__ unsigned row_off(const Unit& u, int r) const {
        const int s = u.pm * BM + r; const int a = (s < u.cnt) ? list[(size_t)u.e * LIST_CAP + s] : 0; return (unsigned)(a >> 1) * (unsigned)(K * 2);
    }
};

__device__ __forceinline__ unsigned cvt_pk_bf16(float lo, float hi) { unsigned r; asm volatile("v_cvt_pk_bf16_f32 %0, %1, %2" : "=v"(r) : "v"(lo), "v"(hi)); return r; }

struct EpiProj {
    static constexpr bool PERM = true;
    bf16_t* O; const float* cs; const float* sn;
    __device__ __forceinline__ void operator()(const f32x4 (&acc)[2][2][4][2], const Unit& u, int wr, int wc, int fr, int fq) const {
        const int row0 = u.pm * BM + wr * 64 + fr, colt = u.pn * BM;
        if (u.pn < 4) {
            const float sc = (u.pn < 2) ? C2Q : 1.f; const int q8 = 4 * (wc & 1) + fq;
#pragma unroll
            for (int ai = 0; ai < 2; ++ai)
#pragma unroll
                for (int m = 0; m < 4; ++m) { const int row = row0 + ai * HALF + m * 16, pos = row & (SEQ - 1);
                    const f32x4 c4 = *(const f32x4*)(cs + pos * 32 + 4 * q8) * sc, s4 = *(const f32x4*)(sn + pos * 32 + 4 * q8) * sc;
                    bf16_t* rowp = O + (size_t)row * NPROJ + colt + 64 * (wc >> 1) + 4 * q8;
#pragma unroll
                    for (int bj = 0; bj < 2; ++bj) { const f32x4 x1 = acc[ai][bj][m][0], x2 = acc[ai][bj][m][1]; const f32x4 o1 = x1 * c4 - x2 * s4, o2 = x1 * s4 + x2 * c4;
                        u32x2 w1, w2; w1.x = cvt_pk_bf16(o1[0], o1[1]); w1.y = cvt_pk_bf16(o1[2], o1[3]); w2.x = cvt_pk_bf16(o2[0], o2[1]); w2.y = cvt_pk_bf16(o2[2], o2[3]);
                        *(u32x2*)(rowp + bj * HALF) = w1; *(u32x2*)(rowp + bj * HALF + 32) = w2; } }
        } else {
            const int col0 = colt + wc * 32 + 8 * fq;
#pragma unroll
            for (int ai = 0; ai < 2; ++ai)
#pragma unroll
                for (int m = 0; m < 4; ++m) { bf16_t* rowp = O + (size_t)(row0 + ai * HALF + m * 16) * NPROJ + col0;
#pragma unroll
                    for (int bj = 0; bj < 2; ++bj) { const f32x4 v0 = acc[ai][bj][m][0], v1 = acc[ai][bj][m][1];
                        u32x4 w; w.x = cvt_pk_bf16(v0[0], v0[1]); w.y = cvt_pk_bf16(v0[2], v0[3]); w.z = cvt_pk_bf16(v1[0], v1[1]); w.w = cvt_pk_bf16(v1[2], v1[3]);
                        *(u32x4*)(rowp + bj * HALF) = w; } }
        }
    }
};
struct EpiOut {
    static constexpr bool PERM = true;
    const float* x; float* X1; bf16_t* X1B;
    __device__ __forceinline__ void operator()(const f32x4 (&acc)[2][2][4][2], const Unit& u, int wr, int wc, int fr, int fq) const {
        const int row0 = u.pm * BM + wr * 64 + fr, col0 = u.pn * BM + wc * 32 + 8 * fq;
#pragma unroll
        for (int ai = 0; ai < 2; ++ai)
#pragma unroll
            for (int m = 0; m < 4; ++m) { const size_t off = (size_t)(row0 + ai * HALF + m * 16) * D + col0;
#pragma unroll
                for (int bj = 0; bj < 2; ++bj) { const f32x4 v0 = acc[ai][bj][m][0] + *(const f32x4*)(x + off + bj * HALF), v1 = acc[ai][bj][m][1] + *(const f32x4*)(x + off + bj * HALF + 4);
                    *(f32x4*)(X1 + off + bj * HALF) = v0; *(f32x4*)(X1 + off + bj * HALF + 4) = v1;
                    u32x4 w; w.x = cvt_pk_bf16(v0[0], v0[1]); w.y = cvt_pk_bf16(v0[2], v0[3]); w.z = cvt_pk_bf16(v1[0], v1[1]); w.w = cvt_pk_bf16(v1[2], v1[3]);
                    *(u32x4*)(X1B + off + bj * HALF) = w; }
                asm volatile("" ::: "memory"); }
    }
};
struct EpiUp {
    static constexpr bool PERM = true;
    bf16_t* HD; const float* rstd; const int* list;
    __device__ __forceinline__ void operator()(const f32x4 (&acc)[2][2][4][2], const Unit& u, int wr, int wc, int fr, int fq) const {
        const int r0 = u.pm * BM + wr * 64 + fr, col0 = u.pn * HALF + wc * 32 + 8 * fq;
#pragma unroll
        for (int ai = 0; ai < 2; ++ai)
#pragma unroll
            for (int m = 0; m < 4; ++m) { const int s = r0 + ai * HALF + m * 16; if (s < u.cnt) { const float rs = rstd[list[(size_t)u.e * LIST_CAP + s] >> 1];
                    float h[8];
#pragma unroll
                    for (int n = 0; n < 2; ++n)
#pragma unroll
                        for (int i = 0; i < 4; ++i) { const float a = acc[ai][0][m][n][i] * rs, b = acc[ai][1][m][n][i] * rs; h[4 * n + i] = a * b / (1.f + __expf(-a)); }
                    u32x4 w; w.x = cvt_pk_bf16(h[0], h[1]); w.y = cvt_pk_bf16(h[2], h[3]); w.z = cvt_pk_bf16(h[4], h[5]); w.w = cvt_pk_bf16(h[6], h[7]);
                    *(u32x4*)(HD + (size_t)(u.ps + s) * DE + col0) = w; } }
    }
};
struct EpiDown {
    static constexpr bool PERM = true;
    bf16_t* Y; const float* tokw; const int* list;
    __device__ __forceinline__ void operator()(const f32x4 (&acc)[2][2][4][2], const Unit& u, int wr, int wc, int fr, int fq) const {
        const int r0 = u.pm * BM + wr * 64 + fr, col0 = u.pn * BM + wc * 32 + 8 * fq;
#pragma unroll
        for (int ai = 0; ai < 2; ++ai)
#pragma unroll
            for (int m = 0; m < 4; ++m) { const int s = r0 + ai * HALF + m * 16; if (s < u.cnt) { const int a = list[(size_t)u.e * LIST_CAP + s]; const float w8 = tokw[a];
                    bf16_t* rowp = Y + (size_t)a * D + col0;
#pragma unroll
                    for (int bj = 0; bj < 2; ++bj) { const f32x4 v0 = acc[ai][bj][m][0] * w8, v1 = acc[ai][bj][m][1] * w8;
                        u32x4 w; w.x = cvt_pk_bf16(v0[0], v0[1]); w.y = cvt_pk_bf16(v0[2], v0[3]); w.z = cvt_pk_bf16(v1[0], v1[1]); w.w = cvt_pk_bf16(v1[2], v1[3]);
                        *(u32x4*)(rowp + bj * HALF) = w; } } }
    }
};

template <class Epi, class Sched, bool ALIGN_EPI, bool GATHER>
__device__ __forceinline__ void gemm_phase(PG8_LAS unsigned char* lds, const int K, const Sched& S, const Epi& E) {
    const int tid = threadIdx.x, wid = __builtin_amdgcn_readfirstlane(tid >> 6), lane = tid & 63, wr = wid >> 2, wc = wid & 3, fr = lane & 15, fq = lane >> 4;
    const int nt = K / BK;
    unsigned voffB[2], ga[2][2], gn[2][2]; int RA[2], CA[2];
#pragma unroll
    for (int i = 0; i < 2; ++i) { int R, C; stage_rc(tid * 16 + i * 8192, R, C); const int Rb = Epi::PERM ? ((R & ~31) + perm32(R & 31)) : R;
        RA[i] = R; CA[i] = C; voffB[i] = (unsigned)(Rb * K + C) * 2u; }
    const size_t kstep = (size_t)(BK * 2);
    const size_t hstep = (size_t)HALF * K * 2;
    const unsigned ldsw = (unsigned)wid * 1024u;
    const int aoff = lds_byte(wr * 64 + fr, fq * 8), boff = lds_byte(wc * 32 + fr, fq * 8);
#define PG8_SA(b, h) (((b) * 2 + (h)) * HTB)
#define PG8_SB(b, h) ((4 + (b) * 2 + (h)) * HTB)
#define PG8_STAGE(bufoff, gbase, voff) do { _Pragma("unroll") for (int _i = 0; _i < 2; ++_i) \
        __builtin_amdgcn_global_load_lds((const unsigned*)((const char*)(gbase) + (voff)[_i]), (PG8_LAS unsigned*)(lds + (bufoff) + ldsw + _i * 8192), 16, 0, 0); } while (0)
#define PG8_LDA(dst, b, h) do { _Pragma("unroll") for (int m = 0; m < 4; ++m) _Pragma("unroll") for (int k = 0; k < 2; ++k) dst[m][k] = *(const PG8_LAS bf16x8*)(lds + PG8_SA(b, h) + aoff + m * 2048 + k * 1024); } while (0)
#define PG8_LDB(dst, b, h) do { _Pragma("unroll") for (int n = 0; n < 2; ++n) _Pragma("unroll") for (int k = 0; k < 2; ++k) dst[n][k] = *(const PG8_LAS bf16x8*)(lds + PG8_SB(b, h) + boff + n * 2048 + k * 1024); } while (0)
#define PG8_MMA(ai, bj, At, Bt) do { __builtin_amdgcn_s_setprio(1); _Pragma("unroll") for (int m = 0; m < 4; ++m) _Pragma("unroll") for (int n = 0; n < 2; ++n) _Pragma("unroll") for (int k = 0; k < 2; ++k) \
        acc[ai][bj][m][n] = __builtin_amdgcn_mfma_f32_16x16x32_bf16(Bt[n][k], At[m][k], acc[ai][bj][m][n], 0, 0, 0); __builtin_amdgcn_s_setprio(0); } while (0)
#define PG8_WAIT_V(n) asm volatile("s_waitcnt vmcnt(" #n ")" ::: "memory")
#define PG8_WAIT_L(n) asm volatile("s_waitcnt lgkmcnt(" #n ")" ::: "memory")
#define PG8_BAR __builtin_amdgcn_s_barrier()
#define PG8_SCHED __builtin_amdgcn_sched_barrier(0)
    Unit cur, nxt; int ui = 0;
    if (!S.next(0, cur)) return;
#pragma unroll
    for (int h = 0; h < 2; ++h)
#pragma unroll
        for (int i = 0; i < 2; ++i) { ga[h][i] = (GATHER ? S.row_off(cur, h * HALF + RA[i]) : (unsigned)((h * HALF + RA[i]) * K) * 2u) + (unsigned)CA[i] * 2u; gn[h][i] = ga[h][i]; }
    f32x4 acc[2][2][4][2];
#pragma unroll
    for (int a = 0; a < 2; ++a)
#pragma unroll
        for (int b = 0; b < 2; ++b)
#pragma unroll
            for (int m = 0; m < 4; ++m)
#pragma unroll
                for (int n = 0; n < 2; ++n) acc[a][b][m][n] = (f32x4){0.f, 0.f, 0.f, 0.f};
    bf16x8 At[4][2], B0[2][2], B1[2][2];
    const char* cA = cur.a; const char* cB = cur.b;
    PG8_STAGE(PG8_SB(0, 0), cB, voffB); PG8_STAGE(PG8_SB(0, 1), cB + hstep, voffB); PG8_STAGE(PG8_SA(0, 0), cA, ga[0]); PG8_STAGE(PG8_SA(0, 1), cA, ga[1]);
    if (wr == 1) PG8_BAR;
    PG8_WAIT_V(2); PG8_BAR;
    PG8_STAGE(PG8_SB(1, 0), cB + kstep, voffB); PG8_STAGE(PG8_SA(1, 0), cA + kstep, ga[0]); PG8_STAGE(PG8_SB(1, 1), cB + hstep + kstep, voffB);
    PG8_WAIT_V(6); PG8_BAR;
    for (;;) {
        const bool has_next = S.next(ui + 1, nxt);
        const char* nA = has_next ? nxt.a : cA; const char* nB = has_next ? nxt.b : cB;
        if (GATHER && has_next) {
#pragma unroll
            for (int h = 0; h < 2; ++h)
#pragma unroll
                for (int i = 0; i < 2; ++i) gn[h][i] = S.row_off(nxt, h * HALF + RA[i]) + (unsigned)CA[i] * 2u;
        }
        for (int t = 0; t < nt; t += 2) {
            const bool last = (t == nt - 2);
            const char* a1 = cA + (size_t)(t + 1) * kstep;
            const char* a2 = last ? nA : cA + (size_t)(t + 2) * kstep; const char* b2 = last ? nB : cB + (size_t)(t + 2) * kstep;
            const char* a3 = a2 + kstep; const char* b3 = b2 + kstep;
            unsigned g2[2][2];
#pragma unroll
            for (int h = 0; h < 2; ++h)
#pragma unroll
                for (int i = 0; i < 2; ++i) g2[h][i] = (GATHER && last) ? gn[h][i] : ga[h][i];
            PG8_LDB(B0, 0, 0); PG8_LDB(B1, 0, 1); PG8_SCHED; PG8_LDA(At, 0, 0); PG8_STAGE(PG8_SA(1, 1), a1, ga[1]);
            PG8_WAIT_V(8); PG8_WAIT_L(0); PG8_BAR; PG8_MMA(0, 0, At, B0); PG8_MMA(0, 1, At, B1); PG8_BAR; PG8_SCHED;
            PG8_LDA(At, 0, 1); PG8_STAGE(PG8_SB(0, 0), b2, voffB); PG8_STAGE(PG8_SB(0, 1), b2 + hstep, voffB); PG8_STAGE(PG8_SA(0, 0), a2, g2[0]);
            PG8_WAIT_V(8); PG8_WAIT_L(0); PG8_BAR; PG8_MMA(1, 0, At, B0); PG8_MMA(1, 1, At, B1); PG8_BAR; PG8_SCHED;
            PG8_LDB(B0, 1, 0); PG8_LDB(B1, 1, 1); PG8_SCHED; PG8_LDA(At, 1, 0); PG8_STAGE(PG8_SA(0, 1), a2, g2[1]);
            PG8_WAIT_V(8); PG8_WAIT_L(0); PG8_BAR; PG8_MMA(0, 0, At, B0); PG8_MMA(0, 1, At, B1); PG8_BAR; PG8_SCHED;
            PG8_LDA(At, 1, 1); PG8_STAGE(PG8_SB(1, 0), b3, voffB); PG8_STAGE(PG8_SB(1, 1), b3 + hstep, voffB); PG8_STAGE(PG8_SA(1, 0), a3, g2[0]);
            PG8_WAIT_V(8); PG8_WAIT_L(0); PG8_BAR; PG8_MMA(1, 0, At, B0); PG8_MMA(1, 1, At, B1); PG8_BAR; PG8_SCHED;
        }
        if constexpr (ALIGN_EPI) { if (wr == 0) PG8_BAR; }
        E(acc, cur, wr, wc, fr, fq);
        if (!has_next) break;
#pragma unroll
        for (int a = 0; a < 2; ++a)
#pragma unroll
            for (int b = 0; b < 2; ++b)
#pragma unroll
                for (int m = 0; m < 4; ++m)
#pragma unroll
                    for (int n = 0; n < 2; ++n) acc[a][b][m][n] = (f32x4){0.f, 0.f, 0.f, 0.f};
        cur = nxt; cA = nA; cB = nB; ++ui;
#pragma unroll
        for (int h = 0; h < 2; ++h)
#pragma unroll
            for (int i = 0; i < 2; ++i) ga[h][i] = gn[h][i];
        if constexpr (ALIGN_EPI) { if (wr == 1) PG8_BAR; }
    }
    PG8_WAIT_V(0);
    if constexpr (!ALIGN_EPI) { if (wr == 0) PG8_BAR; }
    PG8_BAR;
#undef PG8_SA
#undef PG8_SB
#undef PG8_STAGE
#undef PG8_LDA
#undef PG8_LDB
#undef PG8_MMA
#undef PG8_WAIT_V
#undef PG8_WAIT_L
#undef PG8_BAR
#undef PG8_SCHED
}
}

constexpr int NWAVES = 8;
constexpr int RING_OFF = 0, RING_BYTES = 131072;
constexpr int LDSCTL_OFF = RING_BYTES;
constexpr int MISC_OFF = LDSCTL_OFF + 64;
constexpr int TAB_OFF = LDSCTL_OFF + 256;
constexpr int LDS_BYTES = RING_BYTES + 2048;

#define GAS __attribute__((address_space(1)))
typedef GAS unsigned gu32;
#define RLX_AGENT __ATOMIC_RELAXED, __HIP_MEMORY_SCOPE_AGENT
#define LDS_WAIT() asm volatile("s_waitcnt lgkmcnt(0)" ::: "memory")
#define VM_WAIT() asm volatile("s_waitcnt vmcnt(0)" ::: "memory")

#define XB_TMO      128
#define XB_XCNT(j)  (256  + 64 * (j))
#define XB_XSUB(j)  (1280 + 64 * (j))
#define XB_XGEN(j)  (2304 + 64 * (j))
#define XB_TOP      3328
#define XB_TOPGEN   3392
#define XCD_BAR_WORDS 3456
#define XB_SPIN_CAP (1u << 18)

__device__ __forceinline__ unsigned xb_ld(unsigned* p)              { return __hip_atomic_load(p, __ATOMIC_RELAXED, __HIP_MEMORY_SCOPE_AGENT); }
__device__ __forceinline__ unsigned xb_add(unsigned* p, unsigned v) { return __hip_atomic_fetch_add(p, v, __ATOMIC_RELAXED, __HIP_MEMORY_SCOPE_AGENT); }
__device__ __forceinline__ unsigned xb_xcc_id() { return (unsigned)__builtin_amdgcn_s_getreg((3 << 11) | 20) & 0xFu; }
#define XB_SPIN(cond, bar) do { unsigned _sp = 0; while (cond) { __builtin_amdgcn_s_sleep(1); \
    if ((++_sp & 255u) == 0u) { if (xb_ld(&(bar)[XB_TMO])) break; if (_sp > XB_SPIN_CAP) { atomicAdd(&(bar)[XB_TMO], 1u); break; } } } } while (0)

struct XcdBarrier { unsigned* bar; unsigned x; volatile LAS unsigned* st; };

__device__ __forceinline__ XcdBarrier xcd_barrier_post(unsigned* bar, volatile LAS unsigned* st) {
    XcdBarrier b; b.bar = bar; b.x = xb_xcc_id(); b.st = st;
    if (threadIdx.x == 0) (void)xb_add(&bar[XB_XCNT(b.x)], 1u);
    return b;
}
__device__ __forceinline__ void xcd_barrier_complete(unsigned* bar, unsigned x, unsigned& nloc, unsigned& nx) {
    const unsigned G = gridDim.x * gridDim.y * gridDim.z;
    unsigned sum, cnt, mine, sp = 0u;
    for (;;) {
        sum = 0u; cnt = 0u; mine = 0u;
#pragma unroll
        for (unsigned j = 0; j < 16; ++j) { const unsigned c = xb_ld(&bar[XB_XCNT(j)]); sum += c; cnt += (c > 0u) ? 1u : 0u; mine = (j == x) ? c : mine; }
        if (sum == G) break;
        __builtin_amdgcn_s_sleep(1);
        if ((++sp & 255u) == 0u) { if (xb_ld(&bar[XB_TMO])) break; if (sp > XB_SPIN_CAP) { atomicAdd(&bar[XB_TMO], 1u); break; } }
    }
    nloc = mine > 0u ? mine : 1u; nx = cnt > 0u ? cnt : 1u;
}
__device__ __forceinline__ void xcd_barrier(const XcdBarrier& b) {
    asm volatile("s_waitcnt vmcnt(0)" ::: "memory");
    __syncthreads();
    if (threadIdx.x == 0) {
        unsigned* bar = b.bar;
        __builtin_amdgcn_s_waitcnt(0);
        unsigned nloc = b.st[0], nx = b.st[1];
        if (nloc == 0u) { xcd_barrier_complete(bar, b.x, nloc, nx); b.st[0] = nloc; b.st[1] = nx; }
        const unsigned old = xb_add(&bar[XB_XSUB(b.x)], 1u);
        const unsigned gen = old / nloc;
        if (old + 1u == (gen + 1u) * nloc) {
            __builtin_amdgcn_fence(__ATOMIC_RELEASE, "agent");
            asm volatile("s_waitcnt vmcnt(0)" ::: "memory");
            const unsigned og = xb_add(&bar[XB_TOP], 1u);
            const unsigned tg = og / nx;
            if (og + 1u == (tg + 1u) * nx) xb_add(&bar[XB_TOPGEN], 1u);
            else XB_SPIN(xb_ld(&bar[XB_TOPGEN]) == tg, bar);
            __builtin_amdgcn_fence(__ATOMIC_ACQUIRE, "agent");
            xb_add(&bar[XB_XGEN(b.x)], 1u);
            asm volatile("s_waitcnt vmcnt(0)" ::: "memory");
        } else {
            XB_SPIN(xb_ld(&bar[XB_XGEN(b.x)]) == gen, bar);
            __builtin_amdgcn_fence(__ATOMIC_ACQUIRE, "agent");
            asm volatile("s_waitcnt vmcnt(0)" ::: "memory");
        }
    }
    __syncthreads();
}

struct Frame {
    LAS unsigned char* lds;
    unsigned* ctl;
    int tid, lane, wave, vcu, G;
    Ptrs p;
};

__device__ __forceinline__ void p0_prologue(Frame& F) {
    const Ptrs& p = F.p; const int tid = F.tid, lane = F.lane, wave = F.wave;
    LAS float* scr = (LAS float*)(F.lds + RING_OFF) + wave * 64 * 33;
    LAS float* gw = (LAS float*)(F.lds + RING_OFF + 8 * 64 * 33 * 4);
    const int gw_id = F.vcu * NWAVES + wave, NGW = F.G * NWAVES;
    bf16_t* WIN = (bf16_t*)(p.ws + WS_WIN); bf16_t* WOUT = (bf16_t*)(p.ws + WS_WOUT); bf16_t* W13 = (bf16_t*)(p.ws + WS_W13); bf16_t* W2 = (bf16_t*)(p.ws + WS_W2);
    for (int i = tid; i < 1024 * 8; i += NWAVES * 64) gw[i] = p.w_in[(size_t)(i >> 3) * DIN + C_IG + (i & 7)];
    __syncthreads();
    constexpr int I_IN = 16 * 112, I_OUT = 16 * 32, I_13 = 16 * 16 * 32, I_2 = 8 * 32 * 32;
    constexpr int NITEMS = I_IN + I_OUT + 2 * I_13 + I_2;
    for (int it = gw_id; it < NITEMS; it += NGW) {
        int r = it;
        if (r < I_IN) { const int kb = r / 112, nb = r % 112; transpose_item(p.w_in, DIN, WIN, 1024, 64 * kb, 32 * nb, MapRope(), nullptr, scr, lane); continue; } r -= I_IN;
        if (r < I_OUT) { const int kb = r / 32, nb = r % 32; transpose_item(p.w_out, 1024, WOUT, 1024, 64 * kb, 32 * nb, MapId(), nullptr, scr, lane); continue; } r -= I_OUT;
        if (r < I_13) { const int e = r / 256, q = r % 256, kb = q / 16, nb = q % 16; transpose_item(p.w1 + (size_t)e * 1024 * 512, 512, W13 + (size_t)e * 1024 * 1024, 1024, 64 * kb, 32 * nb, MapW1(), p.g_ffn, scr, lane); continue; } r -= I_13;
        if (r < I_13) { const int e = r / 256, q = r % 256, kb = q / 16, nb = q % 16; transpose_item(p.w3 + (size_t)e * 1024 * 512, 512, W13 + (size_t)e * 1024 * 1024, 1024, 64 * kb, 32 * nb, MapW3(), p.g_ffn, scr, lane); continue; } r -= I_13;
        { const int e = r / 256, q = r % 256, kb = q / 32, nb = q % 32; transpose_item(p.w2 + (size_t)e * 512 * 1024, 1024, W2 + (size_t)e * 1024 * 512, 512, 64 * kb, 32 * nb, MapId(), nullptr, scr, lane); }
    }
    { float* cs = (float*)(p.ws + WS_ROPE); float* sn = cs + 2048 * 32;
      for (int i = blockIdx.x * 512 + tid; i < 2048 * 32; i += F.G * 512) { const int pos = i >> 5, j = i & 31;
          const float inv = 1.0f / exp2f((float)(2 * j) * (1.f / 64.f) * 13.287712379549449f);
          const float ang = (float)pos * inv; const double rev = (double)ang * 0.15915494309189535; const float fr = (float)(rev - rint(rev));
          cs[i] = __builtin_amdgcn_cosf(fr); sn[i] = __builtin_amdgcn_sinf(fr); } }
    bf16_t* HB = (bf16_t*)(p.ws + WS_HB); float* GATES = (float*)(p.ws + WS_GATES);
    for (int m = gw_id; m < T; m += NGW) {
        const f32x4* xr = (const f32x4*)(p.x + (size_t)m * D) + lane; const f32x4* gr = (const f32x4*)p.g_mix + lane;
        f32x4 v[4]; float s = 0.f;
#pragma unroll
        for (int j = 0; j < 4; ++j) { v[j] = xr[64 * j]; s += (v[j].x * v[j].x + v[j].y * v[j].y) + (v[j].z * v[j].z + v[j].w * v[j].w); }
        const float rstd = 1.f / sqrtf(wave_sum(s) * (1.f / D) + RMS_EPS);
        float ga[8];
#pragma unroll
        for (int e = 0; e < 8; ++e) ga[e] = 0.f;
        unsigned long long* o8 = (unsigned long long*)(HB + (size_t)m * D) + lane;
#pragma unroll
        for (int j = 0; j < 4; ++j) { const f32x4 g = gr[64 * j]; f32x4 h = v[j] * rstd * g;
            o8[64 * j] = (unsigned long long)pk2(h.x, h.y) | ((unsigned long long)pk2(h.z, h.w) << 32);
            const int k0 = 256 * j + 4 * lane;
#pragma unroll
            for (int q = 0; q < 4; ++q) { const float hv = h[q]; const LAS float* w = gw + (k0 + q) * 8;
#pragma unroll
                for (int e = 0; e < 8; ++e) ga[e] += hv * w[e]; } }
#pragma unroll
        for (int e = 0; e < 8; ++e) ga[e] = wave_sum(ga[e]);
        if (lane < 8) { float gv = 0.f;
#pragma unroll
            for (int e = 0; e < 8; ++e) gv = (lane == e) ? ga[e] : gv;
            gv += p.gate_b[lane];
            if (lane >= 4) gv = fminf(gv, 0.f) - log1pf(__expf(-fabsf(gv)));
            GATES[(size_t)m * 8 + lane] = gv; }
    }
}

__device__ __forceinline__ void attn_ref_body(Frame& F) {
    const bf16_t* PROJ = (const bf16_t*)(F.p.ws + WS_PROJ); float* OC = F.p.out;
    for (int idx = blockIdx.x * 512 + F.tid; idx < BATCH * 4 * 2 * SEQ; idx += F.G * 512) {
        const int q = idx & (SEQ - 1), c = (idx >> 11) & 1, h = (idx >> 12) & 3, b = idx >> 14;
        const int qmax = __builtin_amdgcn_readfirstlane(q | 63);
        const size_t rowb = (size_t)b * SEQ;
        float qv[64];
        { const bf16_t* qp = PROJ + (rowb + q) * NPROJ + C_QA + h * 128 + c * 64;
#pragma unroll
          for (int d = 0; d < 64; ++d) qv[d] = bf2f(qp[d]); }
        float o[128];
#pragma unroll
        for (int d = 0; d < 128; ++d) o[d] = 0.f;
        float m = -INFINITY, l = 0.f;
        for (int j = 0; j <= qmax; ++j) {
            const bf16_t* kp = PROJ + (rowb + j) * NPROJ + C_KA + h * 128 + c * 64; const bf16_t* vp = PROJ + (rowb + j) * NPROJ + C_VA + h * 128;
            float s = 0.f;
#pragma unroll
            for (int d = 0; d < 64; ++d) s += qv[d] * bf2f(kp[d]);
            if (j <= q) { const float mn = fmaxf(m, s), sc = exp2f(m - mn), pr = exp2f(s - mn); l = l * sc + pr; m = mn;
#pragma unroll
                for (int d = 0; d < 128; ++d) o[d] = o[d] * sc + pr * bf2f(vp[d]); }
        }
        const float rl = 1.f / l; float* op = OC + ((size_t)c * T + rowb + q) * 512 + h * 128;
#pragma unroll
        for (int d = 0; d < 128; ++d) op[d] = o[d] * rl;
    }
}
__device__ __forceinline__ void attn_combine_body(Frame& F) {
    const float* OC = F.p.out; bf16_t* MIX = (bf16_t*)(F.p.ws + WS_MIX); const float* lam_qk = F.p.lam_qk; const int lane = F.lane;
    const float lam = __expf(wave_sum(lam_qk[lane] * lam_qk[64 + lane])) - __expf(wave_sum(lam_qk[128 + lane] * lam_qk[192 + lane])) + LAMBDA_INIT;
    for (int w = F.vcu * NWAVES + F.wave; w < T * 4; w += F.G * NWAVES) { const int row = w >> 2, h = w & 3;
        const float* o1 = OC + (size_t)row * 512 + h * 128; const float* o2 = OC + ((size_t)T + row) * 512 + h * 128;
        const float v0 = o1[lane] - lam * o2[lane], v1 = o1[lane + 64] - lam * o2[lane + 64];
        const float rs = 1.f / sqrtf(wave_sum(v0 * v0 + v1 * v1) * (1.f / 128.f) + RMS_EPS) * (1.f - LAMBDA_INIT);
        bf16_t* o = MIX + (size_t)row * D + h * 128;
        o[lane] = (bf16_t)f2bf(v0 * rs * F.p.subln_g[lane]); o[lane + 64] = (bf16_t)f2bf(v1 * rs * F.p.subln_g[lane + 64]); }
}
__device__ __forceinline__ void mlstm_ref_body(Frame& F, int bh) {
    const bf16_t* PROJ = (const bf16_t*)(F.p.ws + WS_PROJ); const float* GATES = (const float*)(F.p.ws + WS_GATES); bf16_t* MIX = (bf16_t*)(F.p.ws + WS_MIX);
    LAS float* sq = (LAS float*)(F.lds + RING_OFF); LAS float* sk = sq + 128; LAS float* sv = sk + 128; LAS float* so = sv + 128; LAS float* sh = so + 128;
    const int tid = F.tid, v = tid >> 2, kg = tid & 3; const int b = bh >> 2, h = bh & 3;
    float C[32], n[32];
#pragma unroll
    for (int i = 0; i < 32; ++i) { C[i] = 0.f; n[i] = 0.f; }
    float m = 0.f;
    for (int t = 0; t < SEQ; ++t) {
        const size_t row = (size_t)b * SEQ + t;
        if (tid < 256) { const int cc = (tid < 128) ? h * 128 + tid : 512 + h * 128 + (tid - 128);
            float y = F.p.conv_b[cc];
#pragma unroll
            for (int j = 0; j < 4; ++j) { const int tt = t - 3 + j; if (tt >= 0) y += F.p.conv_w[j * 1024 + cc] * bf2f(PROJ[((size_t)b * SEQ + tt) * NPROJ + C_QM + cc]); }
            const float sl = y * sigmoidf_(y);
            if (tid < 128) sq[tid] = sl; else sk[tid - 128] = sl * 0.08838834764831845f; }
        else if (tid < 384) sv[tid - 256] = bf2f(PROJ[row * NPROJ + C_VM + h * 128 + (tid - 256)]);
        else so[tid - 384] = bf2f(PROJ[row * NPROJ + C_OM + h * 128 + (tid - 384)]);
        __syncthreads();
        const float li = GATES[row * 8 + h], lf = GATES[row * 8 + 4 + h];
        const float mn = fmaxf(lf + m, li), fd = __expf(lf + m - mn), ii = __expf(li - mn);
        float pn = 0.f, pd = 0.f; const float vv = sv[v] * ii;
#pragma unroll
        for (int i = 0; i < 32; ++i) { const float kk = sk[kg * 32 + i], qq = sq[kg * 32 + i]; C[i] = fd * C[i] + vv * kk; n[i] = fd * n[i] + ii * kk; pn += C[i] * qq; pd += n[i] * qq; }
        pn += __shfl_xor(pn, 1); pn += __shfl_xor(pn, 2);
        pd += __shfl_xor(pd, 1); pd += __shfl_xor(pd, 2);
        const float hv = pn / fmaxf(fabsf(pd), __expf(-mn));
        if (kg == 0) sh[v] = hv * sigmoidf_(so[v]);
        m = mn;
        __syncthreads();
        if (tid < 128) { float ss = 0.f;
            for (int i = 0; i < 128; ++i) ss += sh[i] * sh[i];
            MIX[row * D + 512 + h * 128 + tid] = (bf16_t)f2bf(sh[tid] * (1.f / sqrtf(ss * (1.f / 128.f) + RMS_EPS)) * F.p.mhnorm_g[h * 128 + tid]); }
        __syncthreads();
    }
}

__device__ __forceinline__ void router_ref_body(Frame& F) {
    const Ptrs& p = F.p; const int lane = F.lane;
    const float* X1 = p.out; unsigned* ctl = F.ctl; int* list = (int*)(p.ws + WS_LIST); float* tokw = (float*)(p.ws + WS_TOKW); float* rstd_o = (float*)(p.ws + WS_RSTD);
    for (int tok = F.vcu * NWAVES + F.wave; tok < T; tok += F.G * NWAVES) {
        float hv[16]; float s = 0.f;
#pragma unroll
        for (int j = 0; j < 4; ++j) { const f32x4 v = ((const f32x4*)(X1 + (size_t)tok * D))[lane + 64 * j]; hv[4 * j] = v.x; hv[4 * j + 1] = v.y; hv[4 * j + 2] = v.z; hv[4 * j + 3] = v.w; s += (v.x * v.x + v.y * v.y) + (v.z * v.z + v.w * v.w); }
        const float rstd = 1.f / sqrtf(wave_sum(s) * (1.f / D) + RMS_EPS);
#pragma unroll
        for (int j = 0; j < 4; ++j)
#pragma unroll
            for (int q = 0; q < 4; ++q) hv[4 * j + q] *= rstd * p.g_ffn[256 * j + 4 * lane + q];
        float gl[4];
#pragma unroll
        for (int g = 0; g < 4; ++g) { float a = 0.f;
#pragma unroll
            for (int j = 0; j < 4; ++j)
#pragma unroll
                for (int q = 0; q < 4; ++q) a += hv[4 * j + q] * p.w_grp[(size_t)(256 * j + 4 * lane + q) * 4 + g];
            gl[g] = wave_sum(a) + p.b_grp[g]; }
        int gs = 0; float gm = gl[0];
#pragma unroll
        for (int g = 1; g < 4; ++g) if (gl[g] > gm) { gm = gl[g]; gs = g; }
        float gsum = 0.f;
#pragma unroll
        for (int g = 0; g < 4; ++g) gsum += __expf(gl[g] - gm);
        const float gwt = 1.f / gsum;
        float el[8];
#pragma unroll
        for (int e = 0; e < 8; ++e) { float a = 0.f;
#pragma unroll
            for (int j = 0; j < 4; ++j)
#pragma unroll
                for (int q = 0; q < 4; ++q) a += hv[4 * j + q] * p.w_er[((size_t)gs * 1024 + 256 * j + 4 * lane + q) * 8 + e];
            el[e] = wave_sum(a) + p.b_er[gs * 8 + e]; }
        int i0 = 0; float v0 = el[0];
#pragma unroll
        for (int e = 1; e < 8; ++e) if (el[e] > v0) { v0 = el[e]; i0 = e; }
        int i1 = -1; float v1 = -INFINITY;
#pragma unroll
        for (int e = 0; e < 8; ++e) if (e != i0 && el[e] > v1) { v1 = el[e]; i1 = e; }
        const float e1 = __expf(v1 - v0), w0 = gwt / (1.f + e1), w1 = gwt * e1 / (1.f + e1);
        if (lane == 0) {
            const int ea = gs * 8 + i0, eb = gs * 8 + i1;
            const unsigned sa = atomicAdd(&ctl[CW_CNT + 64 * ea], 1u); list[(size_t)ea * LIST_CAP + sa] = tok * 2;
            const unsigned sb = atomicAdd(&ctl[CW_CNT + 64 * eb], 1u); list[(size_t)eb * LIST_CAP + sb] = tok * 2 + 1;
            tokw[tok * 2] = w0; tokw[tok * 2 + 1] = w1; rstd_o[tok] = rstd; }
    }
}
__device__ __forceinline__ void final_body(Frame& F) {
    const Ptrs& p = F.p; const int lane = F.lane; float* X1 = p.out; const bf16_t* Y = (const bf16_t*)(p.ws + WS_Y);
    for (size_t tok = F.vcu * NWAVES + F.wave; tok < T; tok += F.G * NWAVES) {
        f32x4 v[4]; float s = 0.f;
#pragma unroll
        for (int j = 0; j < 4; ++j) { v[j] = ((const f32x4*)(X1 + tok * D))[lane + 64 * j];
            const u32x2 a = ((const u32x2*)(Y + (2 * tok) * D))[lane + 64 * j], b = ((const u32x2*)(Y + (2 * tok + 1) * D))[lane + 64 * j];
            v[j].x += bf2f(a.x & 0xffffu) + bf2f(b.x & 0xffffu); v[j].y += bf2f(a.x >> 16) + bf2f(b.x >> 16); v[j].z += bf2f(a.y & 0xffffu) + bf2f(b.y & 0xffffu); v[j].w += bf2f(a.y >> 16) + bf2f(b.y >> 16);
            s += (v[j].x * v[j].x + v[j].y * v[j].y) + (v[j].z * v[j].z + v[j].w * v[j].w); }
        const float rstd = 1.f / sqrtf(wave_sum(s) * (1.f / D) + RMS_EPS);
#pragma unroll
        for (int j = 0; j < 4; ++j) { const f32x4 g = ((const f32x4*)p.g_final)[lane + 64 * j]; ((f32x4*)(X1 + tok * D))[lane + 64 * j] = v[j] * rstd * g; }
    }
}
__device__ __forceinline__ void moe_tables(Frame& F) {
    LAS int* tab = (LAS int*)(F.lds + TAB_OFF);
    if (F.tid == 0) { int us = 0, ps = 0;
        for (int e = 0; e < NE; ++e) { const int c = (int)__hip_atomic_load(F.ctl + CW_CNT + 64 * e, RLX_AGENT); const int nb = (c + 255) >> 8;
            tab[e] = us; tab[64 + e] = ps; tab[128 + e] = c; us += nb * 4; ps += nb * 256; }
        tab[32] = us; tab[96] = ps; }
    __syncthreads();
}

struct Args { Ptrs p; int ph_lo, ph_hi; };
constexpr int N_PHASES = 9;
__global__ void __launch_bounds__(NWAVES * 64, 2) mk_fwd(Args args) {
    extern __shared__ __attribute__((aligned(16))) unsigned char lds_raw[];
    Frame F;
    F.lds = (LAS unsigned char*)lds_raw; F.p = args.p;
    F.tid = threadIdx.x; F.lane = F.tid & 63; F.wave = __builtin_amdgcn_readfirstlane(F.tid >> 6);
    F.G = gridDim.x; { const int bx = blockIdx.x; F.vcu = (F.G % 8 == 0) ? (bx % 8) * (F.G / 8) + bx / 8 : bx; }
    F.ctl = (unsigned*)(args.p.ws + WS_CTL);
    for (int u = F.tid; u < (LDS_BYTES - LDSCTL_OFF) / 4; u += NWAVES * 64) ((LAS unsigned*)(F.lds + LDSCTL_OFF))[u] = 0u;
    __syncthreads();
    XcdBarrier bar = xcd_barrier_post(F.ctl + CW_BAR, (volatile LAS unsigned*)(F.lds + MISC_OFF) + 8);
    const int lo = args.ph_lo, hi = args.ph_hi;
    unsigned char* ws = args.p.ws;
#define IN(k) (lo <= (k) && (k) < hi)
#define SEAM(k) do { if (IN(k) && IN((k) + 1)) xcd_barrier(bar); } while (0)

    if (IN(0)) { p0_prologue(F); }
    SEAM(0);
    if (IN(1)) {
        pg8::StaticOrder S; S.init(ws + WS_HB, ws + WS_WIN, T, NPROJ, D, F.G, (int)blockIdx.x);
        const float* cs = (const float*)(ws + WS_ROPE);
        pg8::EpiProj E{(bf16_t*)(ws + WS_PROJ), cs, cs + 2048 * 32};
        pg8::gemm_phase<pg8::EpiProj, pg8::StaticOrder, true, false>(F.lds + RING_OFF, D, S, E);
    }
    SEAM(1);
    if (IN(2)) { attn_ref_body(F); }
    SEAM(2);
    if (IN(3)) { attn_combine_body(F); if (blockIdx.x < BATCH * 4) mlstm_ref_body(F, (int)blockIdx.x); }
    SEAM(3);
    if (IN(4)) {
        pg8::StaticOrder S; S.init(ws + WS_MIX, ws + WS_WOUT, T, D, D, F.G, (int)blockIdx.x);
        pg8::EpiOut E{F.p.x, F.p.out, (bf16_t*)(ws + WS_X1B)};
        pg8::gemm_phase<pg8::EpiOut, pg8::StaticOrder, true, false>(F.lds + RING_OFF, D, S, E);
    }
    SEAM(4);
    if (IN(5)) { router_ref_body(F); }
    SEAM(5);
    if (IN(6)) {
        moe_tables(F);
        pg8::MoeOrder S{(const LAS int*)(F.lds + TAB_OFF), F.G, F.vcu, (const char*)(ws + WS_X1B), (const char*)(ws + WS_W13), (size_t)1024 * 1024 * 2, (size_t)256 * 1024 * 2, 0, true, (const int*)(ws + WS_LIST), D};
        pg8::EpiUp E{(bf16_t*)(ws + WS_HD), (const float*)(ws + WS_RSTD), (const int*)(ws + WS_LIST)};
        pg8::gemm_phase<pg8::EpiUp, pg8::MoeOrder, true, true>(F.lds + RING_OFF, D, S, E);
    }
    SEAM(6);
    if (IN(7)) {
        moe_tables(F);
        pg8::MoeOrder S{(const LAS int*)(F.lds + TAB_OFF), F.G, F.vcu, (const char*)(ws + WS_HD), (const char*)(ws + WS_W2), (size_t)1024 * 512 * 2, (size_t)256 * 512 * 2, (size_t)DE * 2, false, (const int*)(ws + WS_LIST), DE};
        pg8::EpiDown E{(bf16_t*)(ws + WS_Y), (const float*)(ws + WS_TOKW), (const int*)(ws + WS_LIST)};
        pg8::gemm_phase<pg8::EpiDown, pg8::MoeOrder, true, false>(F.lds + RING_OFF, DE, S, E);
    }
    SEAM(7);
    if (IN(8)) { final_body(F); }
#undef IN
#undef SEAM
}

extern "C" void kernel_launch(void* const* d_in, const int* in_sizes, int n_in, void* d_out, int out_size, void* d_ws, size_t ws_size, hipStream_t stream) {
    static int grid = 0;
    if (grid == 0) {
        if (n_in != 19 || out_size != T * D || ws_size < WS_END) { fprintf(stderr, "kernel_launch: unexpected shapes (n_in %d out %d ws %zu)\n", n_in, out_size, ws_size); grid = -1; return; }
        int dev = 0, cus = 0, per_cu = 0;
        if (hipGetDevice(&dev) != hipSuccess || hipDeviceGetAttribute(&cus, hipDeviceAttributeMultiprocessorCount, dev) != hipSuccess) { grid = -1; return; }
        if (hipFuncSetAttribute((const void*)mk_fwd, hipFuncAttributeMaxDynamicSharedMemorySize, LDS_BYTES) != hipSuccess) { fprintf(stderr, "kernel_launch: hipFuncSetAttribute failed\n"); grid = -1; return; }
        if (hipOccupancyMaxActiveBlocksPerMultiprocessor(&per_cu, (const void*)mk_fwd, NWAVES * 64, LDS_BYTES) != hipSuccess || per_cu < 1) { fprintf(stderr, "kernel_launch: occupancy query says %d\n", per_cu); }
        (void)hipGetLastError();
        grid = cus;
    }
    if (grid < 0) return;
    Args a{};
    Ptrs& p = a.p;
    p.x = (const float*)d_in[0]; p.w_in = (const float*)d_in[1]; p.conv_w = (const float*)d_in[2]; p.conv_b = (const float*)d_in[3]; p.gate_b = (const float*)d_in[4];
    p.lam_qk = (const float*)d_in[5]; p.subln_g = (const float*)d_in[6]; p.mhnorm_g = (const float*)d_in[7]; p.w_out = (const float*)d_in[8]; p.g_mix = (const float*)d_in[9];
    p.g_ffn = (const float*)d_in[10]; p.w_grp = (const float*)d_in[11]; p.b_grp = (const float*)d_in[12]; p.w_er = (const float*)d_in[13]; p.b_er = (const float*)d_in[14];
    p.w1 = (const float*)d_in[15]; p.w3 = (const float*)d_in[16]; p.w2 = (const float*)d_in[17]; p.g_final = (const float*)d_in[18];
    p.out = (float*)d_out; p.ws = (unsigned char*)d_ws;
    if (hipMemsetAsync((char*)d_ws + WS_CTL, 0, CTL_ZERO_BYTES, stream) != hipSuccess) return;
    a.ph_lo = 0; a.ph_hi = N_PHASES;
    hipLaunchKernelGGL(mk_fwd, dim3(grid), dim3(NWAVES * 64), LDS_BYTES, stream, a);
}
```

```cpp
#include <hip/hip_runtime.h>
#include <cstdio>
#include <cstdint>

constexpr int BATCH = 16, SEQ = 2048, D = 1024, T = BATCH * SEQ;
constexpr int DIN = 3592, NPROJ = 3584;
constexpr int C_QA = 0, C_KA = 512, C_VA = 1024, C_QM = 1536, C_KM = 2048, C_VM = 2560, C_OM = 3072, C_IG = 3584, C_FG = 3588;
constexpr int NE = 32, EPG = 8, DE = 512;
constexpr float RMS_EPS = 1e-6f;
constexpr float LAMBDA_INIT = 0.2f;
constexpr float C2Q = 0.125f * 1.4426950408889634f;
constexpr int LIST_CAP = T;

constexpr size_t MiB = 1u << 20;
constexpr size_t WS_CTL = 0, CTL_ZERO_BYTES = 1 * MiB;
constexpr size_t WS_ROPE = 1 * MiB;
constexpr size_t WS_TOKW = 2 * MiB;
constexpr size_t WS_RSTD = 2 * MiB + 512 * 1024;
constexpr size_t WS_LIST = 4 * MiB;
constexpr size_t WS_GATES = 8 * MiB;
constexpr size_t WS_WIN = 10 * MiB;
constexpr size_t WS_WOUT = 17 * MiB;
constexpr size_t WS_W13 = 20 * MiB;
constexpr size_t WS_W2 = 84 * MiB;
constexpr size_t WS_PROJ = 116 * MiB;
constexpr size_t WS_MIX = 340 * MiB;
constexpr size_t WS_X1B = 404 * MiB;
constexpr size_t WS_HB = 404 * MiB;
constexpr size_t WS_HD = 116 * MiB;
constexpr size_t WS_Y = 188 * MiB;
constexpr size_t WS_END = 468 * MiB;
constexpr int CW_TMO = 0, CW_CODE = 1;
constexpr int CW_CNT = 1024;
constexpr int CW_BAR = 4096;
constexpr int CW_QATT = 8192;

#define LAS __attribute__((address_space(3)))
typedef unsigned short bf16_t;
typedef short bf16x8 __attribute__((ext_vector_type(8)));
typedef float f32x4 __attribute__((ext_vector_type(4)));
typedef unsigned u32x4 __attribute__((ext_vector_type(4)));
typedef unsigned u32x2 __attribute__((ext_vector_type(2)));

__device__ __forceinline__ unsigned f2bf(float f) { unsigned u = __float_as_uint(f); return (u + 0x7fffu + ((u >> 16) & 1u)) >> 16; }
__device__ __forceinline__ unsigned pk2(float lo, float hi) { return f2bf(lo) | (f2bf(hi) << 16); }
__device__ __forceinline__ float bf2f(unsigned b) { return __uint_as_float(b << 16); }
__device__ __forceinline__ float wave_sum(float v) {
#pragma unroll
    for (int o = 1; o < 64; o <<= 1) v += __shfl_xor(v, o);
    return v;
}
__device__ __forceinline__ float sigmoidf_(float x) { return 1.f / (1.f + __expf(-x)); }

struct MapId { __device__ __forceinline__ int operator()(int n) const { return n; } };
struct MapRope {
    __device__ __forceinline__ int operator()(int c) const { if (c >= 1024) return c; const int g = c & ~63, d = c & 63; return g + 8 * ((d & 31) >> 2) + 4 * (d >> 5) + (d & 3); } };
struct MapW1 { __device__ __forceinline__ int operator()(int c) const { return 256 * (c >> 7) + (c & 127); } };
struct MapW3 { __device__ __forceinline__ int operator()(int c) const { return 256 * (c >> 7) + 128 + (c & 127); } };
template <class Map>
__device__ __forceinline__ void transpose_item(const float* W, int ldw, bf16_t* WT, int K, int k0, int n0, const Map& map, const float* kscale, LAS float* scr, int lane) {
#pragma unroll 8
    for (int i = 0; i < 32; ++i) { const int kk = 2 * i + (lane >> 5); scr[kk * 33 + (lane & 31)] = W[(size_t)(k0 + kk) * ldw + n0 + (lane & 31)]; }
    asm volatile("s_waitcnt vmcnt(0) lgkmcnt(0)" ::: "memory");
    const int c = lane & 7;
    float ks[8];
#pragma unroll
    for (int i = 0; i < 8; ++i) ks[i] = kscale ? kscale[k0 + 8 * c + i] : 1.f;
#pragma unroll
    for (int j = 0; j < 4; ++j) { const int n = (lane >> 3) + 8 * j; const LAS float* s = scr + (8 * c) * 33 + n;
        u32x4 o; o.x = pk2(s[0 * 33] * ks[0], s[1 * 33] * ks[1]); o.y = pk2(s[2 * 33] * ks[2], s[3 * 33] * ks[3]); o.z = pk2(s[4 * 33] * ks[4], s[5 * 33] * ks[5]); o.w = pk2(s[6 * 33] * ks[6], s[7 * 33] * ks[7]);
        *(u32x4*)(WT + (size_t)map(n0 + n) * K + k0 + 8 * c) = o; }
    asm volatile("s_waitcnt lgkmcnt(0)" ::: "memory");
}

struct Ptrs {
    const float *x, *w_in, *conv_w, *conv_b, *gate_b, *lam_qk, *subln_g, *mhnorm_g, *w_out, *g_mix, *g_ffn, *w_grp, *b_grp, *w_er, *b_er, *w1, *w3, *w2, *g_final;
    float* out; unsigned char* ws;
};


namespace pg8 {
#define PG8_LAS __attribute__((address_space(3)))
constexpr int BM = 256, BK = 64, HALF = 128, HTB = HALF * BK * 2, STAGE_BYTES = 8 * HTB, NXCD = 8, WGM = 8;
__host__ __device__ __forceinline__ int lds_byte(int r, int c) { const int st = (r >> 4) * 2 + (c >> 5), rr = r & 15, cc = c & 31, ob = rr * 64 + cc * 2; return st * 1024 + (ob ^ (((ob >> 9) & 1) << 5)); }
__host__ __device__ __forceinline__ void stage_rc(int b, int& R, int& C) { const int st = b / 1024, sb = b % 1024, swz = sb ^ (((sb >> 9) & 1) << 5); R = (st >> 1) * 16 + swz / 64; C = (st & 1) * 32 + (swz % 64) / 2; }
__host__ __device__ __forceinline__ int perm32(int rho) { const int n = rho >> 4, i = rho & 15; return 8 * (i >> 2) + 4 * n + (i & 3); }

struct Unit { int pm, pn; const char* a; const char* b; int e, cnt, ps; };

struct StaticOrder {
    int nM, nN, nwg, G, c; const char* A; const char* Bt; size_t tstep;
    __device__ void init(const void* A_, const void* Bt_, int M, int N, int K, int G_, int c_) { A = (const char*)A_; Bt = (const char*)Bt_; nM = M / BM; nN = N / BM; nwg = nM * nN; G = G_; c = c_; tstep = (size_t)BM * K * 2; }
    __device__ bool next(int i, Unit& u) const {
        const long L = (long)i * G + c; if (L >= nwg) return false;
        int wgid = (int)L; { const int q = nwg / NXCD, r = nwg % NXCD, xcd = wgid % NXCD, off = wgid / NXCD; wgid = (xcd < r ? xcd * (q + 1) : r * (q + 1) + (xcd - r) * q) + off; }
        const int nig = WGM * nN, gid = wgid / nig, fm = gid * WGM, gsz = (nM - fm) < WGM ? (nM - fm) : WGM;
        u.pm = fm + ((wgid % nig) % gsz); u.pn = (wgid % nig) / gsz; u.a = A + (size_t)u.pm * tstep; u.b = Bt + (size_t)u.pn * tstep; u.e = 0; u.cnt = 0; u.ps = 0; return true;
    }
    __device__ __forceinline__ unsigned row_off(const Unit&, int) const { return 0u; }
};
struct MoeOrder {
    const PG8_LAS int* tab; int G, vcu; const char* A; const char* Bt; size_t bstep_e, bstep_n, astep; bool gather; const int* list; int K;
    __device__ bool next(int i, Unit& u) const {
        const int L = i * G + vcu; if (L >= tab[32]) return false;
        int e = 0;
#pragma unroll 1
        for (int j = 1; j < 32; ++j) e = (L >= tab[j]) ? j : e;
        const int loc = L - tab[e]; u.e = e; u.pn = loc & 3; u.pm = loc >> 2; u.cnt = tab[128 + e]; u.ps = tab[64 + e];
        u.b = Bt + (size_t)e * bstep_e + (size_t)u.pn * bstep_n;
        u.a = gather ? A : A + (size_t)(u.ps + u.pm * BM) * astep;
        return true;
    }
    __device__ __forceinline__ unsigned row_off(const Unit& u, int r) const {
        const int s = u.pm * BM + r; const int a = (s < u.cnt) ? list[(size_t)u.e * LIST_CAP + s] : 0; return (unsigned)(a >> 1) * (unsigned)(K * 2);
    }
};

__device__ __forceinline__ unsigned cvt_pk_bf16(float lo, float hi) { unsigned r; asm volatile("v_cvt_pk_bf16_f32 %0, %1, %2" : "=v"(r) : "v"(lo), "v"(hi)); return r; }

struct EpiProj {
    static constexpr bool PERM = true;
    bf16_t* O; const float* cs; const float* sn;
    __device__ __forceinline__ void operator()(const f32x4 (&acc)[2][2][4][2], const Unit& u, int wr, int wc, int fr, int fq) const {
        const int row0 = u.pm * BM + wr * 64 + fr, colt = u.pn * BM;
        if (u.pn < 4) {
            const float sc = (u.pn < 2) ? C2Q : 1.f; const int q8 = 4 * (wc & 1) + fq;
#pragma unroll
            for (int ai = 0; ai < 2; ++ai)
#pragma unroll
                for (int m = 0; m < 4; ++m) { const int row = row0 + ai * HALF + m * 16, pos = row & (SEQ - 1);
                    const f32x4 c4 = *(const f32x4*)(cs + pos * 32 + 4 * q8) * sc, s4 = *(const f32x4*)(sn + pos * 32 + 4 * q8) * sc;
                    bf16_t* rowp = O + (size_t)row * NPROJ + colt + 64 * (wc >> 1) + 4 * q8;
#pragma unroll
                    for (int bj = 0; bj < 2; ++bj) { const f32x4 x1 = acc[ai][bj][m][0], x2 = acc[ai][bj][m][1]; const f32x4 o1 = x1 * c4 - x2 * s4, o2 = x1 * s4 + x2 * c4;
                        u32x2 w1, w2; w1.x = cvt_pk_bf16(o1[0], o1[1]); w1.y = cvt_pk_bf16(o1[2], o1[3]); w2.x = cvt_pk_bf16(o2[0], o2[1]); w2.y = cvt_pk_bf16(o2[2], o2[3]);
                        *(u32x2*)(rowp + bj * HALF) = w1; *(u32x2*)(rowp + bj * HALF + 32) = w2; } }
        } else {
            const int col0 = colt + wc * 32 + 8 * fq;
#pragma unroll
            for (int ai = 0; ai < 2; ++ai)
#pragma unroll
                for (int m = 0; m < 4; ++m) { bf16_t* rowp = O + (size_t)(row0 + ai * HALF + m * 16) * NPROJ + col0;
#pragma unroll
                    for (int bj = 0; bj < 2; ++bj) { const f32x4 v0 = acc[ai][bj][m][0], v1 = acc[ai][bj][m][1];
                        u32x4 w; w.x = cvt_pk_bf16(v0[0], v0[1]); w.y = cvt_pk_bf16(v0[2], v0[3]); w.z = cvt_pk_bf16(v1[0], v1[1]); w.w = cvt_pk_bf16(v1[2], v1[3]);
                        *(u32x4*)(rowp + bj * HALF) = w; } }
        }
    }
};
struct EpiOut {
    static constexpr bool PERM = true;
    const float* x; float* X1; bf16_t* X1B;
    __device__ __forceinline__ void operator()(const f32x4 (&acc)[2][2][4][2], const Unit& u, int wr, int wc, int fr, int fq) const {
        const int row0 = u.pm * BM + wr * 64 + fr, col0 = u.pn * BM + wc * 32 + 8 * fq;
#pragma unroll
        for (int ai = 0; ai < 2; ++ai)
#pragma unroll
            for (int m = 0; m < 4; ++m) { const size_t off = (size_t)(row0 + ai * HALF + m * 16) * D + col0;
#pragma unroll
                for (int bj = 0; bj < 2; ++bj) { const f32x4 v0 = acc[ai][bj][m][0] + *(const f32x4*)(x + off + bj * HALF), v1 = acc[ai][bj][m][1] + *(const f32x4*)(x + off + bj * HALF + 4);
                    *(f32x4*)(X1 + off + bj * HALF) = v0; *(f32x4*)(X1 + off + bj * HALF + 4) = v1;
                    u32x4 w; w.x = cvt_pk_bf16(v0[0], v0[1]); w.y = cvt_pk_bf16(v0[2], v0[3]); w.z = cvt_pk_bf16(v1[0], v1[1]); w.w = cvt_pk_bf16(v1[2], v1[3]);
                    *(u32x4*)(X1B + off + bj * HALF) = w; }
                asm volatile("" ::: "memory"); }
    }
};
struct EpiUp {
    static constexpr bool PERM = true;
    bf16_t* HD; const float* rstd; const int* list;
    __device__ __forceinline__ void operator()(const f32x4 (&acc)[2][2][4][2], const Unit& u, int wr, int wc, int fr, int fq) const {
        const int r0 = u.pm * BM + wr * 64 + fr, col0 = u.pn * HALF + wc * 32 + 8 * fq;
#pragma unroll
        for (int ai = 0; ai < 2; ++ai)
#pragma unroll
            for (int m = 0; m < 4; ++m) { const int s = r0 + ai * HALF + m * 16; if (s < u.cnt) { const float rs = rstd[list[(size_t)u.e * LIST_CAP + s] >> 1];
                    float h[8];
#pragma unroll
                    for (int n = 0; n < 2; ++n)
#pragma unroll
                        for (int i = 0; i < 4; ++i) { const float a = acc[ai][0][m][n][i] * rs, b = acc[ai][1][m][n][i] * rs; h[4 * n + i] = a * b / (1.f + __expf(-a)); }
                    u32x4 w; w.x = cvt_pk_bf16(h[0], h[1]); w.y = cvt_pk_bf16(h[2], h[3]); w.z = cvt_pk_bf16(h[4], h[5]); w.w = cvt_pk_bf16(h[6], h[7]);
                    *(u32x4*)(HD + (size_t)(u.ps + s) * DE + col0) = w; } }
    }
};
struct EpiDown {
    static constexpr bool PERM = true;
    bf16_t* Y; const float* tokw; const int* list;
    __device__ __forceinline__ void operator()(const f32x4 (&acc)[2][2][4][2], const Unit& u, int wr, int wc, int fr, int fq) const {
        const int r0 = u.pm * BM + wr * 64 + fr, col0 = u.pn * BM + wc * 32 + 8 * fq;
#pragma unroll
        for (int ai = 0; ai < 2; ++ai)
#pragma unroll
            for (int m = 0; m < 4; ++m) { const int s = r0 + ai * HALF + m * 16; if (s < u.cnt) { const int a = list[(size_t)u.e * LIST_CAP + s]; const float w8 = tokw[a];
                    bf16_t* rowp = Y + (size_t)a * D + col0;
#pragma unroll
                    for (int bj = 0; bj < 2; ++bj) { const f32x4 v0 = acc[ai][bj][m][0] * w8, v1 = acc[ai][bj][m][1] * w8;
                        u32x4 w; w.x = cvt_pk_bf16(v0[0], v0[1]); w.y = cvt_pk_bf16(v0[2], v0[3]); w.z = cvt_pk_bf16(v1[0], v1[1]); w.w = cvt_pk_bf16(v1[2], v1[3]);
                        *(u32x4*)(rowp + bj * HALF) = w; } } }
    }
};

template <class Epi, class Sched, bool ALIGN_EPI, bool GATHER>
__device__ __forceinline__ void gemm_phase(PG8_LAS unsigned char* lds, const int K, const Sched& S, const Epi& E) {
    const int tid = threadIdx.x, wid = __builtin_amdgcn_readfirstlane(tid >> 6), lane = tid & 63, wr = wid >> 2, wc = wid & 3, fr = lane & 15, fq = lane >> 4;
    const int nt = K / BK;
    unsigned voffB[2], ga[2][2], gn[2][2]; int RA[2], CA[2];
#pragma unroll
    for (int i = 0; i < 2; ++i) { int R, C; stage_rc(tid * 16 + i * 8192, R, C); const int Rb = Epi::PERM ? ((R & ~31) + perm32(R & 31)) : R;
        RA[i] = R; CA[i] = C; voffB[i] = (unsigned)(Rb * K + C) * 2u; }
    const size_t kstep = (size_t)(BK * 2);
    const size_t hstep = (size_t)HALF * K * 2;
    const unsigned ldsw = (unsigned)wid * 1024u;
    const int aoff = lds_byte(wr * 64 + fr, fq * 8), boff = lds_byte(wc * 32 + fr, fq * 8);
#define PG8_SA(b, h) (((b) * 2 + (h)) * HTB)
#define PG8_SB(b, h) ((4 + (b) * 2 + (h)) * HTB)
#define PG8_STAGE(bufoff, gbase, voff) do { _Pragma("unroll") for (int _i = 0; _i < 2; ++_i) \
        __builtin_amdgcn_global_load_lds((const unsigned*)((const char*)(gbase) + (voff)[_i]), (PG8_LAS unsigned*)(lds + (bufoff) + ldsw + _i * 8192), 16, 0, 0); } while (0)
#define PG8_LDA(dst, b, h) do { _Pragma("unroll") for (int m = 0; m < 4; ++m) _Pragma("unroll") for (int k = 0; k < 2; ++k) dst[m][k] = *(const PG8_LAS bf16x8*)(lds + PG8_SA(b, h) + aoff + m * 2048 + k * 1024); } while (0)
#define PG8_LDB(dst, b, h) do { _Pragma("unroll") for (int n = 0; n < 2; ++n) _Pragma("unroll") for (int k = 0; k < 2; ++k) dst[n][k] = *(const PG8_LAS bf16x8*)(lds + PG8_SB(b, h) + boff + n * 2048 + k * 1024); } while (0)
#define PG8_MMA(ai, bj, At, Bt) do { __builtin_amdgcn_s_setprio(1); _Pragma("unroll") for (int m = 0; m < 4; ++m) _Pragma("unroll") for (int n = 0; n < 2; ++n) _Pragma("unroll") for (int k = 0; k < 2; ++k) \
        acc[ai][bj][m][n] = __builtin_amdgcn_mfma_f32_16x16x32_bf16(Bt[n][k], At[m][k], acc[ai][bj][m][n], 0, 0, 0); __builtin_amdgcn_s_setprio(0); } while (0)
#define PG8_WAIT_V(n) asm volatile("s_waitcnt vmcnt(" #n ")" ::: "memory")
#define PG8_WAIT_L(n) asm volatile("s_waitcnt lgkmcnt(" #n ")" ::: "memory")
#define PG8_BAR __builtin_amdgcn_s_barrier()
#define PG8_SCHED __builtin_amdgcn_sched_barrier(0)
    Unit cur, nxt; int ui = 0;
    if (!S.next(0, cur)) return;
#pragma unroll
    for (int h = 0; h < 2; ++h)
#pragma unroll
        for (int i = 0; i < 2; ++i) { ga[h][i] = (GATHER ? S.row_off(cur, h * HALF + RA[i]) : (unsigned)((h * HALF + RA[i]) * K) * 2u) + (unsigned)CA[i] * 2u; gn[h][i] = ga[h][i]; }
    f32x4 acc[2][2][4][2];
#pragma unroll
    for (int a = 0; a < 2; ++a)
#pragma unroll
        for (int b = 0; b < 2; ++b)
#pragma unroll
            for (int m = 0; m < 4; ++m)
#pragma unroll
                for (int n = 0; n < 2; ++n) acc[a][b][m][n] = (f32x4){0.f, 0.f, 0.f, 0.f};
    bf16x8 At[4][2], B0[2][2], B1[2][2];
    const char* cA = cur.a; const char* cB = cur.b;
    PG8_STAGE(PG8_SB(0, 0), cB, voffB); PG8_STAGE(PG8_SB(0, 1), cB + hstep, voffB); PG8_STAGE(PG8_SA(0, 0), cA, ga[0]); PG8_STAGE(PG8_SA(0, 1), cA, ga[1]);
    if (wr == 1) PG8_BAR;
    PG8_WAIT_V(2); PG8_BAR;
    PG8_STAGE(PG8_SB(1, 0), cB + kstep, voffB); PG8_STAGE(PG8_SA(1, 0), cA + kstep, ga[0]); PG8_STAGE(PG8_SB(1, 1), cB + hstep + kstep, voffB);
    PG8_WAIT_V(6); PG8_BAR;
    for (;;) {
        const bool has_next = S.next(ui + 1, nxt);
        const char* nA = has_next ? nxt.a : cA; const char* nB = has_next ? nxt.b : cB;
        if (GATHER && has_next) {
#pragma unroll
            for (int h = 0; h < 2; ++h)
#pragma unroll
                for (int i = 0; i < 2; ++i) gn[h][i] = S.row_off(nxt, h * HALF + RA[i]) + (unsigned)CA[i] * 2u;
        }
        for (int t = 0; t < nt; t += 2) {
            const bool last = (t == nt - 2);
            const char* a1 = cA + (size_t)(t + 1) * kstep;
            const char* a2 = last ? nA : cA + (size_t)(t + 2) * kstep; const char* b2 = last ? nB : cB + (size_t)(t + 2) * kstep;
            const char* a3 = a2 + kstep; const char* b3 = b2 + kstep;
            unsigned g2[2][2];
#pragma unroll
            for (int h = 0; h < 2; ++h)
#pragma unroll
                for (int i = 0; i < 2; ++i) g2[h][i] = (GATHER && last) ? gn[h][i] : ga[h][i];
            PG8_LDB(B0, 0, 0); PG8_LDB(B1, 0, 1); PG8_SCHED; PG8_LDA(At, 0, 0); PG8_STAGE(PG8_SA(1, 1), a1, ga[1]);
            PG8_WAIT_V(8); PG8_WAIT_L(0); PG8_BAR; PG8_MMA(0, 0, At, B0); PG8_MMA(0, 1, At, B1); PG8_BAR; PG8_SCHED;
            PG8_LDA(At, 0, 1); PG8_STAGE(PG8_SB(0, 0), b2, voffB); PG8_STAGE(PG8_SB(0, 1), b2 + hstep, voffB); PG8_STAGE(PG8_SA(0, 0), a2, g2[0]);
            PG8_WAIT_V(8); PG8_WAIT_L(0); PG8_BAR; PG8_MMA(1, 0, At, B0); PG8_MMA(1, 1, At, B1); PG8_BAR; PG8_SCHED;
            PG8_LDB(B0, 1, 0); PG8_LDB(B1, 1, 1); PG8_SCHED; PG8_LDA(At, 1, 0); PG8_STAGE(PG8_SA(0, 1), a2, g2[1]);
            PG8_WAIT_V(8); PG8_WAIT_L(0); PG8_BAR; PG8_MMA(0, 0, At, B0); PG8_MMA(0, 1, At, B1); PG8_BAR; PG8_SCHED;
            PG8_LDA(At, 1, 1); PG8_STAGE(PG8_SB(1, 0), b3, voffB); PG8_STAGE(PG8_SB(1, 1), b3 + hstep, voffB); PG8_STAGE(PG8_SA(1, 0), a3, g2[0]);
            PG8_WAIT_V(8); PG8_WAIT_L(0); PG8_BAR; PG8_MMA(1, 0, At, B0); PG8_MMA(1, 1, At, B1); PG8_BAR; PG8_SCHED;
        }
        if constexpr (ALIGN_EPI) { if (wr == 0) PG8_BAR; }
        E(acc, cur, wr, wc, fr, fq);
        if (!has_next) break;
#pragma unroll
        for (int a = 0; a < 2; ++a)
#pragma unroll
            for (int b = 0; b < 2; ++b)
#pragma unroll
                for (int m = 0; m < 4; ++m)
#pragma unroll
                    for (int n = 0; n < 2; ++n) acc[a][b][m][n] = (f32x4){0.f, 0.f, 0.f, 0.f};
        cur = nxt; cA = nA; cB = nB; ++ui;
#pragma unroll
        for (int h = 0; h < 2; ++h)
#pragma unroll
            for (int i = 0; i < 2; ++i) ga[h][i] = gn[h][i];
        if constexpr (ALIGN_EPI) { if (wr == 1) PG8_BAR; }
    }
    PG8_WAIT_V(0);
    if constexpr (!ALIGN_EPI) { if (wr == 0) PG8_BAR; }
    PG8_BAR;
#undef PG8_SA
#undef PG8_SB
#undef PG8_STAGE
#undef PG8_LDA
#undef PG8_LDB
#undef PG8_MMA
#undef PG8_WAIT_V
#undef PG8_WAIT_L
#undef PG8_BAR
#undef PG8_SCHED
}
}

constexpr int NWAVES = 8;
constexpr int RING_OFF = 0, RING_BYTES = 131072;
constexpr int LDSCTL_OFF = RING_BYTES;
constexpr int MISC_OFF = LDSCTL_OFF + 64;
constexpr int TAB_OFF = LDSCTL_OFF + 256;
constexpr int LDS_BYTES = RING_BYTES + 2048;

#define GAS __attribute__((address_space(1)))
typedef GAS unsigned gu32;
#define RLX_AGENT __ATOMIC_RELAXED, __HIP_MEMORY_SCOPE_AGENT
#define LDS_WAIT() asm volatile("s_waitcnt lgkmcnt(0)" ::: "memory")
#define VM_WAIT() asm volatile("s_waitcnt vmcnt(0)" ::: "memory")

#define XB_TMO      128
#define XB_XCNT(j)  (256  + 64 * (j))
#define XB_XSUB(j)  (1280 + 64 * (j))
#define XB_XGEN(j)  (2304 + 64 * (j))
#define XB_TOP      3328
#define XB_TOPGEN   3392
#define XCD_BAR_WORDS 3456
#define XB_SPIN_CAP (1u << 18)

__device__ __forceinline__ unsigned xb_ld(unsigned* p)              { return __hip_atomic_load(p, __ATOMIC_RELAXED, __HIP_MEMORY_SCOPE_AGENT); }
__device__ __forceinline__ unsigned xb_add(unsigned* p, unsigned v) { return __hip_atomic_fetch_add(p, v, __ATOMIC_RELAXED, __HIP_MEMORY_SCOPE_AGENT); }
__device__ __forceinline__ unsigned xb_xcc_id() { return (unsigned)__builtin_amdgcn_s_getreg((3 << 11) | 20) & 0xFu; }
#define XB_SPIN(cond, bar) do { unsigned _sp = 0; while (cond) { __builtin_amdgcn_s_sleep(1); \
    if ((++_sp & 255u) == 0u) { if (xb_ld(&(bar)[XB_TMO])) break; if (_sp > XB_SPIN_CAP) { atomicAdd(&(bar)[XB_TMO], 1u); break; } } } } while (0)

struct XcdBarrier { unsigned* bar; unsigned x; volatile LAS unsigned* st; };

__device__ __forceinline__ XcdBarrier xcd_barrier_post(unsigned* bar, volatile LAS unsigned* st) {
    XcdBarrier b; b.bar = bar; b.x = xb_xcc_id(); b.st = st;
    if (threadIdx.x == 0) (void)xb_add(&bar[XB_XCNT(b.x)], 1u);
    return b;
}
__device__ __forceinline__ void xcd_barrier_complete(unsigned* bar, unsigned x, unsigned& nloc, unsigned& nx) {
    const unsigned G = gridDim.x * gridDim.y * gridDim.z;
    unsigned sum, cnt, mine, sp = 0u;
    for (;;) {
        sum = 0u; cnt = 0u; mine = 0u;
#pragma unroll
        for (unsigned j = 0; j < 16; ++j) { const unsigned c = xb_ld(&bar[XB_XCNT(j)]); sum += c; cnt += (c > 0u) ? 1u : 0u; mine = (j == x) ? c : mine; }
        if (sum == G) break;
        __builtin_amdgcn_s_sleep(1);
        if ((++sp & 255u) == 0u) { if (xb_ld(&bar[XB_TMO])) break; if (sp > XB_SPIN_CAP) { atomicAdd(&bar[XB_TMO], 1u); break; } }
    }
    nloc = mine > 0u ? mine : 1u; nx = cnt > 0u ? cnt : 1u;
}
__device__ __forceinline__ void xcd_barrier(const XcdBarrier& b) {
    asm volatile("s_waitcnt vmcnt(0)" ::: "memory");
    __syncthreads();
    if (threadIdx.x == 0) {
        unsigned* bar = b.bar;
        __builtin_amdgcn_s_waitcnt(0);
        unsigned nloc = b.st[0], nx = b.st[1];
        if (nloc == 0u) { xcd_barrier_complete(bar, b.x, nloc, nx); b.st[0] = nloc; b.st[1] = nx; }
        const unsigned old = xb_add(&bar[XB_XSUB(b.x)], 1u);
        const unsigned gen = old / nloc;
        if (old + 1u == (gen + 1u) * nloc) {
            __builtin_amdgcn_fence(__ATOMIC_RELEASE, "agent");
            asm volatile("s_waitcnt vmcnt(0)" ::: "memory");
            const unsigned og = xb_add(&bar[XB_TOP], 1u);
            const unsigned tg = og / nx;
            if (og + 1u == (tg + 1u) * nx) xb_add(&bar[XB_TOPGEN], 1u);
            else XB_SPIN(xb_ld(&bar[XB_TOPGEN]) == tg, bar);
            __builtin_amdgcn_fence(__ATOMIC_ACQUIRE, "agent");
            xb_add(&bar[XB_XGEN(b.x)], 1u);
            asm volatile("s_waitcnt vmcnt(0)" ::: "memory");
        } else {
            XB_SPIN(xb_ld(&bar[XB_XGEN(b.x)]) == gen, bar);
            __builtin_amdgcn_fence(__ATOMIC_ACQUIRE, "agent");
            asm volatile("s_waitcnt vmcnt(0)" ::: "memory");
        }
    }
    __syncthreads();
}

struct Frame {
    LAS unsigned char* lds;
    unsigned* ctl;
    int tid, lane, wave, vcu, G;
    Ptrs p;
};

__device__ __forceinline__ void p0_prologue(Frame& F) {
    const Ptrs& p = F.p; const int tid = F.tid, lane = F.lane, wave = F.wave;
    LAS float* scr = (LAS float*)(F.lds + RING_OFF) + wave * 64 * 33;
    LAS float* gw = (LAS float*)(F.lds + RING_OFF + 8 * 64 * 33 * 4);
    const int gw_id = F.vcu * NWAVES + wave, NGW = F.G * NWAVES;
    bf16_t* WIN = (bf16_t*)(p.ws + WS_WIN); bf16_t* WOUT = (bf16_t*)(p.ws + WS_WOUT); bf16_t* W13 = (bf16_t*)(p.ws + WS_W13); bf16_t* W2 = (bf16_t*)(p.ws + WS_W2);
    for (int i = tid; i < 1024 * 8; i += NWAVES * 64) gw[i] = p.w_in[(size_t)(i >> 3) * DIN + C_IG + (i & 7)];
    __syncthreads();
    constexpr int I_IN = 16 * 112, I_OUT = 16 * 32, I_13 = 16 * 16 * 32, I_2 = 8 * 32 * 32;
    constexpr int NITEMS = I_IN + I_OUT + 2 * I_13 + I_2;
    for (int it = gw_id; it < NITEMS; it += NGW) {
        int r = it;
        if (r < I_IN) { const int kb = r / 112, nb = r % 112; transpose_item(p.w_in, DIN, WIN, 1024, 64 * kb, 32 * nb, MapRope(), nullptr, scr, lane); continue; } r -= I_IN;
        if (r < I_OUT) { const int kb = r / 32, nb = r % 32; transpose_item(p.w_out, 1024, WOUT, 1024, 64 * kb, 32 * nb, MapId(), nullptr, scr, lane); continue; } r -= I_OUT;
        if (r < I_13) { const int e = r / 256, q = r % 256, kb = q / 16, nb = q % 16; transpose_item(p.w1 + (size_t)e * 1024 * 512, 512, W13 + (size_t)e * 1024 * 1024, 1024, 64 * kb, 32 * nb, MapW1(), p.g_ffn, scr, lane); continue; } r -= I_13;
        if (r < I_13) { const int e = r / 256, q = r % 256, kb = q / 16, nb = q % 16; transpose_item(p.w3 + (size_t)e * 1024 * 512, 512, W13 + (size_t)e * 1024 * 1024, 1024, 64 * kb, 32 * nb, MapW3(), p.g_ffn, scr, lane); continue; } r -= I_13;
        { const int e = r / 256, q = r % 256, kb = q / 32, nb = q % 32; transpose_item(p.w2 + (size_t)e * 512 * 1024, 1024, W2 + (size_t)e * 1024 * 512, 512, 64 * kb, 32 * nb, MapId(), nullptr, scr, lane); }
    }
    { float* cs = (float*)(p.ws + WS_ROPE); float* sn = cs + 2048 * 32;
      for (int i = blockIdx.x * 512 + tid; i < 2048 * 32; i += F.G * 512) { const int pos = i >> 5, j = i & 31;
          const float inv = 1.0f / exp2f((float)(2 * j) * (1.f / 64.f) * 13.287712379549449f);
          const float ang = (float)pos * inv; const double rev = (double)ang * 0.15915494309189535; const float fr = (float)(rev - rint(rev));
          cs[i] = __builtin_amdgcn_cosf(fr); sn[i] = __builtin_amdgcn_sinf(fr); } }
    bf16_t* HB = (bf16_t*)(p.ws + WS_HB); float* GATES = (float*)(p.ws + WS_GATES);
    for (int m = gw_id; m < T; m += NGW) {
        const f32x4* xr = (const f32x4*)(p.x + (size_t)m * D) + lane; const f32x4* gr = (const f32x4*)p.g_mix + lane;
        f32x4 v[4]; float s = 0.f;
#pragma unroll
        for (int j = 0; j < 4; ++j) { v[j] = xr[64 * j]; s += (v[j].x * v[j].x + v[j].y * v[j].y) + (v[j].z * v[j].z + v[j].w * v[j].w); }
        const float rstd = 1.f / sqrtf(wave_sum(s) * (1.f / D) + RMS_EPS);
        float ga[8];
#pragma unroll
        for (int e = 0; e < 8; ++e) ga[e] = 0.f;
        unsigned long long* o8 = (unsigned long long*)(HB + (size_t)m * D) + lane;
#pragma unroll
        for (int j = 0; j < 4; ++j) { const f32x4 g = gr[64 * j]; f32x4 h = v[j] * rstd * g;
            o8[64 * j] = (unsigned long long)pk2(h.x, h.y) | ((unsigned long long)pk2(h.z, h.w) << 32);
            const int k0 = 256 * j + 4 * lane;
#pragma unroll
            for (int q = 0; q < 4; ++q) { const float hv = h[q]; const LAS float* w = gw + (k0 + q) * 8;
#pragma unroll
                for (int e = 0; e < 8; ++e) ga[e] += hv * w[e]; } }
#pragma unroll
        for (int e = 0; e < 8; ++e) ga[e] = wave_sum(ga[e]);
        if (lane < 8) { float gv = 0.f;
#pragma unroll
            for (int e = 0; e < 8; ++e) gv = (lane == e) ? ga[e] : gv;
            gv += p.gate_b[lane];
            if (lane >= 4) gv = fminf(gv, 0.f) - log1pf(__expf(-fabsf(gv)));
            GATES[(size_t)m * 8 + lane] = gv; }
    }
}

__device__ __forceinline__ void attn_ref_body(Frame& F) {
    const bf16_t* PROJ = (const bf16_t*)(F.p.ws + WS_PROJ); float* OC = F.p.out;
    for (int idx = blockIdx.x * 512 + F.tid; idx < BATCH * 4 * 2 * SEQ; idx += F.G * 512) {
        const int q = idx & (SEQ - 1), c = (idx >> 11) & 1, h = (idx >> 12) & 3, b = idx >> 14;
        const int qmax = __builtin_amdgcn_readfirstlane(q | 63);
        const size_t rowb = (size_t)b * SEQ;
        float qv[64];
        { const bf16_t* qp = PROJ + (rowb + q) * NPROJ + C_QA + h * 128 + c * 64;
#pragma unroll
          for (int d = 0; d < 64; ++d) qv[d] = bf2f(qp[d]); }
        float o[128];
#pragma unroll
        for (int d = 0; d < 128; ++d) o[d] = 0.f;
        float m = -INFINITY, l = 0.f;
        for (int j = 0; j <= qmax; ++j) {
            const bf16_t* kp = PROJ + (rowb + j) * NPROJ + C_KA + h * 128 + c * 64; const bf16_t* vp = PROJ + (rowb + j) * NPROJ + C_VA + h * 128;
            float s = 0.f;
#pragma unroll
            for (int d = 0; d < 64; ++d) s += qv[d] * bf2f(kp[d]);
            if (j <= q) { const float mn = fmaxf(m, s), sc = exp2f(m - mn), pr = exp2f(s - mn); l = l * sc + pr; m = mn;
#pragma unroll
                for (int d = 0; d < 128; ++d) o[d] = o[d] * sc + pr * bf2f(vp[d]); }
        }
        const float rl = 1.f / l; float* op = OC + ((size_t)c * T + rowb + q) * 512 + h * 128;
#pragma unroll
        for (int d = 0; d < 128; ++d) op[d] = o[d] * rl;
    }
}
__device__ __forceinline__ void attn_combine_body(Frame& F) {
    const float* OC = F.p.out; bf16_t* MIX = (bf16_t*)(F.p.ws + WS_MIX); const float* lam_qk = F.p.lam_qk; const int lane = F.lane;
    const float lam = __expf(wave_sum(lam_qk[lane] * lam_qk[64 + lane])) - __expf(wave_sum(lam_qk[128 + lane] * lam_qk[192 + lane])) + LAMBDA_INIT;
    for (int w = F.vcu * NWAVES + F.wave; w < T * 4; w += F.G * NWAVES) { const int row = w >> 2, h = w & 3;
        const float* o1 = OC + (size_t)row * 512 + h * 128; const float* o2 = OC + ((size_t)T + row) * 512 + h * 128;
        const float v0 = o1[lane] - lam * o2[lane], v1 = o1[lane + 64] - lam * o2[lane + 64];
        const float rs = 1.f / sqrtf(wave_sum(v0 * v0 + v1 * v1) * (1.f / 128.f) + RMS_EPS) * (1.f - LAMBDA_INIT);
        bf16_t* o = MIX + (size_t)row * D + h * 128;
        o[lane] = (bf16_t)f2bf(v0 * rs * F.p.subln_g[lane]); o[lane + 64] = (bf16_t)f2bf(v1 * rs * F.p.subln_g[lane + 64]); }
}
__device__ __forceinline__ void mlstm_ref_body(Frame& F, int bh) {
    const bf16_t* PROJ = (const bf16_t*)(F.p.ws + WS_PROJ); const float* GATES = (const float*)(F.p.ws + WS_GATES); bf16_t* MIX = (bf16_t*)(F.p.ws + WS_MIX);
    LAS float* sq = (LAS float*)(F.lds + RING_OFF); LAS float* sk = sq + 128; LAS float* sv = sk + 128; LAS float* so = sv + 128; LAS float* sh = so + 128;
    const int tid = F.tid, v = tid >> 2, kg = tid & 3; const int b = bh >> 2, h = bh & 3;
    float C[32], n[32];
#pragma unroll
    for (int i = 0; i < 32; ++i) { C[i] = 0.f; n[i] = 0.f; }
    float m = 0.f;
    for (int t = 0; t < SEQ; ++t) {
        const size_t row = (size_t)b * SEQ + t;
        if (tid < 256) { const int cc = (tid < 128) ? h * 128 + tid : 512 + h * 128 + (tid - 128);
            float y = F.p.conv_b[cc];
#pragma unroll
            for (int j = 0; j < 4; ++j) { const int tt = t - 3 + j; if (tt >= 0) y += F.p.conv_w[j * 1024 + cc] * bf2f(PROJ[((size_t)b * SEQ + tt) * NPROJ + C_QM + cc]); }
            const float sl = y * sigmoidf_(y);
            if (tid < 128) sq[tid] = sl; else sk[tid - 128] = sl * 0.08838834764831845f; }
        else if (tid < 384) sv[tid - 256] = bf2f(PROJ[row * NPROJ + C_VM + h * 128 + (tid - 256)]);
        else so[tid - 384] = bf2f(PROJ[row * NPROJ + C_OM + h * 128 + (tid - 384)]);
        __syncthreads();
        const float li = GATES[row * 8 + h], lf = GATES[row * 8 + 4 + h];
        const float mn = fmaxf(lf + m, li), fd = __expf(lf + m - mn), ii = __expf(li - mn);
        float pn = 0.f, pd = 0.f; const float vv = sv[v] * ii;
#pragma unroll
        for (int i = 0; i < 32; ++i) { const float kk = sk[kg * 32 + i], qq = sq[kg * 32 + i]; C[i] = fd * C[i] + vv * kk; n[i] = fd * n[i] + ii * kk; pn += C[i] * qq; pd += n[i] * qq; }
        pn += __shfl_xor(pn, 1); pn += __shfl_xor(pn, 2);
        pd += __shfl_xor(pd, 1); pd += __shfl_xor(pd, 2);
        const float hv = pn / fmaxf(fabsf(pd), __expf(-mn));
        if (kg == 0) sh[v] = hv * sigmoidf_(so[v]);
        m = mn;
        __syncthreads();
        if (tid < 128) { float ss = 0.f;
            for (int i = 0; i < 128; ++i) ss += sh[i] * sh[i];
            MIX[row * D + 512 + h * 128 + tid] = (bf16_t)f2bf(sh[tid] * (1.f / sqrtf(ss * (1.f / 128.f) + RMS_EPS)) * F.p.mhnorm_g[h * 128 + tid]); }
        __syncthreads();
    }
}

__device__ __forceinline__ void router_ref_body(Frame& F) {
    const Ptrs& p = F.p; const int lane = F.lane;
    const float* X1 = p.out; unsigned* ctl = F.ctl; int* list = (int*)(p.ws + WS_LIST); float* tokw = (float*)(p.ws + WS_TOKW); float* rstd_o = (float*)(p.ws + WS_RSTD);
    for (int tok = F.vcu * NWAVES + F.wave; tok < T; tok += F.G * NWAVES) {
        float hv[16]; float s = 0.f;
#pragma unroll
        for (int j = 0; j < 4; ++j) { const f32x4 v = ((const f32x4*)(X1 + (size_t)tok * D))[lane + 64 * j]; hv[4 * j] = v.x; hv[4 * j + 1] = v.y; hv[4 * j + 2] = v.z; hv[4 * j + 3] = v.w; s += (v.x * v.x + v.y * v.y) + (v.z * v.z + v.w * v.w); }
        const float rstd = 1.f / sqrtf(wave_sum(s) * (1.f / D) + RMS_EPS);
#pragma unroll
        for (int j = 0; j < 4; ++j)
#pragma unroll
            for (int q = 0; q < 4; ++q) hv[4 * j + q] *= rstd * p.g_ffn[256 * j + 4 * lane + q];
        float gl[4];
#pragma unroll
        for (int g = 0; g < 4; ++g) { float a = 0.f;
#pragma unroll
            for (int j = 0; j < 4; ++j)
#pragma unroll
                for (int q = 0; q < 4; ++q) a += hv[4 * j + q] * p.w_grp[(size_t)(256 * j + 4 * lane + q) * 4 + g];
            gl[g] = wave_sum(a) + p.b_grp[g]; }
        int gs = 0; float gm = gl[0];
#pragma unroll
        for (int g = 1; g < 4; ++g) if (gl[g] > gm) { gm = gl[g]; gs = g; }
        float gsum = 0.f;
#pragma unroll
        for (int g = 0; g < 4; ++g) gsum += __expf(gl[g] - gm);
        const float gwt = 1.f / gsum;
        float el[8];
#pragma unroll
        for (int e = 0; e < 8; ++e) { float a = 0.f;
#pragma unroll
            for (int j = 0; j < 4; ++j)
#pragma unroll
                for (int q = 0; q < 4; ++q) a += hv[4 * j + q] * p.w_er[((size_t)gs * 1024 + 256 * j + 4 * lane + q) * 8 + e];
            el[e] = wave_sum(a) + p.b_er[gs * 8 + e]; }
        int i0 = 0; float v0 = el[0];
#pragma unroll
        for (int e = 1; e < 8; ++e) if (el[e] > v0) { v0 = el[e]; i0 = e; }
        int i1 = -1; float v1 = -INFINITY;
#pragma unroll
        for (int e = 0; e < 8; ++e) if (e != i0 && el[e] > v1) { v1 = el[e]; i1 = e; }
        const float e1 = __expf(v1 - v0), w0 = gwt / (1.f + e1), w1 = gwt * e1 / (1.f + e1);
        if (lane == 0) {
            const int ea = gs * 8 + i0, eb = gs * 8 + i1;
            const unsigned sa = atomicAdd(&ctl[CW_CNT + 64 * ea], 1u); list[(size_t)ea * LIST_CAP + sa] = tok * 2;
            const unsigned sb = atomicAdd(&ctl[CW_CNT + 64 * eb], 1u); list[(size_t)eb * LIST_CAP + sb] = tok * 2 + 1;
            tokw[tok * 2] = w0; tokw[tok * 2 + 1] = w1; rstd_o[tok] = rstd; }
    }
}
__device__ __forceinline__ void final_body(Frame& F) {
    const Ptrs& p = F.p; const int lane = F.lane; float* X1 = p.out; const bf16_t* Y = (const bf16_t*)(p.ws + WS_Y);
    for (size_t tok = F.vcu * NWAVES + F.wave; tok < T; tok += F.G * NWAVES) {
        f32x4 v[4]; float s = 0.f;
#pragma unroll
        for (int j = 0; j < 4; ++j) { v[j] = ((const f32x4*)(X1 + tok * D))[lane + 64 * j];
            const u32x2 a = ((const u32x2*)(Y + (2 * tok) * D))[lane + 64 * j], b = ((const u32x2*)(Y + (2 * tok + 1) * D))[lane + 64 * j];
            v[j].x += bf2f(a.x & 0xffffu) + bf2f(b.x & 0xffffu); v[j].y += bf2f(a.x >> 16) + bf2f(b.x >> 16); v[j].z += bf2f(a.y & 0xffffu) + bf2f(b.y & 0xffffu); v[j].w += bf2f(a.y >> 16) + bf2f(b.y >> 16);
            s += (v[j].x * v[j].x + v[j].y * v[j].y) + (v[j].z * v[j].z + v[j].w * v[j].w); }
        const float rstd = 1.f / sqrtf(wave_sum(s) * (1.f / D) + RMS_EPS);
#pragma unroll
        for (int j = 0; j < 4; ++j) { const f32x4 g = ((const f32x4*)p.g_final)[lane + 64 * j]; ((f32x4*)(X1 + tok * D))[lane + 64 * j] = v[j] * rstd * g; }
    }
}
__device__ __forceinline__ void moe_tables(Frame& F) {
    LAS int* tab = (LAS int*)(F.lds + TAB_OFF);
    if (F.tid == 0) { int us = 0, ps = 0;
        for (int e = 0; e < NE; ++e) { const int c = (int)__hip_atomic_load(F.ctl + CW_CNT + 64 * e, RLX_AGENT); const int nb = (c + 255) >> 8;
            tab[e] = us; tab[64 + e] = ps; tab[128 + e] = c; us += nb * 4; ps += nb * 256; }
        tab[32] = us; tab[96] = ps; }
    __syncthreads();
}


namespace att {
typedef float f32x16 __attribute__((ext_vector_type(16)));
typedef short s16x4 __attribute__((ext_vector_type(4)));
constexpr int STAGE = 32768, VOFF = 16384, XCH_OFF = 65536;
constexpr int ROWB = NPROJ * 2;
__device__ __forceinline__ int crow(int r, int hi) { return (r & 3) + 8 * (r >> 2) + 4 * hi; }
__device__ __forceinline__ unsigned swz(unsigned row) { return ((row & 3u) << 2) | ((row >> 2) & 3u); }
__device__ __forceinline__ s16x4 trrd(const LAS unsigned char* p) { return __builtin_bit_cast(s16x4, __builtin_amdgcn_ds_read_tr16_b64_v4i16((LAS s16x4*)p)); }

__device__ __forceinline__ void attn_unit(Frame& F, int bh, int qb, float lam) {
    LAS unsigned char* lds = F.lds + RING_OFF;
    const int lane = F.lane, wid = F.wave, c = wid >> 2, wq = wid & 3, r32 = lane & 31, hi = lane >> 5;
    const int b = bh >> 2, h = bh & 3, q0 = qb * 128, qlo = q0 + 32 * wq;
    const char* projb = (const char*)(F.p.ws + WS_PROJ) + (size_t)(b * SEQ) * ROWB;
    const char* kg = projb + (C_KA + h * 128) * 2; const char* vg = projb + (C_VA + h * 128) * 2;
    unsigned srcoff[2];
#pragma unroll
    for (int n = 0; n < 2; ++n) { const unsigned row = 4u * (wid + 8 * n) + (lane >> 4), slot = lane & 15; srcoff[n] = row * ROWB + ((slot ^ swz(row)) << 4); }
#define ATT_DMA(t, st) do { _Pragma("unroll") for (int _n = 0; _n < 2; ++_n) { \
        __builtin_amdgcn_global_load_lds((const unsigned*)(kg + (size_t)(t) * 64 * ROWB + srcoff[_n]), (LAS unsigned*)(lds + (st) * STAGE + (wid + 8 * _n) * 1024), 16, 0, 0); \
        __builtin_amdgcn_global_load_lds((const unsigned*)(vg + (size_t)(t) * 64 * ROWB + srcoff[_n]), (LAS unsigned*)(lds + (st) * STAGE + VOFF + (wid + 8 * _n) * 1024), 16, 0, 0); } } while (0)
    bf16x8 qf[4];
    { const bf16_t* qp = (const bf16_t*)(projb + (size_t)(qlo + r32) * ROWB) + C_QA + h * 128 + c * 64 + 8 * hi;
#pragma unroll
      for (int s = 0; s < 4; ++s) qf[s] = *(const bf16x8*)(qp + 16 * s); }
    unsigned kaddr[4], vaddr[2][4];
#pragma unroll
    for (int s = 0; s < 4; ++s) kaddr[s] = 256u * r32 + 16u * ((unsigned)(8 * c + 2 * s + hi) ^ swz(r32));
    { const unsigned blk = (lane >> 4) & 1, q = (lane & 15) >> 2, p = lane & 3;
#pragma unroll
      for (int t2 = 0; t2 < 2; ++t2)
#pragma unroll
          for (int dt = 0; dt < 4; ++dt) { const unsigned row = 8u * t2 + 4u * hi + q; vaddr[t2][dt] = 256u * row + 16u * ((4u * dt + 2u * blk + (p >> 1)) ^ swz(row)) + 8u * (p & 1); } }
    f32x16 o[4];
#pragma unroll
    for (int dt = 0; dt < 4; ++dt)
#pragma unroll
        for (int r = 0; r < 16; ++r) o[dt][r] = 0.f;
    float m = -INFINITY, l = 0.f;
    const int NT = 2 * qb + 2;
    ATT_DMA(0, 0);
    for (int t = 0; t < NT; ++t) {
        asm volatile("s_waitcnt vmcnt(0)" ::: "memory"); __builtin_amdgcn_s_barrier(); asm volatile("" ::: "memory");
        if (t + 1 < NT) ATT_DMA(t + 1, (t + 1) & 1);
        if (64 * t <= qlo + 31) {
            const LAS unsigned char* kb = lds + (t & 1) * STAGE; const LAS unsigned char* vb = kb + VOFF;
            f32x16 p0, p1;
#pragma unroll
            for (int r = 0; r < 16; ++r) { p0[r] = 0.f; p1[r] = 0.f; }
#pragma unroll
            for (int s = 0; s < 4; ++s) { const bf16x8 k0 = *(const LAS bf16x8*)(kb + kaddr[s]), k1 = *(const LAS bf16x8*)(kb + 8192 + kaddr[s]);
                p0 = __builtin_amdgcn_mfma_f32_32x32x16_bf16(k0, qf[s], p0, 0, 0, 0); p1 = __builtin_amdgcn_mfma_f32_32x32x16_bf16(k1, qf[s], p1, 0, 0, 0); }
            if (64 * t + 63 > qlo) { const int qg = qlo + r32;
#pragma unroll
                for (int r = 0; r < 16; ++r) { const int key = 64 * t + crow(r, hi); if (key > qg) p0[r] = -INFINITY; if (key + 32 > qg) p1[r] = -INFINITY; } }
            float rm = fmaxf(p0[0], p1[0]);
#pragma unroll
            for (int r = 1; r < 16; ++r) rm = fmaxf(rm, fmaxf(p0[r], p1[r]));
            rm = fmaxf(rm, __shfl_xor(rm, 32));
            const float mn = fmaxf(m, rm), alpha = __builtin_amdgcn_exp2f(m - mn); m = mn;
            float rs = 0.f;
#pragma unroll
            for (int r = 0; r < 16; ++r) { p0[r] = __builtin_amdgcn_exp2f(p0[r] - mn); p1[r] = __builtin_amdgcn_exp2f(p1[r] - mn); rs += p0[r] + p1[r]; }
            l = l * alpha + rs;
#pragma unroll
            for (int dt = 0; dt < 4; ++dt)
#pragma unroll
                for (int r = 0; r < 16; ++r) o[dt][r] *= alpha;
            bf16x8 pf[4];
#pragma unroll
            for (int ks = 0; ks < 4; ++ks) { u32x4 w;
#pragma unroll
                for (int j = 0; j < 4; ++j) { const int r = 8 * (ks & 1) + 2 * j; w[j] = (ks < 2) ? pg8::cvt_pk_bf16(p0[r], p0[r + 1]) : pg8::cvt_pk_bf16(p1[r], p1[r + 1]); }
                pf[ks] = __builtin_bit_cast(bf16x8, w); }
#pragma unroll
            for (int dt = 0; dt < 4; ++dt)
#pragma unroll
                for (int ks = 0; ks < 4; ++ks) { const s16x4 lo = trrd(vb + vaddr[0][dt] + 4096 * ks), hh = trrd(vb + vaddr[1][dt] + 4096 * ks);
                    const bf16x8 vf = (bf16x8){lo[0], lo[1], lo[2], lo[3], hh[0], hh[1], hh[2], hh[3]};
                    o[dt] = __builtin_amdgcn_mfma_f32_32x32x16_bf16(vf, pf[ks], o[dt], 0, 0, 0); }
        }
    }
    asm volatile("s_waitcnt lgkmcnt(0)" ::: "memory"); __builtin_amdgcn_s_barrier(); asm volatile("" ::: "memory");
    l += __shfl_xor(l, 32);
    const float inv = 1.f / l;
    LAS float* xch = (LAS float*)(lds + XCH_OFF + wq * 16384);
    if (c == 1) {
#pragma unroll
        for (int dt = 0; dt < 4; ++dt)
#pragma unroll
            for (int r = 0; r < 16; ++r) xch[(dt * 16 + r) * 64 + lane] = o[dt][r] * inv;
    }
    asm volatile("s_waitcnt lgkmcnt(0)" ::: "memory"); __builtin_amdgcn_s_barrier(); asm volatile("" ::: "memory");
    if (c == 0) {
        float ss = 0.f;
#pragma unroll
        for (int dt = 0; dt < 4; ++dt)
#pragma unroll
            for (int r = 0; r < 16; ++r) { const float v = o[dt][r] * inv - lam * xch[(dt * 16 + r) * 64 + lane]; o[dt][r] = v; ss += v * v; }
        ss += __shfl_xor(ss, 32);
        const float rsn = (1.f - LAMBDA_INIT) / sqrtf(ss * (1.f / 128.f) + RMS_EPS);
        bf16_t* orow = (bf16_t*)(F.p.ws + WS_MIX) + (size_t)(b * SEQ + qlo + r32) * D + h * 128;
#pragma unroll
        for (int dt = 0; dt < 4; ++dt)
#pragma unroll
            for (int r4 = 0; r4 < 4; ++r4) { const int dv = 32 * dt + 8 * r4 + 4 * hi; const f32x4 g = *(const f32x4*)(F.p.subln_g + dv);
                u32x2 w; w.x = pg8::cvt_pk_bf16(o[dt][4 * r4] * rsn * g[0], o[dt][4 * r4 + 1] * rsn * g[1]); w.y = pg8::cvt_pk_bf16(o[dt][4 * r4 + 2] * rsn * g[2], o[dt][4 * r4 + 3] * rsn * g[3]);
                *(u32x2*)(orow + dv) = w; }
    }
#undef ATT_DMA
}

__device__ __forceinline__ void attn_phase(Frame& F) {
    const float* lq = F.p.lam_qk; const int lane = F.lane;
    const float lam = __expf(wave_sum(lq[lane] * lq[64 + lane])) - __expf(wave_sum(lq[128 + lane] * lq[192 + lane])) + LAMBDA_INIT;
    volatile LAS unsigned* qw = (volatile LAS unsigned*)(F.lds + LDSCTL_OFF + 32);
    for (;;) {
        if (F.tid == 0) *qw = __hip_atomic_fetch_add(F.ctl + CW_QATT, 1u, __ATOMIC_RELAXED, __HIP_MEMORY_SCOPE_AGENT);
        __syncthreads();
        const unsigned u = (unsigned)__builtin_amdgcn_readfirstlane((int)*qw);
        if (u >= 1024u) break;
        attn_unit(F, (int)(u & 63u), 15 - (int)(u >> 6), lam);
    }
}
}
#ifndef ATT_FAST
#define ATT_FAST 1
#endif
struct Args { Ptrs p; int ph_lo, ph_hi; };
constexpr int N_PHASES = 9;
__global__ void __launch_bounds__(NWAVES * 64, 2) mk_fwd(Args args) {
    extern __shared__ __attribute__((aligned(16))) unsigned char lds_raw[];
    Frame F;
    F.lds = (LAS unsigned char*)lds_raw; F.p = args.p;
    F.tid = threadIdx.x; F.lane = F.tid & 63; F.wave = __builtin_amdgcn_readfirstlane(F.tid >> 6);
    F.G = gridDim.x; { const int bx = blockIdx.x; F.vcu = (F.G % 8 == 0) ? (bx % 8) * (F.G / 8) + bx / 8 : bx; }
    F.ctl = (unsigned*)(args.p.ws + WS_CTL);
    for (int u = F.tid; u < (LDS_BYTES - LDSCTL_OFF) / 4; u += NWAVES * 64) ((LAS unsigned*)(F.lds + LDSCTL_OFF))[u] = 0u;
    __syncthreads();
    XcdBarrier bar = xcd_barrier_post(F.ctl + CW_BAR, (volatile LAS unsigned*)(F.lds + MISC_OFF) + 8);
    const int lo = args.ph_lo, hi = args.ph_hi;
    unsigned char* ws = args.p.ws;
#define IN(k) (lo <= (k) && (k) < hi)
#define SEAM(k) do { if (IN(k) && IN((k) + 1)) xcd_barrier(bar); } while (0)

    if (IN(0)) { p0_prologue(F); }
    SEAM(0);
    if (IN(1)) {
        pg8::StaticOrder S; S.init(ws + WS_HB, ws + WS_WIN, T, NPROJ, D, F.G, (int)blockIdx.x);
        const float* cs = (const float*)(ws + WS_ROPE);
        pg8::EpiProj E{(bf16_t*)(ws + WS_PROJ), cs, cs + 2048 * 32};
        pg8::gemm_phase<pg8::EpiProj, pg8::StaticOrder, true, false>(F.lds + RING_OFF, D, S, E);
    }
    SEAM(1);
#if ATT_FAST
    if (IN(2)) { att::attn_phase(F); }
    SEAM(2);
    if (IN(3)) { if (blockIdx.x < BATCH * 4) mlstm_ref_body(F, (int)blockIdx.x); }
#else
    if (IN(2)) { attn_ref_body(F); }
    SEAM(2);
    if (IN(3)) { attn_combine_body(F); if (blockIdx.x < BATCH * 4) mlstm_ref_body(F, (int)blockIdx.x); }
#endif
    SEAM(3);
    if (IN(4)) {
        pg8::StaticOrder S; S.init(ws + WS_MIX, ws + WS_WOUT, T, D, D, F.G, (int)blockIdx.x);
        pg8::EpiOut E{F.p.x, F.p.out, (bf16_t*)(ws + WS_X1B)};
        pg8::gemm_phase<pg8::EpiOut, pg8::StaticOrder, true, false>(F.lds + RING_OFF, D, S, E);
    }
    SEAM(4);
    if (IN(5)) { router_ref_body(F); }
    SEAM(5);
    if (IN(6)) {
        moe_tables(F);
        pg8::MoeOrder S{(const LAS int*)(F.lds + TAB_OFF), F.G, F.vcu, (const char*)(ws + WS_X1B), (const char*)(ws + WS_W13), (size_t)1024 * 1024 * 2, (size_t)256 * 1024 * 2, 0, true, (const int*)(ws + WS_LIST), D};
        pg8::EpiUp E{(bf16_t*)(ws + WS_HD), (const float*)(ws + WS_RSTD), (const int*)(ws + WS_LIST)};
        pg8::gemm_phase<pg8::EpiUp, pg8::MoeOrder, true, true>(F.lds + RING_OFF, D, S, E);
    }
    SEAM(6);
    if (IN(7)) {
        moe_tables(F);
        pg8::MoeOrder S{(const LAS int*)(F.lds + TAB_OFF), F.G, F.vcu, (const char*)(ws + WS_HD), (const char*)(ws + WS_W2), (size_t)1024 * 512 * 2, (size_t)256 * 512 * 2, (size_t)DE * 2, false, (const int*)(ws + WS_LIST), DE};
        pg8::EpiDown E{(bf16_t*)(ws + WS_Y), (const float*)(ws + WS_TOKW), (const int*)(ws + WS_LIST)};
        pg8::gemm_phase<pg8::EpiDown, pg8::MoeOrder, true, false>(F.lds + RING_OFF, DE, S, E);
    }
    SEAM(7);
    if (IN(8)) { final_body(F); }
#undef IN
#undef SEAM
}

extern "C" void kernel_launch(void* const* d_in, const int* in_sizes, int n_in, void* d_out, int out_size, void* d_ws, size_t ws_size, hipStream_t stream) {
    static int grid = 0;
    if (grid == 0) {
        if (n_in != 19 || out_size != T * D || ws_size < WS_END) { fprintf(stderr, "kernel_launch: unexpected shapes (n_in %d out %d ws %zu)\n", n_in, out_size, ws_size); grid = -1; return; }
        int dev = 0, cus = 0, per_cu = 0;
        if (hipGetDevice(&dev) != hipSuccess || hipDeviceGetAttribute(&cus, hipDeviceAttributeMultiprocessorCount, dev) != hipSuccess) { grid = -1; return; }
        if (hipFuncSetAttribute((const void*)mk_fwd, hipFuncAttributeMaxDynamicSharedMemorySize, LDS_BYTES) != hipSuccess) { fprintf(stderr, "kernel_launch: hipFuncSetAttribute failed\n"); grid = -1; return; }
        if (hipOccupancyMaxActiveBlocksPerMultiprocessor(&per_cu, (const void*)mk_fwd, NWAVES * 64, LDS_BYTES) != hipSuccess || per_cu < 1) { fprintf(stderr, "kernel_launch: occupancy query says %d\n", per_cu); }
        (void)hipGetLastError();
        grid = cus;
    }
    if (grid < 0) return;
    Args a{};
    Ptrs& p = a.p;
    p.x = (const float*)d_in[0]; p.w_in = (const float*)d_in[1]; p.conv_w = (const float*)d_in[2]; p.conv_b = (const float*)d_in[3]; p.gate_b = (const float*)d_in[4];
    p.lam_qk = (const float*)d_in[5]; p.subln_g = (const float*)d_in[6]; p.mhnorm_g = (const float*)d_in[7]; p.w_out = (const float*)d_in[8]; p.g_mix = (const float*)d_in[9];
    p.g_ffn = (const float*)d_in[10]; p.w_grp = (const float*)d_in[11]; p.b_grp = (const float*)d_in[12]; p.w_er = (const float*)d_in[13]; p.b_er = (const float*)d_in[14];
    p.w1 = (const float*)d_in[15]; p.w3 = (const float*)d_in[16]; p.w2 = (const float*)d_in[17]; p.g_final = (const float*)d_in[18];
    p.out = (float*)d_out; p.ws = (unsigned char*)d_ws;
    if (hipMemsetAsync((char*)d_ws + WS_CTL, 0, CTL_ZERO_BYTES, stream) != hipSuccess) return;
    a.ph_lo = 0; a.ph_hi = N_PHASES;
    hipLaunchKernelGGL(mk_fwd, dim3(grid), dim3(NWAVES * 64), LDS_BYTES, stream, a);
}
```

```cpp
#include <hip/hip_runtime.h>
#include <cstdio>
#include <cstdint>

constexpr int BATCH = 16, SEQ = 2048, D = 1024, T = BATCH * SEQ;
constexpr int DIN = 3592, NPROJ = 3584;
constexpr int C_QA = 0, C_KA = 512, C_VA = 1024, C_QM = 1536, C_KM = 2048, C_VM = 2560, C_OM = 3072, C_IG = 3584, C_FG = 3588;
constexpr int NE = 32, EPG = 8, DE = 512;
constexpr float RMS_EPS = 1e-6f;
constexpr float LAMBDA_INIT = 0.2f;
constexpr float C2Q = 0.125f * 1.4426950408889634f;
constexpr int LIST_CAP = T;

constexpr size_t MiB = 1u << 20;
constexpr size_t WS_CTL = 0, CTL_ZERO_BYTES = 1 * MiB;
constexpr size_t WS_ROPE = 1 * MiB;
constexpr size_t WS_TOKW = 2 * MiB;
constexpr size_t WS_RSTD = 2 * MiB + 512 * 1024;
constexpr size_t WS_LIST = 4 * MiB;
constexpr size_t WS_GATES = 8 * MiB;
constexpr size_t WS_WIN = 10 * MiB;
constexpr size_t WS_WOUT = 17 * MiB;
constexpr size_t WS_W13 = 20 * MiB;
constexpr size_t WS_W2 = 84 * MiB;
constexpr size_t WS_PROJ = 116 * MiB;
constexpr size_t WS_MIX = 340 * MiB;
constexpr size_t WS_X1B = 404 * MiB;
constexpr size_t WS_HB = 404 * MiB;
constexpr size_t WS_HD = 116 * MiB;
constexpr size_t WS_Y = 188 * MiB;
constexpr size_t WS_END = 468 * MiB;
constexpr int CW_TMO = 0, CW_CODE = 1;
constexpr int CW_CNT = 1024;
constexpr int CW_BAR = 4096;
constexpr int CW_QATT = 8192;

#define LAS __attribute__((address_space(3)))
typedef unsigned short bf16_t;
typedef short bf16x8 __attribute__((ext_vector_type(8)));
typedef float f32x4 __attribute__((ext_vector_type(4)));
typedef unsigned u32x4 __attribute__((ext_vector_type(4)));
typedef unsigned u32x2 __attribute__((ext_vector_type(2)));

__device__ __forceinline__ unsigned f2bf(float f) { unsigned u = __float_as_uint(f); return (u + 0x7fffu + ((u >> 16) & 1u)) >> 16; }
__device__ __forceinline__ unsigned pk2(float lo, float hi) { return f2bf(lo) | (f2bf(hi) << 16); }
__device__ __forceinline__ float bf2f(unsigned b) { return __uint_as_float(b << 16); }
__device__ __forceinline__ float wave_sum(float v) {
#pragma unroll
    for (int o = 1; o < 64; o <<= 1) v += __shfl_xor(v, o);
    return v;
}
__device__ __forceinline__ float sigmoidf_(float x) { return 1.f / (1.f + __expf(-x)); }

struct MapId { __device__ __forceinline__ int operator()(int n) const { return n; } };
struct MapRope {
    __device__ __forceinline__ int operator()(int c) const { if (c >= 1024) return c; const int g = c & ~63, d = c & 63; return g + 8 * ((d & 31) >> 2) + 4 * (d >> 5) + (d & 3); } };
struct MapW1 { __device__ __forceinline__ int operator()(int c) const { return 256 * (c >> 7) + (c & 127); } };
struct MapW3 { __device__ __forceinline__ int operator()(int c) const { return 256 * (c >> 7) + 128 + (c & 127); } };
template <class Map>
__device__ __forceinline__ void transpose_item(const float* W, int ldw, bf16_t* WT, int K, int k0, int n0, const Map& map, const float* kscale, LAS float* scr, int lane) {
#pragma unroll 8
    for (int i = 0; i < 32; ++i) { const int kk = 2 * i + (lane >> 5); scr[kk * 33 + (lane & 31)] = W[(size_t)(k0 + kk) * ldw + n0 + (lane & 31)]; }
    asm volatile("s_waitcnt vmcnt(0) lgkmcnt(0)" ::: "memory");
    const int c = lane & 7;
    float ks[8];
#pragma unroll
    for (int i = 0; i < 8; ++i) ks[i] = kscale ? kscale[k0 + 8 * c + i] : 1.f;
#pragma unroll
    for (int j = 0; j < 4; ++j) { const int n = (lane >> 3) + 8 * j; const LAS float* s = scr + (8 * c) * 33 + n;
        u32x4 o; o.x = pk2(s[0 * 33] * ks[0], s[1 * 33] * ks[1]); o.y = pk2(s[2 * 33] * ks[2], s[3 * 33] * ks[3]); o.z = pk2(s[4 * 33] * ks[4], s[5 * 33] * ks[5]); o.w = pk2(s[6 * 33] * ks[6], s[7 * 33] * ks[7]);
        *(u32x4*)(WT + (size_t)map(n0 + n) * K + k0 + 8 * c) = o; }
    asm volatile("s_waitcnt lgkmcnt(0)" ::: "memory");
}

struct Ptrs {
    const float *x, *w_in, *conv_w, *conv_b, *gate_b, *lam_qk, *subln_g, *mhnorm_g, *w_out, *g_mix, *g_ffn, *w_grp, *b_grp, *w_er, *b_er, *w1, *w3, *w2, *g_final;
    float* out; unsigned char* ws;
};


namespace pg8 {
#define PG8_LAS __attribute__((address_space(3)))
constexpr int BM = 256, BK = 64, HALF = 128, HTB = HALF * BK * 2, STAGE_BYTES = 8 * HTB, NXCD = 8, WGM = 8;
__host__ __device__ __forceinline__ int lds_byte(int r, int c) { const int st = (r >> 4) * 2 + (c >> 5), rr = r & 15, cc = c & 31, ob = rr * 64 + cc * 2; return st * 1024 + (ob ^ (((ob >> 9) & 1) << 5)); }
__host__ __device__ __forceinline__ void stage_rc(int b, int& R, int& C) { const int st = b / 1024, sb = b % 1024, swz = sb ^ (((sb >> 9) & 1) << 5); R = (st >> 1) * 16 + swz / 64; C = (st & 1) * 32 + (swz % 64) / 2; }
__host__ __device__ __forceinline__ int perm32(int rho) { const int n = rho >> 4, i = rho & 15; return 8 * (i >> 2) + 4 * n + (i & 3); }

struct Unit { int pm, pn; const char* a; const char* b; int e, cnt, ps; };

struct StaticOrder {
    int nM, nN, nwg, G, c; const char* A; const char* Bt; size_t tstep;
    __device__ void init(const void* A_, const void* Bt_, int M, int N, int K, int G_, int c_) { A = (const char*)A_; Bt = (const char*)Bt_; nM = M / BM; nN = N / BM; nwg = nM * nN; G = G_; c = c_; tstep = (size_t)BM * K * 2; }
    __device__ bool next(int i, Unit& u) const {
        const long L = (long)i * G + c; if (L >= nwg) return false;
        int wgid = (int)L; { const int q = nwg / NXCD, r = nwg % NXCD, xcd = wgid % NXCD, off = wgid / NXCD; wgid = (xcd < r ? xcd * (q + 1) : r * (q + 1) + (xcd - r) * q) + off; }
        const int nig = WGM * nN, gid = wgid / nig, fm = gid * WGM, gsz = (nM - fm) < WGM ? (nM - fm) : WGM;
        u.pm = fm + ((wgid % nig) % gsz); u.pn = (wgid % nig) / gsz; u.a = A + (size_t)u.pm * tstep; u.b = Bt + (size_t)u.pn * tstep; u.e = 0; u.cnt = 0; u.ps = 0; return true;
    }
    __device__ __forceinline__ unsigned row_off(const Unit&, int) const { return 0u; }
};
struct MoeOrder {
    const PG8_LAS int* tab; int G, vcu; const char* A; const char* Bt; size_t bstep_e, bstep_n, astep; bool gather; const int* list; int K;
    __device__ bool next(int i, Unit& u) const {
        const int L = i * G + vcu; if (L >= tab[32]) return false;
        int e = 0;
#pragma unroll 1
        for (int j = 1; j < 32; ++j) e = (L >= tab[j]) ? j : e;
        const int loc = L - tab[e]; u.e = e; u.pn = loc & 3; u.pm = loc >> 2; u.cnt = tab[128 + e]; u.ps = tab[64 + e];
        u.b = Bt + (size_t)e * bstep_e + (size_t)u.pn * bstep_n;
        u.a = gather ? A : A + (size_t)(u.ps + u.pm * BM) * astep;
        return true;
    }
    __device__ __forceinline__ unsigned row_off(const Unit& u, int r) const {
        const int s = u.pm * BM + r; const int a = (s < u.cnt) ? list[(size_t)u.e * LIST_CAP + s] : 0; return (unsigned)(a >> 1) * (unsigned)(K * 2);
    }
};

typedef float f32x2_t __attribute__((ext_vector_type(2))); typedef __bf16 bf16x2_t __attribute__((ext_vector_type(2)));
__device__ __forceinline__ unsigned cvt_pk_bf16(float lo, float hi) { const f32x2_t v = {lo, hi}; const bf16x2_t b = __builtin_convertvector(v, bf16x2_t); return __builtin_bit_cast(unsigned, b); }

struct EpiProj {
    static constexpr bool PERM = true;
    bf16_t* O; const float* cs; const float* sn;
    __device__ __forceinline__ void operator()(const f32x4 (&acc)[2][2][4][2], const Unit& u, int wr, int wc, int fr, int fq) const {
        const int row0 = u.pm * BM + wr * 64 + fr, colt = u.pn * BM;
        if (u.pn < 4) {
            const float sc = (u.pn < 2) ? C2Q : 1.f; const int q8 = 4 * (wc & 1) + fq;
#pragma unroll
            for (int ai = 0; ai < 2; ++ai)
#pragma unroll
                for (int m = 0; m < 4; ++m) { const int row = row0 + ai * HALF + m * 16, pos = row & (SEQ - 1);
                    const f32x4 c4 = *(const f32x4*)(cs + pos * 32 + 4 * q8) * sc, s4 = *(const f32x4*)(sn + pos * 32 + 4 * q8) * sc;
                    bf16_t* rowp = O + (size_t)row * NPROJ + colt + 64 * (wc >> 1) + 4 * q8;
#pragma unroll
                    for (int bj = 0; bj < 2; ++bj) { const f32x4 x1 = acc[ai][bj][m][0], x2 = acc[ai][bj][m][1]; const f32x4 o1 = x1 * c4 - x2 * s4, o2 = x1 * s4 + x2 * c4;
                        u32x2 w1, w2; w1.x = cvt_pk_bf16(o1[0], o1[1]); w1.y = cvt_pk_bf16(o1[2], o1[3]); w2.x = cvt_pk_bf16(o2[0], o2[1]); w2.y = cvt_pk_bf16(o2[2], o2[3]);
                        *(u32x2*)(rowp + bj * HALF) = w1; *(u32x2*)(rowp + bj * HALF + 32) = w2; } }
        } else {
            const int col0 = colt + wc * 32 + 8 * fq;
#pragma unroll
            for (int ai = 0; ai < 2; ++ai)
#pragma unroll
                for (int m = 0; m < 4; ++m) { bf16_t* rowp = O + (size_t)(row0 + ai * HALF + m * 16) * NPROJ + col0;
#pragma unroll
                    for (int bj = 0; bj < 2; ++bj) { const f32x4 v0 = acc[ai][bj][m][0], v1 = acc[ai][bj][m][1];
                        u32x4 w; w.x = cvt_pk_bf16(v0[0], v0[1]); w.y = cvt_pk_bf16(v0[2], v0[3]); w.z = cvt_pk_bf16(v1[0], v1[1]); w.w = cvt_pk_bf16(v1[2], v1[3]);
                        *(u32x4*)(rowp + bj * HALF) = w; } }
        }
    }
};
struct EpiOut {
    static constexpr bool PERM = true;
    const float* x; float* X1; bf16_t* X1B;
    __device__ __forceinline__ void operator()(const f32x4 (&acc)[2][2][4][2], const Unit& u, int wr, int wc, int fr, int fq) const {
        const int row0 = u.pm * BM + wr * 64 + fr, col0 = u.pn * BM + wc * 32 + 8 * fq;
#pragma unroll
        for (int ai = 0; ai < 2; ++ai)
#pragma unroll
            for (int m = 0; m < 4; ++m) { const size_t off = (size_t)(row0 + ai * HALF + m * 16) * D + col0;
#pragma unroll
                for (int bj = 0; bj < 2; ++bj) { const f32x4 v0 = acc[ai][bj][m][0] + *(const f32x4*)(x + off + bj * HALF), v1 = acc[ai][bj][m][1] + *(const f32x4*)(x + off + bj * HALF + 4);
                    *(f32x4*)(X1 + off + bj * HALF) = v0; *(f32x4*)(X1 + off + bj * HALF + 4) = v1;
                    u32x4 w; w.x = cvt_pk_bf16(v0[0], v0[1]); w.y = cvt_pk_bf16(v0[2], v0[3]); w.z = cvt_pk_bf16(v1[0], v1[1]); w.w = cvt_pk_bf16(v1[2], v1[3]);
                    *(u32x4*)(X1B + off + bj * HALF) = w; }
                asm volatile("" ::: "memory"); }
    }
};
struct EpiUp {
    static constexpr bool PERM = true;
    bf16_t* HD; const float* rstd; const int* list;
    __device__ __forceinline__ void operator()(const f32x4 (&acc)[2][2][4][2], const Unit& u, int wr, int wc, int fr, int fq) const {
        const int r0 = u.pm * BM + wr * 64 + fr, col0 = u.pn * HALF + wc * 32 + 8 * fq;
#pragma unroll
        for (int ai = 0; ai < 2; ++ai)
#pragma unroll
            for (int m = 0; m < 4; ++m) { const int s = r0 + ai * HALF + m * 16; if (s < u.cnt) { const float rs = rstd[list[(size_t)u.e * LIST_CAP + s] >> 1];
                    float h[8];
#pragma unroll
                    for (int n = 0; n < 2; ++n)
#pragma unroll
                        for (int i = 0; i < 4; ++i) { const float a = acc[ai][0][m][n][i] * rs, b = acc[ai][1][m][n][i] * rs; h[4 * n + i] = a * b / (1.f + __expf(-a)); }
                    u32x4 w; w.x = cvt_pk_bf16(h[0], h[1]); w.y = cvt_pk_bf16(h[2], h[3]); w.z = cvt_pk_bf16(h[4], h[5]); w.w = cvt_pk_bf16(h[6], h[7]);
                    *(u32x4*)(HD + (size_t)(u.ps + s) * DE + col0) = w; } }
    }
};
struct EpiDown {
    static constexpr bool PERM = true;
    bf16_t* Y; const float* tokw; const int* list;
    __device__ __forceinline__ void operator()(const f32x4 (&acc)[2][2][4][2], const Unit& u, int wr, int wc, int fr, int fq) const {
        const int r0 = u.pm * BM + wr * 64 + fr, col0 = u.pn * BM + wc * 32 + 8 * fq;
#pragma unroll
        for (int ai = 0; ai < 2; ++ai)
#pragma unroll
            for (int m = 0; m < 4; ++m) { const int s = r0 + ai * HALF + m * 16; if (s < u.cnt) { const int a = list[(size_t)u.e * LIST_CAP + s]; const float w8 = tokw[a];
                    bf16_t* rowp = Y + (size_t)a * D + col0;
#pragma unroll
                    for (int bj = 0; bj < 2; ++bj) { const f32x4 v0 = acc[ai][bj][m][0] * w8, v1 = acc[ai][bj][m][1] * w8;
                        u32x4 w; w.x = cvt_pk_bf16(v0[0], v0[1]); w.y = cvt_pk_bf16(v0[2], v0[3]); w.z = cvt_pk_bf16(v1[0], v1[1]); w.w = cvt_pk_bf16(v1[2], v1[3]);
                        *(u32x4*)(rowp + bj * HALF) = w; } } }
    }
};

template <class Epi, class Sched, bool ALIGN_EPI, bool GATHER>
__device__ __forceinline__ void gemm_phase(PG8_LAS unsigned char* lds, const int K, const Sched& S, const Epi& E) {
    const int tid = threadIdx.x, wid = __builtin_amdgcn_readfirstlane(tid >> 6), lane = tid & 63, wr = wid >> 2, wc = wid & 3, fr = lane & 15, fq = lane >> 4;
    const int nt = K / BK;
    unsigned voffB[2], ga[2][2], gn[2][2]; int RA[2], CA[2];
#pragma unroll
    for (int i = 0; i < 2; ++i) { int R, C; stage_rc(tid * 16 + i * 8192, R, C); const int Rb = Epi::PERM ? ((R & ~31) + perm32(R & 31)) : R;
        RA[i] = R; CA[i] = C; voffB[i] = (unsigned)(Rb * K + C) * 2u; }
    const size_t kstep = (size_t)(BK * 2);
    const size_t hstep = (size_t)HALF * K * 2;
    const unsigned ldsw = (unsigned)wid * 1024u;
    const int aoff = lds_byte(wr * 64 + fr, fq * 8), boff = lds_byte(wc * 32 + fr, fq * 8);
#define PG8_SA(b, h) (((b) * 2 + (h)) * HTB)
#define PG8_SB(b, h) ((4 + (b) * 2 + (h)) * HTB)
#define PG8_STAGE(bufoff, gbase, voff) do { _Pragma("unroll") for (int _i = 0; _i < 2; ++_i) \
        __builtin_amdgcn_global_load_lds((const unsigned*)((const char*)(gbase) + (voff)[_i]), (PG8_LAS unsigned*)(lds + (bufoff) + ldsw + _i * 8192), 16, 0, 0); } while (0)
#define PG8_LDA(dst, b, h) do { _Pragma("unroll") for (int m = 0; m < 4; ++m) _Pragma("unroll") for (int k = 0; k < 2; ++k) dst[m][k] = *(const PG8_LAS bf16x8*)(lds + PG8_SA(b, h) + aoff + m * 2048 + k * 1024); } while (0)
#define PG8_LDB(dst, b, h) do { _Pragma("unroll") for (int n = 0; n < 2; ++n) _Pragma("unroll") for (int k = 0; k < 2; ++k) dst[n][k] = *(const PG8_LAS bf16x8*)(lds + PG8_SB(b, h) + boff + n * 2048 + k * 1024); } while (0)
#define PG8_MMA(ai, bj, At, Bt) do { __builtin_amdgcn_s_setprio(1); _Pragma("unroll") for (int m = 0; m < 4; ++m) _Pragma("unroll") for (int n = 0; n < 2; ++n) _Pragma("unroll") for (int k = 0; k < 2; ++k) \
        acc[ai][bj][m][n] = __builtin_amdgcn_mfma_f32_16x16x32_bf16(Bt[n][k], At[m][k], acc[ai][bj][m][n], 0, 0, 0); __builtin_amdgcn_s_setprio(0); } while (0)
#define PG8_WAIT_V(n) asm volatile("s_waitcnt vmcnt(" #n ")" ::: "memory")
#define PG8_WAIT_L(n) asm volatile("s_waitcnt lgkmcnt(" #n ")" ::: "memory")
#define PG8_BAR __builtin_amdgcn_s_barrier()
#define PG8_SCHED __builtin_amdgcn_sched_barrier(0)
    Unit cur, nxt; int ui = 0;
    if (!S.next(0, cur)) return;
#pragma unroll
    for (int h = 0; h < 2; ++h)
#pragma unroll
        for (int i = 0; i < 2; ++i) { ga[h][i] = (GATHER ? S.row_off(cur, h * HALF + RA[i]) : (unsigned)((h * HALF + RA[i]) * K) * 2u) + (unsigned)CA[i] * 2u; gn[h][i] = ga[h][i]; }
    f32x4 acc[2][2][4][2];
#pragma unroll
    for (int a = 0; a < 2; ++a)
#pragma unroll
        for (int b = 0; b < 2; ++b)
#pragma unroll
            for (int m = 0; m < 4; ++m)
#pragma unroll
                for (int n = 0; n < 2; ++n) acc[a][b][m][n] = (f32x4){0.f, 0.f, 0.f, 0.f};
    bf16x8 At[4][2], B0[2][2], B1[2][2];
    const char* cA = cur.a; const char* cB = cur.b;
    PG8_STAGE(PG8_SB(0, 0), cB, voffB); PG8_STAGE(PG8_SB(0, 1), cB + hstep, voffB); PG8_STAGE(PG8_SA(0, 0), cA, ga[0]); PG8_STAGE(PG8_SA(0, 1), cA, ga[1]);
    if (wr == 1) PG8_BAR;
    PG8_WAIT_V(2); PG8_BAR;
    PG8_STAGE(PG8_SB(1, 0), cB + kstep, voffB); PG8_STAGE(PG8_SA(1, 0), cA + kstep, ga[0]); PG8_STAGE(PG8_SB(1, 1), cB + hstep + kstep, voffB);
    PG8_WAIT_V(6); PG8_BAR;
    for (;;) {
        const bool has_next = S.next(ui + 1, nxt);
        const char* nA = has_next ? nxt.a : cA; const char* nB = has_next ? nxt.b : cB;
        if (GATHER && has_next) {
#pragma unroll
            for (int h = 0; h < 2; ++h)
#pragma unroll
                for (int i = 0; i < 2; ++i) gn[h][i] = S.row_off(nxt, h * HALF + RA[i]) + (unsigned)CA[i] * 2u;
        }
        for (int t = 0; t < nt; t += 2) {
            const bool last = (t == nt - 2);
            const char* a1 = cA + (size_t)(t + 1) * kstep;
            const char* a2 = last ? nA : cA + (size_t)(t + 2) * kstep; const char* b2 = last ? nB : cB + (size_t)(t + 2) * kstep;
            const char* a3 = a2 + kstep; const char* b3 = b2 + kstep;
            unsigned g2[2][2];
#pragma unroll
            for (int h = 0; h < 2; ++h)
#pragma unroll
                for (int i = 0; i < 2; ++i) g2[h][i] = (GATHER && last) ? gn[h][i] : ga[h][i];
            PG8_LDB(B0, 0, 0); PG8_LDB(B1, 0, 1); PG8_SCHED; PG8_LDA(At, 0, 0); PG8_STAGE(PG8_SA(1, 1), a1, ga[1]);
            PG8_WAIT_V(8); PG8_WAIT_L(0); PG8_BAR; PG8_MMA(0, 0, At, B0); PG8_MMA(0, 1, At, B1); PG8_BAR; PG8_SCHED;
            PG8_LDA(At, 0, 1); PG8_STAGE(PG8_SB(0, 0), b2, voffB); PG8_STAGE(PG8_SB(0, 1), b2 + hstep, voffB); PG8_STAGE(PG8_SA(0, 0), a2, g2[0]);
            PG8_WAIT_V(8); PG8_WAIT_L(0); PG8_BAR; PG8_MMA(1, 0, At, B0); PG8_MMA(1, 1, At, B1); PG8_BAR; PG8_SCHED;
            PG8_LDB(B0, 1, 0); PG8_LDB(B1, 1, 1); PG8_SCHED; PG8_LDA(At, 1, 0); PG8_STAGE(PG8_SA(0, 1), a2, g2[1]);
            PG8_WAIT_V(8); PG8_WAIT_L(0); PG8_BAR; PG8_MMA(0, 0, At, B0); PG8_MMA(0, 1, At, B1); PG8_BAR; PG8_SCHED;
            PG8_LDA(At, 1, 1); PG8_STAGE(PG8_SB(1, 0), b3, voffB); PG8_STAGE(PG8_SB(1, 1), b3 + hstep, voffB); PG8_STAGE(PG8_SA(1, 0), a3, g2[0]);
            PG8_WAIT_V(8); PG8_WAIT_L(0); PG8_BAR; PG8_MMA(1, 0, At, B0); PG8_MMA(1, 1, At, B1); PG8_BAR; PG8_SCHED;
        }
        if constexpr (ALIGN_EPI) { if (wr == 0) PG8_BAR; }
        E(acc, cur, wr, wc, fr, fq);
        if (!has_next) break;
#pragma unroll
        for (int a = 0; a < 2; ++a)
#pragma unroll
            for (int b = 0; b < 2; ++b)
#pragma unroll
                for (int m = 0; m < 4; ++m)
#pragma unroll
                    for (int n = 0; n < 2; ++n) acc[a][b][m][n] = (f32x4){0.f, 0.f, 0.f, 0.f};
        cur = nxt; cA = nA; cB = nB; ++ui;
#pragma unroll
        for (int h = 0; h < 2; ++h)
#pragma unroll
            for (int i = 0; i < 2; ++i) ga[h][i] = gn[h][i];
        if constexpr (ALIGN_EPI) { if (wr == 1) PG8_BAR; }
    }
    PG8_WAIT_V(0);
    if constexpr (!ALIGN_EPI) { if (wr == 0) PG8_BAR; }
    PG8_BAR;
#undef PG8_SA
#undef PG8_SB
#undef PG8_STAGE
#undef PG8_LDA
#undef PG8_LDB
#undef PG8_MMA
#undef PG8_WAIT_V
#undef PG8_WAIT_L
#undef PG8_BAR
#undef PG8_SCHED
}
}

constexpr int NWAVES = 8;
constexpr int RING_OFF = 0, RING_BYTES = 135168;
constexpr int LDSCTL_OFF = RING_BYTES;
constexpr int MISC_OFF = LDSCTL_OFF + 64;
constexpr int TAB_OFF = LDSCTL_OFF + 256;
constexpr int LDS_BYTES = RING_BYTES + 2048;

#define GAS __attribute__((address_space(1)))
typedef GAS unsigned gu32;
#define RLX_AGENT __ATOMIC_RELAXED, __HIP_MEMORY_SCOPE_AGENT
#define LDS_WAIT() asm volatile("s_waitcnt lgkmcnt(0)" ::: "memory")
#define VM_WAIT() asm volatile("s_waitcnt vmcnt(0)" ::: "memory")

#define XB_TMO      128
#define XB_XCNT(j)  (256  + 64 * (j))
#define XB_XSUB(j)  (1280 + 64 * (j))
#define XB_XGEN(j)  (2304 + 64 * (j))
#define XB_TOP      3328
#define XB_TOPGEN   3392
#define XCD_BAR_WORDS 3456
#define XB_SPIN_CAP (1u << 18)

__device__ __forceinline__ unsigned xb_ld(unsigned* p)              { return __hip_atomic_load(p, __ATOMIC_RELAXED, __HIP_MEMORY_SCOPE_AGENT); }
__device__ __forceinline__ unsigned xb_add(unsigned* p, unsigned v) { return __hip_atomic_fetch_add(p, v, __ATOMIC_RELAXED, __HIP_MEMORY_SCOPE_AGENT); }
__device__ __forceinline__ unsigned xb_xcc_id() { return (unsigned)__builtin_amdgcn_s_getreg((3 << 11) | 20) & 0xFu; }
#define XB_SPIN(cond, bar) do { unsigned _sp = 0; while (cond) { __builtin_amdgcn_s_sleep(1); \
    if ((++_sp & 255u) == 0u) { if (xb_ld(&(bar)[XB_TMO])) break; if (_sp > XB_SPIN_CAP) { atomicAdd(&(bar)[XB_TMO], 1u); break; } } } } while (0)

struct XcdBarrier { unsigned* bar; unsigned x; volatile LAS unsigned* st; };

__device__ __forceinline__ XcdBarrier xcd_barrier_post(unsigned* bar, volatile LAS unsigned* st) {
    XcdBarrier b; b.bar = bar; b.x = xb_xcc_id(); b.st = st;
    if (threadIdx.x == 0) (void)xb_add(&bar[XB_XCNT(b.x)], 1u);
    return b;
}
__device__ __forceinline__ void xcd_barrier_complete(unsigned* bar, unsigned x, unsigned& nloc, unsigned& nx) {
    const unsigned G = gridDim.x * gridDim.y * gridDim.z;
    unsigned sum, cnt, mine, sp = 0u;
    for (;;) {
        sum = 0u; cnt = 0u; mine = 0u;
#pragma unroll
        for (unsigned j = 0; j < 16; ++j) { const unsigned c = xb_ld(&bar[XB_XCNT(j)]); sum += c; cnt += (c > 0u) ? 1u : 0u; mine = (j == x) ? c : mine; }
        if (sum == G) break;
        __builtin_amdgcn_s_sleep(1);
        if ((++sp & 255u) == 0u) { if (xb_ld(&bar[XB_TMO])) break; if (sp > XB_SPIN_CAP) { atomicAdd(&bar[XB_TMO], 1u); break; } }
    }
    nloc = mine > 0u ? mine : 1u; nx = cnt > 0u ? cnt : 1u;
}
__device__ __forceinline__ void xcd_barrier(const XcdBarrier& b) {
    asm volatile("s_waitcnt vmcnt(0)" ::: "memory");
    __syncthreads();
    if (threadIdx.x == 0) {
        unsigned* bar = b.bar;
        __builtin_amdgcn_s_waitcnt(0);
        unsigned nloc = b.st[0], nx = b.st[1];
        if (nloc == 0u) { xcd_barrier_complete(bar, b.x, nloc, nx); b.st[0] = nloc; b.st[1] = nx; }
        const unsigned old = xb_add(&bar[XB_XSUB(b.x)], 1u);
        const unsigned gen = old / nloc;
        if (old + 1u == (gen + 1u) * nloc) {
            __builtin_amdgcn_fence(__ATOMIC_RELEASE, "agent");
            asm volatile("s_waitcnt vmcnt(0)" ::: "memory");
            const unsigned og = xb_add(&bar[XB_TOP], 1u);
            const unsigned tg = og / nx;
            if (og + 1u == (tg + 1u) * nx) xb_add(&bar[XB_TOPGEN], 1u);
            else XB_SPIN(xb_ld(&bar[XB_TOPGEN]) == tg, bar);
            __builtin_amdgcn_fence(__ATOMIC_ACQUIRE, "agent");
            xb_add(&bar[XB_XGEN(b.x)], 1u);
            asm volatile("s_waitcnt vmcnt(0)" ::: "memory");
        } else {
            XB_SPIN(xb_ld(&bar[XB_XGEN(b.x)]) == gen, bar);
            __builtin_amdgcn_fence(__ATOMIC_ACQUIRE, "agent");
            asm volatile("s_waitcnt vmcnt(0)" ::: "memory");
        }
    }
    __syncthreads();
}

struct Frame {
    LAS unsigned char* lds;
    unsigned* ctl;
    int tid, lane, wave, vcu, G;
    Ptrs p;
};

__device__ __forceinline__ void p0_prologue(Frame& F) {
    const Ptrs& p = F.p; const int tid = F.tid, lane = F.lane, wave = F.wave;
    LAS float* scr = (LAS float*)(F.lds + RING_OFF) + wave * 64 * 33;
    LAS float* gw = (LAS float*)(F.lds + RING_OFF + 8 * 64 * 33 * 4);
    const int gw_id = F.vcu * NWAVES + wave, NGW = F.G * NWAVES;
    bf16_t* WIN = (bf16_t*)(p.ws + WS_WIN); bf16_t* WOUT = (bf16_t*)(p.ws + WS_WOUT); bf16_t* W13 = (bf16_t*)(p.ws + WS_W13); bf16_t* W2 = (bf16_t*)(p.ws + WS_W2);
    for (int i = tid; i < 1024 * 8; i += NWAVES * 64) gw[i] = p.w_in[(size_t)(i >> 3) * DIN + C_IG + (i & 7)];
    __syncthreads();
    constexpr int I_IN = 16 * 112, I_OUT = 16 * 32, I_13 = 16 * 16 * 32, I_2 = 8 * 32 * 32;
    constexpr int NITEMS = I_IN + I_OUT + 2 * I_13 + I_2;
    for (int it = gw_id; it < NITEMS; it += NGW) {
        int r = it;
        if (r < I_IN) { const int kb = r / 112, nb = r % 112; transpose_item(p.w_in, DIN, WIN, 1024, 64 * kb, 32 * nb, MapRope(), nullptr, scr, lane); continue; } r -= I_IN;
        if (r < I_OUT) { const int kb = r / 32, nb = r % 32; transpose_item(p.w_out, 1024, WOUT, 1024, 64 * kb, 32 * nb, MapId(), nullptr, scr, lane); continue; } r -= I_OUT;
        if (r < I_13) { const int e = r / 256, q = r % 256, kb = q / 16, nb = q % 16; transpose_item(p.w1 + (size_t)e * 1024 * 512, 512, W13 + (size_t)e * 1024 * 1024, 1024, 64 * kb, 32 * nb, MapW1(), p.g_ffn, scr, lane); continue; } r -= I_13;
        if (r < I_13) { const int e = r / 256, q = r % 256, kb = q / 16, nb = q % 16; transpose_item(p.w3 + (size_t)e * 1024 * 512, 512, W13 + (size_t)e * 1024 * 1024, 1024, 64 * kb, 32 * nb, MapW3(), p.g_ffn, scr, lane); continue; } r -= I_13;
        { const int e = r / 256, q = r % 256, kb = q / 32, nb = q % 32; transpose_item(p.w2 + (size_t)e * 512 * 1024, 1024, W2 + (size_t)e * 1024 * 512, 512, 64 * kb, 32 * nb, MapId(), nullptr, scr, lane); }
    }
    { float* cs = (float*)(p.ws + WS_ROPE); float* sn = cs + 2048 * 32;
      for (int i = blockIdx.x * 512 + tid; i < 2048 * 32; i += F.G * 512) { const int pos = i >> 5, j = i & 31;
          const float inv = 1.0f / exp2f((float)(2 * j) * (1.f / 64.f) * 13.287712379549449f);
          const float ang = (float)pos * inv; const double rev = (double)ang * 0.15915494309189535; const float fr = (float)(rev - rint(rev));
          cs[i] = __builtin_amdgcn_cosf(fr); sn[i] = __builtin_amdgcn_sinf(fr); } }
    bf16_t* HB = (bf16_t*)(p.ws + WS_HB); float* GATES = (float*)(p.ws + WS_GATES);
    for (int m = gw_id; m < T; m += NGW) {
        const f32x4* xr = (const f32x4*)(p.x + (size_t)m * D) + lane; const f32x4* gr = (const f32x4*)p.g_mix + lane;
        f32x4 v[4]; float s = 0.f;
#pragma unroll
        for (int j = 0; j < 4; ++j) { v[j] = xr[64 * j]; s += (v[j].x * v[j].x + v[j].y * v[j].y) + (v[j].z * v[j].z + v[j].w * v[j].w); }
        const float rstd = 1.f / sqrtf(wave_sum(s) * (1.f / D) + RMS_EPS);
        float ga[8];
#pragma unroll
        for (int e = 0; e < 8; ++e) ga[e] = 0.f;
        unsigned long long* o8 = (unsigned long long*)(HB + (size_t)m * D) + lane;
#pragma unroll
        for (int j = 0; j < 4; ++j) { const f32x4 g = gr[64 * j]; f32x4 h = v[j] * rstd * g;
            o8[64 * j] = (unsigned long long)pk2(h.x, h.y) | ((unsigned long long)pk2(h.z, h.w) << 32);
            const int k0 = 256 * j + 4 * lane;
#pragma unroll
            for (int q = 0; q < 4; ++q) { const float hv = h[q]; const LAS float* w = gw + (k0 + q) * 8;
#pragma unroll
                for (int e = 0; e < 8; ++e) ga[e] += hv * w[e]; } }
#pragma unroll
        for (int e = 0; e < 8; ++e) ga[e] = wave_sum(ga[e]);
        if (lane < 8) { float gv = 0.f;
#pragma unroll
            for (int e = 0; e < 8; ++e) gv = (lane == e) ? ga[e] : gv;
            gv += p.gate_b[lane];
            if (lane >= 4) gv = fminf(gv, 0.f) - log1pf(__expf(-fabsf(gv)));
            GATES[(size_t)m * 8 + lane] = gv; }
    }
}

__device__ __forceinline__ void attn_ref_body(Frame& F) {
    const bf16_t* PROJ = (const bf16_t*)(F.p.ws + WS_PROJ); float* OC = F.p.out;
    for (int idx = blockIdx.x * 512 + F.tid; idx < BATCH * 4 * 2 * SEQ; idx += F.G * 512) {
        const int q = idx & (SEQ - 1), c = (idx >> 11) & 1, h = (idx >> 12) & 3, b = idx >> 14;
        const int qmax = __builtin_amdgcn_readfirstlane(q | 63);
        const size_t rowb = (size_t)b * SEQ;
        float qv[64];
        { const bf16_t* qp = PROJ + (rowb + q) * NPROJ + C_QA + h * 128 + c * 64;
#pragma unroll
          for (int d = 0; d < 64; ++d) qv[d] = bf2f(qp[d]); }
        float o[128];
#pragma unroll
        for (int d = 0; d < 128; ++d) o[d] = 0.f;
        float m = -INFINITY, l = 0.f;
        for (int j = 0; j <= qmax; ++j) {
            const bf16_t* kp = PROJ + (rowb + j) * NPROJ + C_KA + h * 128 + c * 64; const bf16_t* vp = PROJ + (rowb + j) * NPROJ + C_VA + h * 128;
            float s = 0.f;
#pragma unroll
            for (int d = 0; d < 64; ++d) s += qv[d] * bf2f(kp[d]);
            if (j <= q) { const float mn = fmaxf(m, s), sc = exp2f(m - mn), pr = exp2f(s - mn); l = l * sc + pr; m = mn;
#pragma unroll
                for (int d = 0; d < 128; ++d) o[d] = o[d] * sc + pr * bf2f(vp[d]); }
        }
        const float rl = 1.f / l; float* op = OC + ((size_t)c * T + rowb + q) * 512 + h * 128;
#pragma unroll
        for (int d = 0; d < 128; ++d) op[d] = o[d] * rl;
    }
}
__device__ __forceinline__ void attn_combine_body(Frame& F) {
    const float* OC = F.p.out; bf16_t* MIX = (bf16_t*)(F.p.ws + WS_MIX); const float* lam_qk = F.p.lam_qk; const int lane = F.lane;
    const float lam = __expf(wave_sum(lam_qk[lane] * lam_qk[64 + lane])) - __expf(wave_sum(lam_qk[128 + lane] * lam_qk[192 + lane])) + LAMBDA_INIT;
    for (int w = F.vcu * NWAVES + F.wave; w < T * 4; w += F.G * NWAVES) { const int row = w >> 2, h = w & 3;
        const float* o1 = OC + (size_t)row * 512 + h * 128; const float* o2 = OC + ((size_t)T + row) * 512 + h * 128;
        const float v0 = o1[lane] - lam * o2[lane], v1 = o1[lane + 64] - lam * o2[lane + 64];
        const float rs = 1.f / sqrtf(wave_sum(v0 * v0 + v1 * v1) * (1.f / 128.f) + RMS_EPS) * (1.f - LAMBDA_INIT);
        bf16_t* o = MIX + (size_t)row * D + h * 128;
        o[lane] = (bf16_t)f2bf(v0 * rs * F.p.subln_g[lane]); o[lane + 64] = (bf16_t)f2bf(v1 * rs * F.p.subln_g[lane + 64]); }
}
__device__ __forceinline__ void mlstm_ref_body(Frame& F, int bh) {
    const bf16_t* PROJ = (const bf16_t*)(F.p.ws + WS_PROJ); const float* GATES = (const float*)(F.p.ws + WS_GATES); bf16_t* MIX = (bf16_t*)(F.p.ws + WS_MIX);
    LAS float* sq = (LAS float*)(F.lds + RING_OFF); LAS float* sk = sq + 128; LAS float* sv = sk + 128; LAS float* so = sv + 128; LAS float* sh = so + 128;
    const int tid = F.tid, v = tid >> 2, kg = tid & 3; const int b = bh >> 2, h = bh & 3;
    float C[32], n[32];
#pragma unroll
    for (int i = 0; i < 32; ++i) { C[i] = 0.f; n[i] = 0.f; }
    float m = 0.f;
    for (int t = 0; t < SEQ; ++t) {
        const size_t row = (size_t)b * SEQ + t;
        if (tid < 256) { const int cc = (tid < 128) ? h * 128 + tid : 512 + h * 128 + (tid - 128);
            float y = F.p.conv_b[cc];
#pragma unroll
            for (int j = 0; j < 4; ++j) { const int tt = t - 3 + j; if (tt >= 0) y += F.p.conv_w[j * 1024 + cc] * bf2f(PROJ[((size_t)b * SEQ + tt) * NPROJ + C_QM + cc]); }
            const float sl = y * sigmoidf_(y);
            if (tid < 128) sq[tid] = sl; else sk[tid - 128] = sl * 0.08838834764831845f; }
        else if (tid < 384) sv[tid - 256] = bf2f(PROJ[row * NPROJ + C_VM + h * 128 + (tid - 256)]);
        else so[tid - 384] = bf2f(PROJ[row * NPROJ + C_OM + h * 128 + (tid - 384)]);
        __syncthreads();
        const float li = GATES[row * 8 + h], lf = GATES[row * 8 + 4 + h];
        const float mn = fmaxf(lf + m, li), fd = __expf(lf + m - mn), ii = __expf(li - mn);
        float pn = 0.f, pd = 0.f; const float vv = sv[v] * ii;
#pragma unroll
        for (int i = 0; i < 32; ++i) { const float kk = sk[kg * 32 + i], qq = sq[kg * 32 + i]; C[i] = fd * C[i] + vv * kk; n[i] = fd * n[i] + ii * kk; pn += C[i] * qq; pd += n[i] * qq; }
        pn += __shfl_xor(pn, 1); pn += __shfl_xor(pn, 2);
        pd += __shfl_xor(pd, 1); pd += __shfl_xor(pd, 2);
        const float hv = pn / fmaxf(fabsf(pd), __expf(-mn));
        if (kg == 0) sh[v] = hv * sigmoidf_(so[v]);
        m = mn;
        __syncthreads();
        if (tid < 128) { float ss = 0.f;
            for (int i = 0; i < 128; ++i) ss += sh[i] * sh[i];
            MIX[row * D + 512 + h * 128 + tid] = (bf16_t)f2bf(sh[tid] * (1.f / sqrtf(ss * (1.f / 128.f) + RMS_EPS)) * F.p.mhnorm_g[h * 128 + tid]); }
        __syncthreads();
    }
}

__device__ __forceinline__ void router_ref_body(Frame& F) {
    const Ptrs& p = F.p; const int lane = F.lane;
    const float* X1 = p.out; unsigned* ctl = F.ctl; int* list = (int*)(p.ws + WS_LIST); float* tokw = (float*)(p.ws + WS_TOKW); float* rstd_o = (float*)(p.ws + WS_RSTD);
    for (int tok = F.vcu * NWAVES + F.wave; tok < T; tok += F.G * NWAVES) {
        float hv[16]; float s = 0.f;
#pragma unroll
        for (int j = 0; j < 4; ++j) { const f32x4 v = ((const f32x4*)(X1 + (size_t)tok * D))[lane + 64 * j]; hv[4 * j] = v.x; hv[4 * j + 1] = v.y; hv[4 * j + 2] = v.z; hv[4 * j + 3] = v.w; s += (v.x * v.x + v.y * v.y) + (v.z * v.z + v.w * v.w); }
        const float rstd = 1.f / sqrtf(wave_sum(s) * (1.f / D) + RMS_EPS);
#pragma unroll
        for (int j = 0; j < 4; ++j)
#pragma unroll
            for (int q = 0; q < 4; ++q) hv[4 * j + q] *= rstd * p.g_ffn[256 * j + 4 * lane + q];
        float gl[4];
#pragma unroll
        for (int g = 0; g < 4; ++g) { float a = 0.f;
#pragma unroll
            for (int j = 0; j < 4; ++j)
#pragma unroll
                for (int q = 0; q < 4; ++q) a += hv[4 * j + q] * p.w_grp[(size_t)(256 * j + 4 * lane + q) * 4 + g];
            gl[g] = wave_sum(a) + p.b_grp[g]; }
        int gs = 0; float gm = gl[0];
#pragma unroll
        for (int g = 1; g < 4; ++g) if (gl[g] > gm) { gm = gl[g]; gs = g; }
        float gsum = 0.f;
#pragma unroll
        for (int g = 0; g < 4; ++g) gsum += __expf(gl[g] - gm);
        const float gwt = 1.f / gsum;
        float el[8];
#pragma unroll
        for (int e = 0; e < 8; ++e) { float a = 0.f;
#pragma unroll
            for (int j = 0; j < 4; ++j)
#pragma unroll
                for (int q = 0; q < 4; ++q) a += hv[4 * j + q] * p.w_er[((size_t)gs * 1024 + 256 * j + 4 * lane + q) * 8 + e];
            el[e] = wave_sum(a) + p.b_er[gs * 8 + e]; }
        int i0 = 0; float v0 = el[0];
#pragma unroll
        for (int e = 1; e < 8; ++e) if (el[e] > v0) { v0 = el[e]; i0 = e; }
        int i1 = -1; float v1 = -INFINITY;
#pragma unroll
        for (int e = 0; e < 8; ++e) if (e != i0 && el[e] > v1) { v1 = el[e]; i1 = e; }
        const float e1 = __expf(v1 - v0), w0 = gwt / (1.f + e1), w1 = gwt * e1 / (1.f + e1);
        if (lane == 0) {
            const int ea = gs * 8 + i0, eb = gs * 8 + i1;
            const unsigned sa = atomicAdd(&ctl[CW_CNT + 64 * ea], 1u); list[(size_t)ea * LIST_CAP + sa] = tok * 2;
            const unsigned sb = atomicAdd(&ctl[CW_CNT + 64 * eb], 1u); list[(size_t)eb * LIST_CAP + sb] = tok * 2 + 1;
            tokw[tok * 2] = w0; tokw[tok * 2 + 1] = w1; rstd_o[tok] = rstd; }
    }
}
__device__ __forceinline__ void final_body(Frame& F) {
    const Ptrs& p = F.p; const int lane = F.lane; float* X1 = p.out; const bf16_t* Y = (const bf16_t*)(p.ws + WS_Y);
    for (size_t tok = F.vcu * NWAVES + F.wave; tok < T; tok += F.G * NWAVES) {
        f32x4 v[4]; float s = 0.f;
#pragma unroll
        for (int j = 0; j < 4; ++j) { v[j] = ((const f32x4*)(X1 + tok * D))[lane + 64 * j];
            const u32x2 a = ((const u32x2*)(Y + (2 * tok) * D))[lane + 64 * j], b = ((const u32x2*)(Y + (2 * tok + 1) * D))[lane + 64 * j];
            v[j].x += bf2f(a.x & 0xffffu) + bf2f(b.x & 0xffffu); v[j].y += bf2f(a.x >> 16) + bf2f(b.x >> 16); v[j].z += bf2f(a.y & 0xffffu) + bf2f(b.y & 0xffffu); v[j].w += bf2f(a.y >> 16) + bf2f(b.y >> 16);
            s += (v[j].x * v[j].x + v[j].y * v[j].y) + (v[j].z * v[j].z + v[j].w * v[j].w); }
        const float rstd = 1.f / sqrtf(wave_sum(s) * (1.f / D) + RMS_EPS);
#pragma unroll
        for (int j = 0; j < 4; ++j) { const f32x4 g = ((const f32x4*)p.g_final)[lane + 64 * j]; ((f32x4*)(X1 + tok * D))[lane + 64 * j] = v[j] * rstd * g; }
    }
}
__device__ __forceinline__ void moe_tables(Frame& F) {
    LAS int* tab = (LAS int*)(F.lds + TAB_OFF);
    if (F.tid == 0) { int us = 0, ps = 0;
        for (int e = 0; e < NE; ++e) { const int c = (int)__hip_atomic_load(F.ctl + CW_CNT + 64 * e, RLX_AGENT); const int nb = (c + 255) >> 8;
            tab[e] = us; tab[64 + e] = ps; tab[128 + e] = c; us += nb * 4; ps += nb * 256; }
        tab[32] = us; tab[96] = ps; }
    __syncthreads();
}


namespace att {
typedef float f32x16 __attribute__((ext_vector_type(16)));
typedef short s16x4 __attribute__((ext_vector_type(4)));
constexpr int STAGE = 32768, VOFF = 16384, XCH_OFF = 65536;
constexpr int ROWB = NPROJ * 2;
__device__ __forceinline__ int crow(int r, int hi) { return (r & 3) + 8 * (r >> 2) + 4 * hi; }
__device__ __forceinline__ unsigned swz(unsigned row) { return ((row & 3u) << 2) | ((row >> 2) & 3u); }
__device__ __forceinline__ s16x4 trrd(const LAS unsigned char* p) { return __builtin_bit_cast(s16x4, __builtin_amdgcn_ds_read_tr16_b64_v4i16((LAS s16x4*)p)); }

__device__ __forceinline__ void attn_unit(Frame& F, int bh, int qb, float lam) {
    LAS unsigned char* lds = F.lds + RING_OFF;
    const int lane = F.lane, wid = F.wave, c = wid >> 2, wq = wid & 3, r32 = lane & 31, hi = lane >> 5;
    const int b = bh >> 2, h = bh & 3, q0 = qb * 128, qlo = q0 + 32 * wq;
    const char* projb = (const char*)(F.p.ws + WS_PROJ) + (size_t)(b * SEQ) * ROWB;
    const char* kg = projb + (C_KA + h * 128) * 2; const char* vg = projb + (C_VA + h * 128) * 2;
    unsigned srcoff[2];
#pragma unroll
    for (int n = 0; n < 2; ++n) { const unsigned row = 4u * (wid + 8 * n) + (lane >> 4), slot = lane & 15; srcoff[n] = row * ROWB + ((slot ^ swz(row)) << 4); }
#define ATT_DMA(t, st) do { _Pragma("unroll") for (int _n = 0; _n < 2; ++_n) { \
        __builtin_amdgcn_global_load_lds((const unsigned*)(kg + (size_t)(t) * 64 * ROWB + srcoff[_n]), (LAS unsigned*)(lds + (st) * STAGE + (wid + 8 * _n) * 1024), 16, 0, 0); \
        __builtin_amdgcn_global_load_lds((const unsigned*)(vg + (size_t)(t) * 64 * ROWB + srcoff[_n]), (LAS unsigned*)(lds + (st) * STAGE + VOFF + (wid + 8 * _n) * 1024), 16, 0, 0); } } while (0)
    bf16x8 qf[4];
    { const bf16_t* qp = (const bf16_t*)(projb + (size_t)(qlo + r32) * ROWB) + C_QA + h * 128 + c * 64 + 8 * hi;
#pragma unroll
      for (int s = 0; s < 4; ++s) qf[s] = *(const bf16x8*)(qp + 16 * s); }
    unsigned kaddr[4], vaddr[2][4];
#pragma unroll
    for (int s = 0; s < 4; ++s) kaddr[s] = 256u * r32 + 16u * ((unsigned)(8 * c + 2 * s + hi) ^ swz(r32));
    { const unsigned blk = (lane >> 4) & 1, q = (lane & 15) >> 2, p = lane & 3;
#pragma unroll
      for (int t2 = 0; t2 < 2; ++t2)
#pragma unroll
          for (int dt = 0; dt < 4; ++dt) { const unsigned row = 8u * t2 + 4u * hi + q; vaddr[t2][dt] = 256u * row + 16u * ((4u * dt + 2u * blk + (p >> 1)) ^ swz(row)) + 8u * (p & 1); } }
    f32x16 o[4];
#pragma unroll
    for (int dt = 0; dt < 4; ++dt)
#pragma unroll
        for (int r = 0; r < 16; ++r) o[dt][r] = 0.f;
    float m = -INFINITY, l = 0.f;
    const int NT = 2 * qb + 2;
    ATT_DMA(0, 0);
    for (int t = 0; t < NT; ++t) {
        asm volatile("s_waitcnt vmcnt(0)" ::: "memory"); __builtin_amdgcn_s_barrier(); asm volatile("" ::: "memory");
        if (t + 1 < NT) ATT_DMA(t + 1, (t + 1) & 1);
        if (64 * t <= qlo + 31) {
            const LAS unsigned char* kb = lds + (t & 1) * STAGE; const LAS unsigned char* vb = kb + VOFF;
            f32x16 p0, p1;
#pragma unroll
            for (int r = 0; r < 16; ++r) { p0[r] = 0.f; p1[r] = 0.f; }
#pragma unroll
            for (int s = 0; s < 4; ++s) { const bf16x8 k0 = *(const LAS bf16x8*)(kb + kaddr[s]), k1 = *(const LAS bf16x8*)(kb + 8192 + kaddr[s]);
                p0 = __builtin_amdgcn_mfma_f32_32x32x16_bf16(k0, qf[s], p0, 0, 0, 0); p1 = __builtin_amdgcn_mfma_f32_32x32x16_bf16(k1, qf[s], p1, 0, 0, 0); }
            if (64 * t + 63 > qlo) { const int qg = qlo + r32;
#pragma unroll
                for (int r = 0; r < 16; ++r) { const int key = 64 * t + crow(r, hi); if (key > qg) p0[r] = -INFINITY; if (key + 32 > qg) p1[r] = -INFINITY; } }
            float rm = fmaxf(p0[0], p1[0]);
#pragma unroll
            for (int r = 1; r < 16; ++r) rm = fmaxf(rm, fmaxf(p0[r], p1[r]));
            rm = fmaxf(rm, __shfl_xor(rm, 32));
            const float mn = fmaxf(m, rm), alpha = __builtin_amdgcn_exp2f(m - mn); m = mn;
            float rs = 0.f;
#pragma unroll
            for (int r = 0; r < 16; ++r) { p0[r] = __builtin_amdgcn_exp2f(p0[r] - mn); p1[r] = __builtin_amdgcn_exp2f(p1[r] - mn); rs += p0[r] + p1[r]; }
            l = l * alpha + rs;
#pragma unroll
            for (int dt = 0; dt < 4; ++dt)
#pragma unroll
                for (int r = 0; r < 16; ++r) o[dt][r] *= alpha;
            bf16x8 pf[4];
#pragma unroll
            for (int ks = 0; ks < 4; ++ks) { u32x4 w;
#pragma unroll
                for (int j = 0; j < 4; ++j) { const int r = 8 * (ks & 1) + 2 * j; w[j] = (ks < 2) ? pg8::cvt_pk_bf16(p0[r], p0[r + 1]) : pg8::cvt_pk_bf16(p1[r], p1[r + 1]); }
                pf[ks] = __builtin_bit_cast(bf16x8, w); }
#pragma unroll
            for (int dt = 0; dt < 4; ++dt)
#pragma unroll
                for (int ks = 0; ks < 4; ++ks) { const s16x4 lo = trrd(vb + vaddr[0][dt] + 4096 * ks), hh = trrd(vb + vaddr[1][dt] + 4096 * ks);
                    const bf16x8 vf = (bf16x8){lo[0], lo[1], lo[2], lo[3], hh[0], hh[1], hh[2], hh[3]};
                    o[dt] = __builtin_amdgcn_mfma_f32_32x32x16_bf16(vf, pf[ks], o[dt], 0, 0, 0); }
        }
    }
    asm volatile("s_waitcnt lgkmcnt(0)" ::: "memory"); __builtin_amdgcn_s_barrier(); asm volatile("" ::: "memory");
    l += __shfl_xor(l, 32);
    const float inv = 1.f / l;
    LAS float* xch = (LAS float*)(lds + XCH_OFF + wq * 16384);
    if (c == 1) {
#pragma unroll
        for (int dt = 0; dt < 4; ++dt)
#pragma unroll
            for (int r = 0; r < 16; ++r) xch[(dt * 16 + r) * 64 + lane] = o[dt][r] * inv;
    }
    asm volatile("s_waitcnt lgkmcnt(0)" ::: "memory"); __builtin_amdgcn_s_barrier(); asm volatile("" ::: "memory");
    if (c == 0) {
        float ss = 0.f;
#pragma unroll
        for (int dt = 0; dt < 4; ++dt)
#pragma unroll
            for (int r = 0; r < 16; ++r) { const float v = o[dt][r] * inv - lam * xch[(dt * 16 + r) * 64 + lane]; o[dt][r] = v; ss += v * v; }
        ss += __shfl_xor(ss, 32);
        const float rsn = (1.f - LAMBDA_INIT) / sqrtf(ss * (1.f / 128.f) + RMS_EPS);
        bf16_t* orow = (bf16_t*)(F.p.ws + WS_MIX) + (size_t)(b * SEQ + qlo + r32) * D + h * 128;
#pragma unroll
        for (int dt = 0; dt < 4; ++dt)
#pragma unroll
            for (int r4 = 0; r4 < 4; ++r4) { const int dv = 32 * dt + 8 * r4 + 4 * hi; const f32x4 g = *(const f32x4*)(F.p.subln_g + dv);
                u32x2 w; w.x = pg8::cvt_pk_bf16(o[dt][4 * r4] * rsn * g[0], o[dt][4 * r4 + 1] * rsn * g[1]); w.y = pg8::cvt_pk_bf16(o[dt][4 * r4 + 2] * rsn * g[2], o[dt][4 * r4 + 3] * rsn * g[3]);
                *(u32x2*)(orow + dv) = w; }
    }
#undef ATT_DMA
}

__device__ __forceinline__ void attn_phase(Frame& F) {
    const float* lq = F.p.lam_qk; const int lane = F.lane;
    const float lam = __expf(wave_sum(lq[lane] * lq[64 + lane])) - __expf(wave_sum(lq[128 + lane] * lq[192 + lane])) + LAMBDA_INIT;
    volatile LAS unsigned* qw = (volatile LAS unsigned*)(F.lds + LDSCTL_OFF + 32);
    for (;;) {
        if (F.tid == 0) *qw = __hip_atomic_fetch_add(F.ctl + CW_QATT, 1u, __ATOMIC_RELAXED, __HIP_MEMORY_SCOPE_AGENT);
        __syncthreads();
        const unsigned u = (unsigned)__builtin_amdgcn_readfirstlane((int)*qw);
        if (u >= 1024u) break;
        attn_unit(F, (int)(u & 63u), 15 - (int)(u >> 6), lam);
    }
}
}

namespace ml {
typedef short s16x4 __attribute__((ext_vector_type(4)));
constexpr int KI = 0, VI = 32768, CB = 65536, BARR = 102400, AARR = 110592, GARR = 118784, PC = 126976, CWL = 129024, ML_END = 134144;
constexpr int ROWB = NPROJ * 2;
__device__ __forceinline__ unsigned swz(unsigned row) { return ((row & 3u) << 2) | ((row >> 2) & 3u); }
__device__ __forceinline__ unsigned off_b(unsigned row, unsigned ch) { return 256u * row + 16u * (ch ^ swz(row)); }
__device__ __forceinline__ s16x4 trrd(const LAS unsigned char* p) { return __builtin_bit_cast(s16x4, __builtin_amdgcn_ds_read_tr16_b64_v4i16((LAS s16x4*)p)); }
__device__ __forceinline__ f32x4 mfma16(bf16x8 a, bf16x8 b, f32x4 c) { return __builtin_amdgcn_mfma_f32_16x16x32_bf16(a, b, c, 0, 0, 0); }

__device__ __forceinline__ void conv8(const bf16_t* src, int t, const LAS float* cw, const LAS float* cb, int lc, float scale, float (&out)[8]) {
    float y[8];
    { const f32x4 b0 = *(const LAS f32x4*)(cb + lc), b1 = *(const LAS f32x4*)(cb + lc + 4); y[0] = b0[0]; y[1] = b0[1]; y[2] = b0[2]; y[3] = b0[3]; y[4] = b1[0]; y[5] = b1[1]; y[6] = b1[2]; y[7] = b1[3]; }
#pragma unroll
    for (int j = 0; j < 4; ++j) { const int tt = t - 3 + j;
        if (tt >= 0) { const u32x4 raw = *(const u32x4*)(src + (ptrdiff_t)(j - 3) * NPROJ);
            const f32x4 w0 = *(const LAS f32x4*)(cw + j * 256 + lc), w1 = *(const LAS f32x4*)(cw + j * 256 + lc + 4);
            y[0] += w0[0] * bf2f(raw.x & 0xffffu); y[1] += w0[1] * bf2f(raw.x >> 16); y[2] += w0[2] * bf2f(raw.y & 0xffffu); y[3] += w0[3] * bf2f(raw.y >> 16);
            y[4] += w1[0] * bf2f(raw.z & 0xffffu); y[5] += w1[1] * bf2f(raw.z >> 16); y[6] += w1[2] * bf2f(raw.w & 0xffffu); y[7] += w1[3] * bf2f(raw.w >> 16); } }
#pragma unroll
    for (int e = 0; e < 8; ++e) out[e] = y[e] * scale / (1.f + __expf(-y[e]));
}
__device__ __forceinline__ bf16x8 pack8(const float (&v)[8]) { u32x4 w; w.x = pg8::cvt_pk_bf16(v[0], v[1]); w.y = pg8::cvt_pk_bf16(v[2], v[3]); w.z = pg8::cvt_pk_bf16(v[4], v[5]); w.w = pg8::cvt_pk_bf16(v[6], v[7]); return __builtin_bit_cast(bf16x8, w); }

__device__ __forceinline__ void mlstm_unit(Frame& F, int bh) {
    LAS unsigned char* lds = F.lds + RING_OFF;
    const int tid = F.tid, lane = F.lane, w = F.wave, l15 = lane & 15, g = lane >> 4, q = l15 >> 2, p = lane & 3;
    const int b = bh >> 2, h = bh & 3; const size_t rowb = (size_t)b * SEQ;
    const bf16_t* PROJ = (const bf16_t*)(F.p.ws + WS_PROJ); const float* GATES = (const float*)(F.p.ws + WS_GATES); bf16_t* MIX = (bf16_t*)(F.p.ws + WS_MIX);
    LAS float* barr = (LAS float*)(lds + BARR); LAS float* aarr = (LAS float*)(lds + AARR); LAS float* garr = (LAS float*)(lds + GARR);
    LAS float* pc_u = (LAS float*)(lds + PC); LAS float* pc_sci = pc_u + 128; LAS float* pc_ws = pc_u + 256; LAS float* pc_emr = pc_u + 384;
    LAS float* cw = (LAS float*)(lds + CWL); LAS float* cb = cw + 1024;
    for (int i = tid; i < 36864 / 16; i += 512) *(LAS u32x4*)(lds + CB + 16 * i) = (u32x4){0u, 0u, 0u, 0u};
    for (int i = tid; i < 1024; i += 512) { const int j = i >> 8, lc = i & 255; const int cc = (lc < 128) ? h * 128 + lc : 512 + h * 128 + (lc - 128); cw[i] = F.p.conv_w[j * 1024 + cc]; if (j == 0) cb[lc] = F.p.conv_b[cc]; }
    for (int i = tid; i < SEQ; i += 512) { aarr[i] = GATES[(rowb + i) * 8 + h]; garr[i] = GATES[(rowb + i) * 8 + 4 + h]; }
    __syncthreads();
    for (int i = tid; i < SEQ; i += 512) { float s = 0.f; for (int j = i & ~127; j <= i; ++j) s += garr[j]; barr[i] = s; }
    __syncthreads();
    for (int i = tid; i < SEQ; i += 512) aarr[i] = aarr[i] - barr[i];
    __syncthreads();
    for (int i = tid; i < SEQ; i += 512) { float mx = -INFINITY; for (int j = i & ~127; j <= i; ++j) mx = fmaxf(mx, aarr[j]); garr[i] = mx; }
    __syncthreads();
    f32x4 accC[9];
#pragma unroll
    for (int vt = 0; vt < 9; ++vt) accC[vt] = (f32x4){0.f, 0.f, 0.f, 0.f};
    float mcur = 0.f;
    const bf16x8 onesf = (l15 == 0) ? (bf16x8){0x3F80, 0x3F80, 0x3F80, 0x3F80, 0x3F80, 0x3F80, 0x3F80, 0x3F80} : (bf16x8){0, 0, 0, 0, 0, 0, 0, 0};
    unsigned vsrc[4];
#pragma unroll
    for (int n = 0; n < 4; ++n) { const unsigned row = 4u * (w + 8 * n) + (lane >> 4), slot = lane & 15; vsrc[n] = row * ROWB + ((slot ^ swz(row)) << 4); }

    for (int ci = 0; ci < 16; ++ci) {
        const int t0 = ci * 128;
        const float bL = barr[t0 + 127], gend = garr[t0 + 127];
        const float mnew = bL + fmaxf(mcur, gend), sc = __expf(bL + mcur - mnew);
        if (tid < 128) { const float bt = barr[t0 + tid], mrow = bt + fmaxf(mcur, garr[t0 + tid]);
            pc_u[tid] = bt - mrow; pc_sci[tid] = __expf(bt + mcur - mrow); pc_ws[tid] = __expf(bL - mnew + aarr[t0 + tid]); pc_emr[tid] = __expf(-mrow); }
        { const char* vg = (const char*)(PROJ + (rowb + t0) * NPROJ + C_VM + h * 128);
#pragma unroll
          for (int n = 0; n < 4; ++n) __builtin_amdgcn_global_load_lds((const unsigned*)(vg + vsrc[n]), (LAS unsigned*)(lds + VI + (w + 8 * n) * 1024), 16, 0, 0); }
        { const int s = tid & 127, kq = tid >> 7; const bf16_t* src = PROJ + (rowb + t0 + s) * NPROJ + C_KM + h * 128 + 32 * kq;
#pragma unroll
          for (int j = 0; j < 4; ++j) { float o8[8]; conv8(src + 8 * j, t0 + s, cw, cb, 128 + 32 * kq + 8 * j, 0.08838834764831845f, o8);
              *(LAS bf16x8*)(lds + KI + off_b(s, 4 * kq + j)) = pack8(o8); } }
        bf16x8 qf[4];
        { const int t = t0 + 16 * w + l15; const bf16_t* src = PROJ + (rowb + t) * NPROJ + C_QM + h * 128 + 8 * g;
#pragma unroll
          for (int ks = 0; ks < 4; ++ks) { float o8[8]; conv8(src + 32 * ks, t, cw, cb, 32 * ks + 8 * g, 1.f, o8); qf[ks] = pack8(o8); } }
        asm volatile("s_waitcnt vmcnt(0) lgkmcnt(0)" ::: "memory"); __builtin_amdgcn_s_barrier(); asm volatile("" ::: "memory");
        const float ut = pc_u[16 * w + l15];
        bf16x8 smf[4];
#pragma unroll
        for (int i = 0; i < 4; ++i) {
            float sv[8];
#pragma unroll
            for (int hh = 0; hh < 2; ++hh) { const int st = 2 * i + hh;
                if (st <= w) { f32x4 acc = (f32x4){0.f, 0.f, 0.f, 0.f};
#pragma unroll
                    for (int ks = 0; ks < 4; ++ks) acc = mfma16(*(const LAS bf16x8*)(lds + KI + off_b(16 * st + l15, 4 * ks + g)), qf[ks], acc);
                    const f32x4 a4 = *(const LAS f32x4*)(aarr + t0 + 16 * st + 4 * g);
#pragma unroll
                    for (int r = 0; r < 4; ++r) { float v = __expf(ut + a4[r]) * acc[r]; if (st == w && (4 * g + r) > l15) v = 0.f; sv[4 * hh + r] = v; } }
                else {
#pragma unroll
                    for (int r = 0; r < 4; ++r) sv[4 * hh + r] = 0.f; } }
            smf[i] = pack8(sv); }
        const float scit = pc_sci[16 * w + l15];
        f32x4 num[9];
#pragma unroll
        for (int vt = 0; vt < 9; ++vt) { f32x4 acc = (f32x4){0.f, 0.f, 0.f, 0.f};
#pragma unroll
            for (int ks = 0; ks < 4; ++ks) acc = mfma16(*(const LAS bf16x8*)(lds + CB + off_b(16 * vt + l15, 4 * ks + g)), qf[ks], acc);
            acc = acc * scit;
#pragma unroll
            for (int i = 0; i < 4; ++i) { if (2 * i <= w) { bf16x8 vf;
                    if (vt < 8) { const s16x4 lo = trrd(lds + VI + off_b(32 * i + 4 * g + q, 2 * vt + (p >> 1)) + 8 * (p & 1)), hi = trrd(lds + VI + off_b(32 * i + 16 + 4 * g + q, 2 * vt + (p >> 1)) + 8 * (p & 1));
                        vf = (bf16x8){lo[0], lo[1], lo[2], lo[3], hi[0], hi[1], hi[2], hi[3]}; }
                    else vf = onesf;
                    acc = mfma16(vf, smf[i], acc); } }
            num[vt] = acc; }
        { const int t = t0 + 16 * w + l15;
          const float den = __shfl(num[8][0], l15); const float hd = 1.f / fmaxf(fabsf(den), pc_emr[16 * w + l15]);
          const bf16_t* omp = PROJ + (rowb + t) * NPROJ + C_OM + h * 128 + 4 * g; float ss = 0.f;
#pragma unroll
          for (int vt = 0; vt < 8; ++vt) { const u32x2 ow = *(const u32x2*)(omp + 16 * vt);
              const float o0 = bf2f(ow.x & 0xffffu), o1 = bf2f(ow.x >> 16), o2 = bf2f(ow.y & 0xffffu), o3 = bf2f(ow.y >> 16);
              f32x4 hv = num[vt] * hd; hv[0] *= sigmoidf_(o0); hv[1] *= sigmoidf_(o1); hv[2] *= sigmoidf_(o2); hv[3] *= sigmoidf_(o3);
              num[vt] = hv; ss += (hv[0] * hv[0] + hv[1] * hv[1]) + (hv[2] * hv[2] + hv[3] * hv[3]); }
          ss += __shfl_xor(ss, 16); ss += __shfl_xor(ss, 32);
          const float rs = 1.f / sqrtf(ss * (1.f / 128.f) + RMS_EPS);
          bf16_t* op = MIX + (rowb + t) * D + 512 + h * 128 + 4 * g; const float* gp = F.p.mhnorm_g + h * 128 + 4 * g;
#pragma unroll
          for (int vt = 0; vt < 8; ++vt) { const f32x4 gg = *(const f32x4*)(gp + 16 * vt); const f32x4 hv = num[vt] * rs * gg;
              u32x2 ww; ww.x = pg8::cvt_pk_bf16(hv[0], hv[1]); ww.y = pg8::cvt_pk_bf16(hv[2], hv[3]); *(u32x2*)(op + 16 * vt) = ww; } }
        asm volatile("s_waitcnt lgkmcnt(0)" ::: "memory"); __builtin_amdgcn_s_barrier(); asm volatile("" ::: "memory");
        { bf16x8 kf[4];
#pragma unroll
          for (int i = 0; i < 4; ++i) { float kv[8];
#pragma unroll
              for (int t2 = 0; t2 < 2; ++t2) { const s16x4 raw = trrd(lds + KI + off_b(32 * i + 8 * g + 4 * t2 + q, 2 * w + (p >> 1)) + 8 * (p & 1)); const f32x4 w4 = *(const LAS f32x4*)(pc_ws + 32 * i + 8 * g + 4 * t2);
#pragma unroll
                  for (int e = 0; e < 4; ++e) kv[4 * t2 + e] = bf2f((unsigned)(unsigned short)raw[e]) * w4[e]; }
              kf[i] = pack8(kv); }
#pragma unroll
          for (int vt = 0; vt < 9; ++vt) { f32x4 acc = accC[vt] * sc;
#pragma unroll
              for (int i = 0; i < 4; ++i) { bf16x8 vf;
                  if (vt < 8) { const s16x4 lo = trrd(lds + VI + off_b(32 * i + 8 * g + q, 2 * vt + (p >> 1)) + 8 * (p & 1)), hi = trrd(lds + VI + off_b(32 * i + 8 * g + 4 + q, 2 * vt + (p >> 1)) + 8 * (p & 1));
                      vf = (bf16x8){lo[0], lo[1], lo[2], lo[3], hi[0], hi[1], hi[2], hi[3]}; }
                  else vf = onesf;
                  acc = mfma16(kf[i], vf, acc); }
              accC[vt] = acc;
              u32x2 ww; ww.x = pg8::cvt_pk_bf16(acc[0], acc[1]); ww.y = pg8::cvt_pk_bf16(acc[2], acc[3]);
              *(LAS u32x2*)(lds + CB + off_b(16 * vt + l15, 2 * w + (g >> 1)) + 8 * (g & 1)) = ww; } }
        mcur = mnew;
        asm volatile("s_waitcnt lgkmcnt(0)" ::: "memory"); __builtin_amdgcn_s_barrier(); asm volatile("" ::: "memory");
    }
}
}
#ifndef ATT_FAST
#define ATT_FAST 1
#endif
#ifndef ML_FAST
#define ML_FAST 1
#endif
struct Args { Ptrs p; int ph_lo, ph_hi; };
constexpr int N_PHASES = 9;
__global__ void __launch_bounds__(NWAVES * 64, 2) mk_fwd(Args args) {
    extern __shared__ __attribute__((aligned(16))) unsigned char lds_raw[];
    Frame F;
    F.lds = (LAS unsigned char*)lds_raw; F.p = args.p;
    F.tid = threadIdx.x; F.lane = F.tid & 63; F.wave = __builtin_amdgcn_readfirstlane(F.tid >> 6);
    F.G = gridDim.x; { const int bx = blockIdx.x; F.vcu = (F.G % 8 == 0) ? (bx % 8) * (F.G / 8) + bx / 8 : bx; }
    F.ctl = (unsigned*)(args.p.ws + WS_CTL);
    for (int u = F.tid; u < (LDS_BYTES - LDSCTL_OFF) / 4; u += NWAVES * 64) ((LAS unsigned*)(F.lds + LDSCTL_OFF))[u] = 0u;
    __syncthreads();
    XcdBarrier bar = xcd_barrier_post(F.ctl + CW_BAR, (volatile LAS unsigned*)(F.lds + MISC_OFF) + 8);
    const int lo = args.ph_lo, hi = args.ph_hi;
    unsigned char* ws = args.p.ws;
#define IN(k) (lo <= (k) && (k) < hi)
#define SEAM(k) do { if (IN(k) && IN((k) + 1)) xcd_barrier(bar); } while (0)

    if (IN(0)) { p0_prologue(F); }
    SEAM(0);
    if (IN(1)) {
        pg8::StaticOrder S; S.init(ws + WS_HB, ws + WS_WIN, T, NPROJ, D, F.G, (int)blockIdx.x);
        const float* cs = (const float*)(ws + WS_ROPE);
        pg8::EpiProj E{(bf16_t*)(ws + WS_PROJ), cs, cs + 2048 * 32};
        pg8::gemm_phase<pg8::EpiProj, pg8::StaticOrder, true, false>(F.lds + RING_OFF, D, S, E);
    }
    SEAM(1);
#if ATT_FAST
    if (IN(2)) { att::attn_phase(F); }
    SEAM(2);
#if ML_FAST
    if (IN(3)) { if (blockIdx.x < BATCH * 4) ml::mlstm_unit(F, (int)blockIdx.x); }
#else
    if (IN(3)) { if (blockIdx.x < BATCH * 4) mlstm_ref_body(F, (int)blockIdx.x); }
#endif
#else
    if (IN(2)) { attn_ref_body(F); }
    SEAM(2);
    if (IN(3)) { attn_combine_body(F); if (blockIdx.x < BATCH * 4) mlstm_ref_body(F, (int)blockIdx.x); }
#endif
    SEAM(3);
    if (IN(4)) {
        pg8::StaticOrder S; S.init(ws + WS_MIX, ws + WS_WOUT, T, D, D, F.G, (int)blockIdx.x);
        pg8::EpiOut E{F.p.x, F.p.out, (bf16_t*)(ws + WS_X1B)};
        pg8::gemm_phase<pg8::EpiOut, pg8::StaticOrder, true, false>(F.lds + RING_OFF, D, S, E);
    }
    SEAM(4);
    if (IN(5)) { router_ref_body(F); }
    SEAM(5);
    if (IN(6)) {
        moe_tables(F);
        pg8::MoeOrder S{(const LAS int*)(F.lds + TAB_OFF), F.G, F.vcu, (const char*)(ws + WS_X1B), (const char*)(ws + WS_W13), (size_t)1024 * 1024 * 2, (size_t)256 * 1024 * 2, 0, true, (const int*)(ws + WS_LIST), D};
        pg8::EpiUp E{(bf16_t*)(ws + WS_HD), (const float*)(ws + WS_RSTD), (const int*)(ws + WS_LIST)};
        pg8::gemm_phase<pg8::EpiUp, pg8::MoeOrder, true, true>(F.lds + RING_OFF, D, S, E);
    }
    SEAM(6);
    if (IN(7)) {
        moe_tables(F);
        pg8::MoeOrder S{(const LAS int*)(F.lds + TAB_OFF), F.G, F.vcu, (const char*)(ws + WS_HD), (const char*)(ws + WS_W2), (size_t)1024 * 512 * 2, (size_t)256 * 512 * 2, (size_t)DE * 2, false, (const int*)(ws + WS_LIST), DE};
        pg8::EpiDown E{(bf16_t*)(ws + WS_Y), (const float*)(ws + WS_TOKW), (const int*)(ws + WS_LIST)};
        pg8::gemm_phase<pg8::EpiDown, pg8::MoeOrder, true, false>(F.lds + RING_OFF, DE, S, E);
    }
    SEAM(7);
    if (IN(8)) { final_body(F); }
#undef IN
#undef SEAM
}

extern "C" void kernel_launch(void* const* d_in, const int* in_sizes, int n_in, void* d_out, int out_size, void* d_ws, size_t ws_size, hipStream_t stream) {
    static int grid = 0;
    if (grid == 0) {
        if (n_in != 19 || out_size != T * D || ws_size < WS_END) { fprintf(stderr, "kernel_launch: unexpected shapes (n_in %d out %d ws %zu)\n", n_in, out_size, ws_size); grid = -1; return; }
        int dev = 0, cus = 0, per_cu = 0;
        if (hipGetDevice(&dev) != hipSuccess || hipDeviceGetAttribute(&cus, hipDeviceAttributeMultiprocessorCount, dev) != hipSuccess) { grid = -1; return; }
        if (hipFuncSetAttribute((const void*)mk_fwd, hipFuncAttributeMaxDynamicSharedMemorySize, LDS_BYTES) != hipSuccess) { fprintf(stderr, "kernel_launch: hipFuncSetAttribute failed\n"); grid = -1; return; }
        if (hipOccupancyMaxActiveBlocksPerMultiprocessor(&per_cu, (const void*)mk_fwd, NWAVES * 64, LDS_BYTES) != hipSuccess || per_cu < 1) { fprintf(stderr, "kernel_launch: occupancy query says %d\n", per_cu); }
        (void)hipGetLastError();
        grid = cus;
    }
    if (grid < 0) return;
    Args a{};
    Ptrs& p = a.p;
    p.x = (const float*)d_in[0]; p.w_in = (const float*)d_in[1]; p.conv_w = (const float*)d_in[2]; p.conv_b = (const float*)d_in[3]; p.gate_b = (const float*)d_in[4];
    p.lam_qk = (const float*)d_in[5]; p.subln_g = (const float*)d_in[6]; p.mhnorm_g = (const float*)d_in[7]; p.w_out = (const float*)d_in[8]; p.g_mix = (const float*)d_in[9];
    p.g_ffn = (const float*)d_in[10]; p.w_grp = (const float*)d_in[11]; p.b_grp = (const float*)d_in[12]; p.w_er = (const float*)d_in[13]; p.b_er = (const float*)d_in[14];
    p.w1 = (const float*)d_in[15]; p.w3 = (const float*)d_in[16]; p.w2 = (const float*)d_in[17]; p.g_final = (const float*)d_in[18];
    p.out = (float*)d_out; p.ws = (unsigned char*)d_ws;
    if (hipMemsetAsync((char*)d_ws + WS_CTL, 0, CTL_ZERO_BYTES, stream) != hipSuccess) return;
    a.ph_lo = 0; a.ph_hi = N_PHASES;
    hipLaunchKernelGGL(mk_fwd, dim3(grid), dim3(NWAVES * 64), LDS_BYTES, stream, a);
}
```

```cpp
#include <hip/hip_runtime.h>
#include <cstdio>
#include <cstdint>

constexpr int BATCH = 16, SEQ = 2048, D = 1024, T = BATCH * SEQ;
constexpr int DIN = 3592, NPROJ = 3584;
constexpr int C_QA = 0, C_KA = 512, C_VA = 1024, C_QM = 1536, C_KM = 2048, C_VM = 2560, C_OM = 3072, C_IG = 3584, C_FG = 3588;
constexpr int NE = 32, EPG = 8, DE = 512;
constexpr float RMS_EPS = 1e-6f;
constexpr float LAMBDA_INIT = 0.2f;
constexpr float C2Q = 0.125f * 1.4426950408889634f;
constexpr int LIST_CAP = T;

constexpr size_t MiB = 1u << 20;
constexpr size_t WS_CTL = 0, CTL_ZERO_BYTES = 1 * MiB;
constexpr size_t WS_ROPE = 1 * MiB;
constexpr size_t WS_TOKW = 2 * MiB;
constexpr size_t WS_RSTD = 2 * MiB + 512 * 1024;
constexpr size_t WS_WR = 3 * MiB;
constexpr size_t WS_LIST = 4 * MiB;
constexpr size_t WS_GATES = 8 * MiB;
constexpr size_t WS_WIN = 10 * MiB;
constexpr size_t WS_WOUT = 17 * MiB;
constexpr size_t WS_W13 = 20 * MiB;
constexpr size_t WS_W2 = 84 * MiB;
constexpr size_t WS_PROJ = 116 * MiB;
constexpr size_t WS_MIX = 340 * MiB;
constexpr size_t WS_X1B = 404 * MiB;
constexpr size_t WS_HB = 404 * MiB;
constexpr size_t WS_HD = 116 * MiB;
constexpr size_t WS_Y = 188 * MiB;
constexpr size_t WS_END = 468 * MiB;
constexpr int CW_TMO = 0, CW_CODE = 1;
constexpr int CW_CNT = 1024;
constexpr int CW_BAR = 4096;
constexpr int CW_QATT = 8192;

#define LAS __attribute__((address_space(3)))
typedef unsigned short bf16_t;
typedef short bf16x8 __attribute__((ext_vector_type(8)));
typedef float f32x4 __attribute__((ext_vector_type(4)));
typedef unsigned u32x4 __attribute__((ext_vector_type(4)));
typedef unsigned u32x2 __attribute__((ext_vector_type(2)));

__device__ __forceinline__ unsigned f2bf(float f) { unsigned u = __float_as_uint(f); return (u + 0x7fffu + ((u >> 16) & 1u)) >> 16; }
__device__ __forceinline__ unsigned pk2(float lo, float hi) { return f2bf(lo) | (f2bf(hi) << 16); }
__device__ __forceinline__ float bf2f(unsigned b) { return __uint_as_float(b << 16); }
__device__ __forceinline__ float wave_sum(float v) {
#pragma unroll
    for (int o = 1; o < 64; o <<= 1) v += __shfl_xor(v, o);
    return v;
}
__device__ __forceinline__ float sigmoidf_(float x) { return 1.f / (1.f + __expf(-x)); }

struct MapId { __device__ __forceinline__ int operator()(int n) const { return n; } };
struct MapRope {
    __device__ __forceinline__ int operator()(int c) const { if (c >= 1024) return c; const int g = c & ~63, d = c & 63; return g + 8 * ((d & 31) >> 2) + 4 * (d >> 5) + (d & 3); } };
struct MapW1 { __device__ __forceinline__ int operator()(int c) const { return 256 * (c >> 7) + (c & 127); } };
struct MapW3 { __device__ __forceinline__ int operator()(int c) const { return 256 * (c >> 7) + 128 + (c & 127); } };
template <class Map>
__device__ __forceinline__ void transpose_item(const float* W, int ldw, bf16_t* WT, int K, int k0, int n0, const Map& map, const float* kscale, LAS float* scr, int lane) {
#pragma unroll 8
    for (int i = 0; i < 32; ++i) { const int kk = 2 * i + (lane >> 5); scr[kk * 33 + (lane & 31)] = W[(size_t)(k0 + kk) * ldw + n0 + (lane & 31)]; }
    asm volatile("s_waitcnt vmcnt(0) lgkmcnt(0)" ::: "memory");
    const int c = lane & 7;
    float ks[8];
#pragma unroll
    for (int i = 0; i < 8; ++i) ks[i] = kscale ? kscale[k0 + 8 * c + i] : 1.f;
#pragma unroll
    for (int j = 0; j < 4; ++j) { const int n = (lane >> 3) + 8 * j; const LAS float* s = scr + (8 * c) * 33 + n;
        u32x4 o; o.x = pk2(s[0 * 33] * ks[0], s[1 * 33] * ks[1]); o.y = pk2(s[2 * 33] * ks[2], s[3 * 33] * ks[3]); o.z = pk2(s[4 * 33] * ks[4], s[5 * 33] * ks[5]); o.w = pk2(s[6 * 33] * ks[6], s[7 * 33] * ks[7]);
        *(u32x4*)(WT + (size_t)map(n0 + n) * K + k0 + 8 * c) = o; }
    asm volatile("s_waitcnt lgkmcnt(0)" ::: "memory");
}

struct Ptrs {
    const float *x, *w_in, *conv_w, *conv_b, *gate_b, *lam_qk, *subln_g, *mhnorm_g, *w_out, *g_mix, *g_ffn, *w_grp, *b_grp, *w_er, *b_er, *w1, *w3, *w2, *g_final;
    float* out; unsigned char* ws;
};


namespace pg8 {
#define PG8_LAS __attribute__((address_space(3)))
constexpr int BM = 256, BK = 64, HALF = 128, HTB = HALF * BK * 2, STAGE_BYTES = 8 * HTB, NXCD = 8, WGM = 8;
__host__ __device__ __forceinline__ int lds_byte(int r, int c) { const int st = (r >> 4) * 2 + (c >> 5), rr = r & 15, cc = c & 31, ob = rr * 64 + cc * 2; return st * 1024 + (ob ^ (((ob >> 9) & 1) << 5)); }
__host__ __device__ __forceinline__ void stage_rc(int b, int& R, int& C) { const int st = b / 1024, sb = b % 1024, swz = sb ^ (((sb >> 9) & 1) << 5); R = (st >> 1) * 16 + swz / 64; C = (st & 1) * 32 + (swz % 64) / 2; }
__host__ __device__ __forceinline__ int perm32(int rho) { const int n = rho >> 4, i = rho & 15; return 8 * (i >> 2) + 4 * n + (i & 3); }

struct Unit { int pm, pn; const char* a; const char* b; int e, cnt, ps; };

struct StaticOrder {
    int nM, nN, nwg, G, c; const char* A; const char* Bt; size_t tstep;
    __device__ void init(const void* A_, const void* Bt_, int M, int N, int K, int G_, int c_) { A = (const char*)A_; Bt = (const char*)Bt_; nM = M / BM; nN = N / BM; nwg = nM * nN; G = G_; c = c_; tstep = (size_t)BM * K * 2; }
    __device__ bool next(int i, Unit& u) const {
        const long L = (long)i * G + c; if (L >= nwg) return false;
        int wgid = (int)L; { const int q = nwg / NXCD, r = nwg % NXCD, xcd = wgid % NXCD, off = wgid / NXCD; wgid = (xcd < r ? xcd * (q + 1) : r * (q + 1) + (xcd - r) * q) + off; }
        const int nig = WGM * nN, gid = wgid / nig, fm = gid * WGM, gsz = (nM - fm) < WGM ? (nM - fm) : WGM;
        u.pm = fm + ((wgid % nig) % gsz); u.pn = (wgid % nig) / gsz; u.a = A + (size_t)u.pm * tstep; u.b = Bt + (size_t)u.pn * tstep; u.e = 0; u.cnt = 0; u.ps = 0; return true;
    }
    __device__ __forceinline__ unsigned row_off(const Unit&, int) const { return 0u; }
};
struct MoeOrder {
    const PG8_LAS int* tab; int G, vcu; const char* A; const char* Bt; size_t bstep_e, bstep_n, astep; bool gather; const int* list; int K;
    __device__ bool next(int i, Unit& u) const {
        const int L = i * G + vcu; if (L >= tab[32]) return false;
        int e = 0;
#pragma unroll 1
        for (int j = 1; j < 32; ++j) e = (L >= tab[j]) ? j : e;
        const int loc = L - tab[e]; u.e = e; u.pn = loc & 3; u.pm = loc >> 2; u.cnt = tab[128 + e]; u.ps = tab[64 + e];
        u.b = Bt + (size_t)e * bstep_e + (size_t)u.pn * bstep_n;
        u.a = gather ? A : A + (size_t)(u.ps + u.pm * BM) * astep;
        return true;
    }
    __device__ __forceinline__ unsigned row_off(const Unit& u, int r) const {
        const int s = u.pm * BM + r; const int a = (s < u.cnt) ? list[(size_t)u.e * LIST_CAP + s] : 0; return (unsigned)(a >> 1) * (unsigned)(K * 2);
    }
};

typedef float f32x2_t __attribute__((ext_vector_type(2))); typedef __bf16 bf16x2_t __attribute__((ext_vector_type(2)));
__device__ __forceinline__ unsigned cvt_pk_bf16(float lo, float hi) { const f32x2_t v = {lo, hi}; const bf16x2_t b = __builtin_convertvector(v, bf16x2_t); return __builtin_bit_cast(unsigned, b); }

struct EpiProj {
    static constexpr bool PERM = true;
    bf16_t* O; const float* cs; const float* sn;
    __device__ __forceinline__ void operator()(const f32x4 (&acc)[2][2][4][2], const Unit& u, int wr, int wc, int fr, int fq) const {
        const int row0 = u.pm * BM + wr * 64 + fr, colt = u.pn * BM;
        if (u.pn < 4) {
            const float sc = (u.pn < 2) ? C2Q : 1.f; const int q8 = 4 * (wc & 1) + fq;
#pragma unroll
            for (int ai = 0; ai < 2; ++ai)
#pragma unroll
                for (int m = 0; m < 4; ++m) { const int row = row0 + ai * HALF + m * 16, pos = row & (SEQ - 1);
                    const f32x4 c4 = *(const f32x4*)(cs + pos * 32 + 4 * q8) * sc, s4 = *(const f32x4*)(sn + pos * 32 + 4 * q8) * sc;
                    bf16_t* rowp = O + (size_t)row * NPROJ + colt + 64 * (wc >> 1) + 4 * q8;
#pragma unroll
                    for (int bj = 0; bj < 2; ++bj) { const f32x4 x1 = acc[ai][bj][m][0], x2 = acc[ai][bj][m][1]; const f32x4 o1 = x1 * c4 - x2 * s4, o2 = x1 * s4 + x2 * c4;
                        u32x2 w1, w2; w1.x = cvt_pk_bf16(o1[0], o1[1]); w1.y = cvt_pk_bf16(o1[2], o1[3]); w2.x = cvt_pk_bf16(o2[0], o2[1]); w2.y = cvt_pk_bf16(o2[2], o2[3]);
                        *(u32x2*)(rowp + bj * HALF) = w1; *(u32x2*)(rowp + bj * HALF + 32) = w2; } }
        } else {
            const int col0 = colt + wc * 32 + 8 * fq;
#pragma unroll
            for (int ai = 0; ai < 2; ++ai)
#pragma unroll
                for (int m = 0; m < 4; ++m) { bf16_t* rowp = O + (size_t)(row0 + ai * HALF + m * 16) * NPROJ + col0;
#pragma unroll
                    for (int bj = 0; bj < 2; ++bj) { const f32x4 v0 = acc[ai][bj][m][0], v1 = acc[ai][bj][m][1];
                        u32x4 w; w.x = cvt_pk_bf16(v0[0], v0[1]); w.y = cvt_pk_bf16(v0[2], v0[3]); w.z = cvt_pk_bf16(v1[0], v1[1]); w.w = cvt_pk_bf16(v1[2], v1[3]);
                        *(u32x4*)(rowp + bj * HALF) = w; } }
        }
    }
};
struct EpiOut {
    static constexpr bool PERM = true;
    const float* x; float* X1; bf16_t* X1B;
    __device__ __forceinline__ void operator()(const f32x4 (&acc)[2][2][4][2], const Unit& u, int wr, int wc, int fr, int fq) const {
        const int row0 = u.pm * BM + wr * 64 + fr, col0 = u.pn * BM + wc * 32 + 8 * fq;
#pragma unroll
        for (int ai = 0; ai < 2; ++ai)
#pragma unroll
            for (int m = 0; m < 4; ++m) { const size_t off = (size_t)(row0 + ai * HALF + m * 16) * D + col0;
#pragma unroll
                for (int bj = 0; bj < 2; ++bj) { const f32x4 v0 = acc[ai][bj][m][0] + *(const f32x4*)(x + off + bj * HALF), v1 = acc[ai][bj][m][1] + *(const f32x4*)(x + off + bj * HALF + 4);
                    *(f32x4*)(X1 + off + bj * HALF) = v0; *(f32x4*)(X1 + off + bj * HALF + 4) = v1;
                    u32x4 w; w.x = cvt_pk_bf16(v0[0], v0[1]); w.y = cvt_pk_bf16(v0[2], v0[3]); w.z = cvt_pk_bf16(v1[0], v1[1]); w.w = cvt_pk_bf16(v1[2], v1[3]);
                    *(u32x4*)(X1B + off + bj * HALF) = w; }
                asm volatile("" ::: "memory"); }
    }
};
struct EpiUp {
    static constexpr bool PERM = true;
    bf16_t* HD; const float* rstd; const int* list;
    __device__ __forceinline__ void operator()(const f32x4 (&acc)[2][2][4][2], const Unit& u, int wr, int wc, int fr, int fq) const {
        const int r0 = u.pm * BM + wr * 64 + fr, col0 = u.pn * HALF + wc * 32 + 8 * fq;
#pragma unroll
        for (int ai = 0; ai < 2; ++ai)
#pragma unroll
            for (int m = 0; m < 4; ++m) { const int s = r0 + ai * HALF + m * 16; if (s < u.cnt) { const float rs = rstd[list[(size_t)u.e * LIST_CAP + s] >> 1];
                    float h[8];
#pragma unroll
                    for (int n = 0; n < 2; ++n)
#pragma unroll
                        for (int i = 0; i < 4; ++i) { const float a = acc[ai][0][m][n][i] * rs, b = acc[ai][1][m][n][i] * rs; h[4 * n + i] = a * b / (1.f + __expf(-a)); }
                    u32x4 w; w.x = cvt_pk_bf16(h[0], h[1]); w.y = cvt_pk_bf16(h[2], h[3]); w.z = cvt_pk_bf16(h[4], h[5]); w.w = cvt_pk_bf16(h[6], h[7]);
                    *(u32x4*)(HD + (size_t)(u.ps + s) * DE + col0) = w; } }
    }
};
struct EpiDown {
    static constexpr bool PERM = true;
    bf16_t* Y; const float* tokw; const int* list;
    __device__ __forceinline__ void operator()(const f32x4 (&acc)[2][2][4][2], const Unit& u, int wr, int wc, int fr, int fq) const {
        const int r0 = u.pm * BM + wr * 64 + fr, col0 = u.pn * BM + wc * 32 + 8 * fq;
#pragma unroll
        for (int ai = 0; ai < 2; ++ai)
#pragma unroll
            for (int m = 0; m < 4; ++m) { const int s = r0 + ai * HALF + m * 16; if (s < u.cnt) { const int a = list[(size_t)u.e * LIST_CAP + s]; const float w8 = tokw[a];
                    bf16_t* rowp = Y + (size_t)a * D + col0;
#pragma unroll
                    for (int bj = 0; bj < 2; ++bj) { const f32x4 v0 = acc[ai][bj][m][0] * w8, v1 = acc[ai][bj][m][1] * w8;
                        u32x4 w; w.x = cvt_pk_bf16(v0[0], v0[1]); w.y = cvt_pk_bf16(v0[2], v0[3]); w.z = cvt_pk_bf16(v1[0], v1[1]); w.w = cvt_pk_bf16(v1[2], v1[3]);
                        *(u32x4*)(rowp + bj * HALF) = w; } } }
    }
};

template <class Epi, class Sched, bool ALIGN_EPI, bool GATHER>
__device__ __forceinline__ void gemm_phase(PG8_LAS unsigned char* lds, const int K, const Sched& S, const Epi& E) {
    const int tid = threadIdx.x, wid = __builtin_amdgcn_readfirstlane(tid >> 6), lane = tid & 63, wr = wid >> 2, wc = wid & 3, fr = lane & 15, fq = lane >> 4;
    const int nt = K / BK;
    unsigned voffB[2], ga[2][2], gn[2][2]; int RA[2], CA[2];
#pragma unroll
    for (int i = 0; i < 2; ++i) { int R, C; stage_rc(tid * 16 + i * 8192, R, C); const int Rb = Epi::PERM ? ((R & ~31) + perm32(R & 31)) : R;
        RA[i] = R; CA[i] = C; voffB[i] = (unsigned)(Rb * K + C) * 2u; }
    const size_t kstep = (size_t)(BK * 2);
    const size_t hstep = (size_t)HALF * K * 2;
    const unsigned ldsw = (unsigned)wid * 1024u;
    const int aoff = lds_byte(wr * 64 + fr, fq * 8), boff = lds_byte(wc * 32 + fr, fq * 8);
#define PG8_SA(b, h) (((b) * 2 + (h)) * HTB)
#define PG8_SB(b, h) ((4 + (b) * 2 + (h)) * HTB)
#define PG8_STAGE(bufoff, gbase, voff) do { _Pragma("unroll") for (int _i = 0; _i < 2; ++_i) \
        __builtin_amdgcn_global_load_lds((const unsigned*)((const char*)(gbase) + (voff)[_i]), (PG8_LAS unsigned*)(lds + (bufoff) + ldsw + _i * 8192), 16, 0, 0); } while (0)
#define PG8_LDA(dst, b, h) do { _Pragma("unroll") for (int m = 0; m < 4; ++m) _Pragma("unroll") for (int k = 0; k < 2; ++k) dst[m][k] = *(const PG8_LAS bf16x8*)(lds + PG8_SA(b, h) + aoff + m * 2048 + k * 1024); } while (0)
#define PG8_LDB(dst, b, h) do { _Pragma("unroll") for (int n = 0; n < 2; ++n) _Pragma("unroll") for (int k = 0; k < 2; ++k) dst[n][k] = *(const PG8_LAS bf16x8*)(lds + PG8_SB(b, h) + boff + n * 2048 + k * 1024); } while (0)
#define PG8_MMA(ai, bj, At, Bt) do { __builtin_amdgcn_s_setprio(1); _Pragma("unroll") for (int m = 0; m < 4; ++m) _Pragma("unroll") for (int n = 0; n < 2; ++n) _Pragma("unroll") for (int k = 0; k < 2; ++k) \
        acc[ai][bj][m][n] = __builtin_amdgcn_mfma_f32_16x16x32_bf16(Bt[n][k], At[m][k], acc[ai][bj][m][n], 0, 0, 0); __builtin_amdgcn_s_setprio(0); } while (0)
#define PG8_WAIT_V(n) asm volatile("s_waitcnt vmcnt(" #n ")" ::: "memory")
#define PG8_WAIT_L(n) asm volatile("s_waitcnt lgkmcnt(" #n ")" ::: "memory")
#define PG8_BAR __builtin_amdgcn_s_barrier()
#define PG8_SCHED __builtin_amdgcn_sched_barrier(0)
    Unit cur, nxt; int ui = 0;
    if (!S.next(0, cur)) return;
#pragma unroll
    for (int h = 0; h < 2; ++h)
#pragma unroll
        for (int i = 0; i < 2; ++i) { ga[h][i] = (GATHER ? S.row_off(cur, h * HALF + RA[i]) : (unsigned)((h * HALF + RA[i]) * K) * 2u) + (unsigned)CA[i] * 2u; gn[h][i] = ga[h][i]; }
    f32x4 acc[2][2][4][2];
#pragma unroll
    for (int a = 0; a < 2; ++a)
#pragma unroll
        for (int b = 0; b < 2; ++b)
#pragma unroll
            for (int m = 0; m < 4; ++m)
#pragma unroll
                for (int n = 0; n < 2; ++n) acc[a][b][m][n] = (f32x4){0.f, 0.f, 0.f, 0.f};
    bf16x8 At[4][2], B0[2][2], B1[2][2];
    const char* cA = cur.a; const char* cB = cur.b;
    PG8_STAGE(PG8_SB(0, 0), cB, voffB); PG8_STAGE(PG8_SB(0, 1), cB + hstep, voffB); PG8_STAGE(PG8_SA(0, 0), cA, ga[0]); PG8_STAGE(PG8_SA(0, 1), cA, ga[1]);
    if (wr == 1) PG8_BAR;
    PG8_WAIT_V(2); PG8_BAR;
    PG8_STAGE(PG8_SB(1, 0), cB + kstep, voffB); PG8_STAGE(PG8_SA(1, 0), cA + kstep, ga[0]); PG8_STAGE(PG8_SB(1, 1), cB + hstep + kstep, voffB);
    PG8_WAIT_V(6); PG8_BAR;
    for (;;) {
        const bool has_next = S.next(ui + 1, nxt);
        const char* nA = has_next ? nxt.a : cA; const char* nB = has_next ? nxt.b : cB;
        if (GATHER && has_next) {
#pragma unroll
            for (int h = 0; h < 2; ++h)
#pragma unroll
                for (int i = 0; i < 2; ++i) gn[h][i] = S.row_off(nxt, h * HALF + RA[i]) + (unsigned)CA[i] * 2u;
        }
        for (int t = 0; t < nt; t += 2) {
            const bool last = (t == nt - 2);
            const char* a1 = cA + (size_t)(t + 1) * kstep;
            const char* a2 = last ? nA : cA + (size_t)(t + 2) * kstep; const char* b2 = last ? nB : cB + (size_t)(t + 2) * kstep;
            const char* a3 = a2 + kstep; const char* b3 = b2 + kstep;
            unsigned g2[2][2];
#pragma unroll
            for (int h = 0; h < 2; ++h)
#pragma unroll
                for (int i = 0; i < 2; ++i) g2[h][i] = (GATHER && last) ? gn[h][i] : ga[h][i];
            PG8_LDB(B0, 0, 0); PG8_LDB(B1, 0, 1); PG8_SCHED; PG8_LDA(At, 0, 0); PG8_STAGE(PG8_SA(1, 1), a1, ga[1]);
            PG8_WAIT_V(8); PG8_WAIT_L(0); PG8_BAR; PG8_MMA(0, 0, At, B0); PG8_MMA(0, 1, At, B1); PG8_BAR; PG8_SCHED;
            PG8_LDA(At, 0, 1); PG8_STAGE(PG8_SB(0, 0), b2, voffB); PG8_STAGE(PG8_SB(0, 1), b2 + hstep, voffB); PG8_STAGE(PG8_SA(0, 0), a2, g2[0]);
            PG8_WAIT_V(8); PG8_WAIT_L(0); PG8_BAR; PG8_MMA(1, 0, At, B0); PG8_MMA(1, 1, At, B1); PG8_BAR; PG8_SCHED;
            PG8_LDB(B0, 1, 0); PG8_LDB(B1, 1, 1); PG8_SCHED; PG8_LDA(At, 1, 0); PG8_STAGE(PG8_SA(0, 1), a2, g2[1]);
            PG8_WAIT_V(8); PG8_WAIT_L(0); PG8_BAR; PG8_MMA(0, 0, At, B0); PG8_MMA(0, 1, At, B1); PG8_BAR; PG8_SCHED;
            PG8_LDA(At, 1, 1); PG8_STAGE(PG8_SB(1, 0), b3, voffB); PG8_STAGE(PG8_SB(1, 1), b3 + hstep, voffB); PG8_STAGE(PG8_SA(1, 0), a3, g2[0]);
            PG8_WAIT_V(8); PG8_WAIT_L(0); PG8_BAR; PG8_MMA(1, 0, At, B0); PG8_MMA(1, 1, At, B1); PG8_BAR; PG8_SCHED;
        }
        if constexpr (ALIGN_EPI) { if (wr == 0) PG8_BAR; }
        E(acc, cur, wr, wc, fr, fq);
        if (!has_next) break;
#pragma unroll
        for (int a = 0; a < 2; ++a)
#pragma unroll
            for (int b = 0; b < 2; ++b)
#pragma unroll
                for (int m = 0; m < 4; ++m)
#pragma unroll
                    for (int n = 0; n < 2; ++n) acc[a][b][m][n] = (f32x4){0.f, 0.f, 0.f, 0.f};
        cur = nxt; cA = nA; cB = nB; ++ui;
#pragma unroll
        for (int h = 0; h < 2; ++h)
#pragma unroll
            for (int i = 0; i < 2; ++i) ga[h][i] = gn[h][i];
        if constexpr (ALIGN_EPI) { if (wr == 1) PG8_BAR; }
    }
    PG8_WAIT_V(0);
    if constexpr (!ALIGN_EPI) { if (wr == 0) PG8_BAR; }
    PG8_BAR;
#undef PG8_SA
#undef PG8_SB
#undef PG8_STAGE
#undef PG8_LDA
#undef PG8_LDB
#undef PG8_MMA
#undef PG8_WAIT_V
#undef PG8_WAIT_L
#undef PG8_BAR
#undef PG8_SCHED
}
}

constexpr int NWAVES = 8;
constexpr int RING_OFF = 0, RING_BYTES = 135168;
constexpr int LDSCTL_OFF = RING_BYTES;
constexpr int MISC_OFF = LDSCTL_OFF + 64;
constexpr int TAB_OFF = LDSCTL_OFF + 256;
constexpr int LDS_BYTES = RING_BYTES + 2048;

#define GAS __attribute__((address_space(1)))
typedef GAS unsigned gu32;
#define RLX_AGENT __ATOMIC_RELAXED, __HIP_MEMORY_SCOPE_AGENT
#define LDS_WAIT() asm volatile("s_waitcnt lgkmcnt(0)" ::: "memory")
#define VM_WAIT() asm volatile("s_waitcnt vmcnt(0)" ::: "memory")

#define XB_TMO      128
#define XB_XCNT(j)  (256  + 64 * (j))
#define XB_XSUB(j)  (1280 + 64 * (j))
#define XB_XGEN(j)  (2304 + 64 * (j))
#define XB_TOP      3328
#define XB_TOPGEN   3392
#define XCD_BAR_WORDS 3456
#define XB_SPIN_CAP (1u << 18)

__device__ __forceinline__ unsigned xb_ld(unsigned* p)              { return __hip_atomic_load(p, __ATOMIC_RELAXED, __HIP_MEMORY_SCOPE_AGENT); }
__device__ __forceinline__ unsigned xb_add(unsigned* p, unsigned v) { return __hip_atomic_fetch_add(p, v, __ATOMIC_RELAXED, __HIP_MEMORY_SCOPE_AGENT); }
__device__ __forceinline__ unsigned xb_xcc_id() { return (unsigned)__builtin_amdgcn_s_getreg((3 << 11) | 20) & 0xFu; }
#define XB_SPIN(cond, bar) do { unsigned _sp = 0; while (cond) { __builtin_amdgcn_s_sleep(1); \
    if ((++_sp & 255u) == 0u) { if (xb_ld(&(bar)[XB_TMO])) break; if (_sp > XB_SPIN_CAP) { atomicAdd(&(bar)[XB_TMO], 1u); break; } } } } while (0)

struct XcdBarrier { unsigned* bar; unsigned x; volatile LAS unsigned* st; };

__device__ __forceinline__ XcdBarrier xcd_barrier_post(unsigned* bar, volatile LAS unsigned* st) {
    XcdBarrier b; b.bar = bar; b.x = xb_xcc_id(); b.st = st;
    if (threadIdx.x == 0) (void)xb_add(&bar[XB_XCNT(b.x)], 1u);
    return b;
}
__device__ __forceinline__ void xcd_barrier_complete(unsigned* bar, unsigned x, unsigned& nloc, unsigned& nx) {
    const unsigned G = gridDim.x * gridDim.y * gridDim.z;
    unsigned sum, cnt, mine, sp = 0u;
    for (;;) {
        sum = 0u; cnt = 0u; mine = 0u;
#pragma unroll
        for (unsigned j = 0; j < 16; ++j) { const unsigned c = xb_ld(&bar[XB_XCNT(j)]); sum += c; cnt += (c > 0u) ? 1u : 0u; mine = (j == x) ? c : mine; }
        if (sum == G) break;
        __builtin_amdgcn_s_sleep(1);
        if ((++sp & 255u) == 0u) { if (xb_ld(&bar[XB_TMO])) break; if (sp > XB_SPIN_CAP) { atomicAdd(&bar[XB_TMO], 1u); break; } }
    }
    nloc = mine > 0u ? mine : 1u; nx = cnt > 0u ? cnt : 1u;
}
__device__ __forceinline__ void xcd_barrier(const XcdBarrier& b) {
    asm volatile("s_waitcnt vmcnt(0)" ::: "memory");
    __syncthreads();
    if (threadIdx.x == 0) {
        unsigned* bar = b.bar;
        __builtin_amdgcn_s_waitcnt(0);
        unsigned nloc = b.st[0], nx = b.st[1];
        if (nloc == 0u) { xcd_barrier_complete(bar, b.x, nloc, nx); b.st[0] = nloc; b.st[1] = nx; }
        const unsigned old = xb_add(&bar[XB_XSUB(b.x)], 1u);
        const unsigned gen = old / nloc;
        if (old + 1u == (gen + 1u) * nloc) {
            __builtin_amdgcn_fence(__ATOMIC_RELEASE, "agent");
            asm volatile("s_waitcnt vmcnt(0)" ::: "memory");
            const unsigned og = xb_add(&bar[XB_TOP], 1u);
            const unsigned tg = og / nx;
            if (og + 1u == (tg + 1u) * nx) xb_add(&bar[XB_TOPGEN], 1u);
            else XB_SPIN(xb_ld(&bar[XB_TOPGEN]) == tg, bar);
            __builtin_amdgcn_fence(__ATOMIC_ACQUIRE, "agent");
            xb_add(&bar[XB_XGEN(b.x)], 1u);
            asm volatile("s_waitcnt vmcnt(0)" ::: "memory");
        } else {
            XB_SPIN(xb_ld(&bar[XB_XGEN(b.x)]) == gen, bar);
            __builtin_amdgcn_fence(__ATOMIC_ACQUIRE, "agent");
            asm volatile("s_waitcnt vmcnt(0)" ::: "memory");
        }
    }
    __syncthreads();
}

struct Frame {
    LAS unsigned char* lds;
    unsigned* ctl;
    int tid, lane, wave, vcu, G;
    Ptrs p;
};

__device__ __forceinline__ void p0_prologue(Frame& F) {
    const Ptrs& p = F.p; const int tid = F.tid, lane = F.lane, wave = F.wave;
    LAS float* scr = (LAS float*)(F.lds + RING_OFF) + wave * 64 * 33;
    LAS float* gw = (LAS float*)(F.lds + RING_OFF + 8 * 64 * 33 * 4);
    const int gw_id = F.vcu * NWAVES + wave, NGW = F.G * NWAVES;
    bf16_t* WIN = (bf16_t*)(p.ws + WS_WIN); bf16_t* WOUT = (bf16_t*)(p.ws + WS_WOUT); bf16_t* W13 = (bf16_t*)(p.ws + WS_W13); bf16_t* W2 = (bf16_t*)(p.ws + WS_W2);
    for (int i = tid; i < 1024 * 8; i += NWAVES * 64) gw[i] = p.w_in[(size_t)(i >> 3) * DIN + C_IG + (i & 7)];
    __syncthreads();
    constexpr int I_IN = 16 * 112, I_OUT = 16 * 32, I_13 = 16 * 16 * 32, I_2 = 8 * 32 * 32;
    constexpr int NITEMS = I_IN + I_OUT + 2 * I_13 + I_2;
    for (int it = gw_id; it < NITEMS; it += NGW) {
        int r = it;
        if (r < I_IN) { const int kb = r / 112, nb = r % 112; transpose_item(p.w_in, DIN, WIN, 1024, 64 * kb, 32 * nb, MapRope(), nullptr, scr, lane); continue; } r -= I_IN;
        if (r < I_OUT) { const int kb = r / 32, nb = r % 32; transpose_item(p.w_out, 1024, WOUT, 1024, 64 * kb, 32 * nb, MapId(), nullptr, scr, lane); continue; } r -= I_OUT;
        if (r < I_13) { const int e = r / 256, q = r % 256, kb = q / 16, nb = q % 16; transpose_item(p.w1 + (size_t)e * 1024 * 512, 512, W13 + (size_t)e * 1024 * 1024, 1024, 64 * kb, 32 * nb, MapW1(), p.g_ffn, scr, lane); continue; } r -= I_13;
        if (r < I_13) { const int e = r / 256, q = r % 256, kb = q / 16, nb = q % 16; transpose_item(p.w3 + (size_t)e * 1024 * 512, 512, W13 + (size_t)e * 1024 * 1024, 1024, 64 * kb, 32 * nb, MapW3(), p.g_ffn, scr, lane); continue; } r -= I_13;
        { const int e = r / 256, q = r % 256, kb = q / 32, nb = q % 32; transpose_item(p.w2 + (size_t)e * 512 * 1024, 1024, W2 + (size_t)e * 1024 * 512, 512, 64 * kb, 32 * nb, MapId(), nullptr, scr, lane); }
    }
    { float* cs = (float*)(p.ws + WS_ROPE); float* sn = cs + 2048 * 32;
      for (int i = blockIdx.x * 512 + tid; i < 2048 * 32; i += F.G * 512) { const int pos = i >> 5, j = i & 31;
          const float inv = 1.0f / exp2f((float)(2 * j) * (1.f / 64.f) * 13.287712379549449f);
          const float ang = (float)pos * inv; const double rev = (double)ang * 0.15915494309189535; const float fr = (float)(rev - rint(rev));
          cs[i] = __builtin_amdgcn_cosf(fr); sn[i] = __builtin_amdgcn_sinf(fr); } }
    { bf16_t* WR = (bf16_t*)(p.ws + WS_WR);
      for (int i = blockIdx.x * 512 + tid; i < 48 * 1024; i += F.G * 512) { const int c = i >> 10, k = i & 1023; float v = 0.f;
          if (c < 4) v = p.w_grp[k * 4 + c]; else if (c < 36) v = p.w_er[((size_t)((c - 4) >> 3) * 1024 + k) * 8 + ((c - 4) & 7)];
          WR[i] = (bf16_t)f2bf(v * p.g_ffn[k]); } }
    bf16_t* HB = (bf16_t*)(p.ws + WS_HB); float* GATES = (float*)(p.ws + WS_GATES);
    for (int m = gw_id; m < T; m += NGW) {
        const f32x4* xr = (const f32x4*)(p.x + (size_t)m * D) + lane; const f32x4* gr = (const f32x4*)p.g_mix + lane;
        f32x4 v[4]; float s = 0.f;
#pragma unroll
        for (int j = 0; j < 4; ++j) { v[j] = xr[64 * j]; s += (v[j].x * v[j].x + v[j].y * v[j].y) + (v[j].z * v[j].z + v[j].w * v[j].w); }
        const float rstd = 1.f / sqrtf(wave_sum(s) * (1.f / D) + RMS_EPS);
        float ga[8];
#pragma unroll
        for (int e = 0; e < 8; ++e) ga[e] = 0.f;
        unsigned long long* o8 = (unsigned long long*)(HB + (size_t)m * D) + lane;
#pragma unroll
        for (int j = 0; j < 4; ++j) { const f32x4 g = gr[64 * j]; f32x4 h = v[j] * rstd * g;
            o8[64 * j] = (unsigned long long)pk2(h.x, h.y) | ((unsigned long long)pk2(h.z, h.w) << 32);
            const int k0 = 256 * j + 4 * lane;
#pragma unroll
            for (int q = 0; q < 4; ++q) { const float hv = h[q]; const LAS float* w = gw + (k0 + q) * 8;
#pragma unroll
                for (int e = 0; e < 8; ++e) ga[e] += hv * w[e]; } }
#pragma unroll
        for (int e = 0; e < 8; ++e) ga[e] = wave_sum(ga[e]);
        if (lane < 8) { float gv = 0.f;
#pragma unroll
            for (int e = 0; e < 8; ++e) gv = (lane == e) ? ga[e] : gv;
            gv += p.gate_b[lane];
            if (lane >= 4) gv = fminf(gv, 0.f) - log1pf(__expf(-fabsf(gv)));
            GATES[(size_t)m * 8 + lane] = gv; }
    }
}

__device__ __forceinline__ void attn_ref_body(Frame& F) {
    const bf16_t* PROJ = (const bf16_t*)(F.p.ws + WS_PROJ); float* OC = F.p.out;
    for (int idx = blockIdx.x * 512 + F.tid; idx < BATCH * 4 * 2 * SEQ; idx += F.G * 512) {
        const int q = idx & (SEQ - 1), c = (idx >> 11) & 1, h = (idx >> 12) & 3, b = idx >> 14;
        const int qmax = __builtin_amdgcn_readfirstlane(q | 63);
        const size_t rowb = (size_t)b * SEQ;
        float qv[64];
        { const bf16_t* qp = PROJ + (rowb + q) * NPROJ + C_QA + h * 128 + c * 64;
#pragma unroll
          for (int d = 0; d < 64; ++d) qv[d] = bf2f(qp[d]); }
        float o[128];
#pragma unroll
        for (int d = 0; d < 128; ++d) o[d] = 0.f;
        float m = -INFINITY, l = 0.f;
        for (int j = 0; j <= qmax; ++j) {
            const bf16_t* kp = PROJ + (rowb + j) * NPROJ + C_KA + h * 128 + c * 64; const bf16_t* vp = PROJ + (rowb + j) * NPROJ + C_VA + h * 128;
            float s = 0.f;
#pragma unroll
            for (int d = 0; d < 64; ++d) s += qv[d] * bf2f(kp[d]);
            if (j <= q) { const float mn = fmaxf(m, s), sc = exp2f(m - mn), pr = exp2f(s - mn); l = l * sc + pr; m = mn;
#pragma unroll
                for (int d = 0; d < 128; ++d) o[d] = o[d] * sc + pr * bf2f(vp[d]); }
        }
        const float rl = 1.f / l; float* op = OC + ((size_t)c * T + rowb + q) * 512 + h * 128;
#pragma unroll
        for (int d = 0; d < 128; ++d) op[d] = o[d] * rl;
    }
}
__device__ __forceinline__ void attn_combine_body(Frame& F) {
    const float* OC = F.p.out; bf16_t* MIX = (bf16_t*)(F.p.ws + WS_MIX); const float* lam_qk = F.p.lam_qk; const int lane = F.lane;
    const float lam = __expf(wave_sum(lam_qk[lane] * lam_qk[64 + lane])) - __expf(wave_sum(lam_qk[128 + lane] * lam_qk[192 + lane])) + LAMBDA_INIT;
    for (int w = F.vcu * NWAVES + F.wave; w < T * 4; w += F.G * NWAVES) { const int row = w >> 2, h = w & 3;
        const float* o1 = OC + (size_t)row * 512 + h * 128; const float* o2 = OC + ((size_t)T + row) * 512 + h * 128;
        const float v0 = o1[lane] - lam * o2[lane], v1 = o1[lane + 64] - lam * o2[lane + 64];
        const float rs = 1.f / sqrtf(wave_sum(v0 * v0 + v1 * v1) * (1.f / 128.f) + RMS_EPS) * (1.f - LAMBDA_INIT);
        bf16_t* o = MIX + (size_t)row * D + h * 128;
        o[lane] = (bf16_t)f2bf(v0 * rs * F.p.subln_g[lane]); o[lane + 64] = (bf16_t)f2bf(v1 * rs * F.p.subln_g[lane + 64]); }
}
__device__ __forceinline__ void mlstm_ref_body(Frame& F, int bh) {
    const bf16_t* PROJ = (const bf16_t*)(F.p.ws + WS_PROJ); const float* GATES = (const float*)(F.p.ws + WS_GATES); bf16_t* MIX = (bf16_t*)(F.p.ws + WS_MIX);
    LAS float* sq = (LAS float*)(F.lds + RING_OFF); LAS float* sk = sq + 128; LAS float* sv = sk + 128; LAS float* so = sv + 128; LAS float* sh = so + 128;
    const int tid = F.tid, v = tid >> 2, kg = tid & 3; const int b = bh >> 2, h = bh & 3;
    float C[32], n[32];
#pragma unroll
    for (int i = 0; i < 32; ++i) { C[i] = 0.f; n[i] = 0.f; }
    float m = 0.f;
    for (int t = 0; t < SEQ; ++t) {
        const size_t row = (size_t)b * SEQ + t;
        if (tid < 256) { const int cc = (tid < 128) ? h * 128 + tid : 512 + h * 128 + (tid - 128);
            float y = F.p.conv_b[cc];
#pragma unroll
            for (int j = 0; j < 4; ++j) { const int tt = t - 3 + j; if (tt >= 0) y += F.p.conv_w[j * 1024 + cc] * bf2f(PROJ[((size_t)b * SEQ + tt) * NPROJ + C_QM + cc]); }
            const float sl = y * sigmoidf_(y);
            if (tid < 128) sq[tid] = sl; else sk[tid - 128] = sl * 0.08838834764831845f; }
        else if (tid < 384) sv[tid - 256] = bf2f(PROJ[row * NPROJ + C_VM + h * 128 + (tid - 256)]);
        else so[tid - 384] = bf2f(PROJ[row * NPROJ + C_OM + h * 128 + (tid - 384)]);
        __syncthreads();
        const float li = GATES[row * 8 + h], lf = GATES[row * 8 + 4 + h];
        const float mn = fmaxf(lf + m, li), fd = __expf(lf + m - mn), ii = __expf(li - mn);
        float pn = 0.f, pd = 0.f; const float vv = sv[v] * ii;
#pragma unroll
        for (int i = 0; i < 32; ++i) { const float kk = sk[kg * 32 + i], qq = sq[kg * 32 + i]; C[i] = fd * C[i] + vv * kk; n[i] = fd * n[i] + ii * kk; pn += C[i] * qq; pd += n[i] * qq; }
        pn += __shfl_xor(pn, 1); pn += __shfl_xor(pn, 2);
        pd += __shfl_xor(pd, 1); pd += __shfl_xor(pd, 2);
        const float hv = pn / fmaxf(fabsf(pd), __expf(-mn));
        if (kg == 0) sh[v] = hv * sigmoidf_(so[v]);
        m = mn;
        __syncthreads();
        if (tid < 128) { float ss = 0.f;
            for (int i = 0; i < 128; ++i) ss += sh[i] * sh[i];
            MIX[row * D + 512 + h * 128 + tid] = (bf16_t)f2bf(sh[tid] * (1.f / sqrtf(ss * (1.f / 128.f) + RMS_EPS)) * F.p.mhnorm_g[h * 128 + tid]); }
        __syncthreads();
    }
}

__device__ __forceinline__ void router_ref_body(Frame& F) {
    const Ptrs& p = F.p; const int lane = F.lane;
    const float* X1 = p.out; unsigned* ctl = F.ctl; int* list = (int*)(p.ws + WS_LIST); float* tokw = (float*)(p.ws + WS_TOKW); float* rstd_o = (float*)(p.ws + WS_RSTD);
    for (int tok = F.vcu * NWAVES + F.wave; tok < T; tok += F.G * NWAVES) {
        float hv[16]; float s = 0.f;
#pragma unroll
        for (int j = 0; j < 4; ++j) { const f32x4 v = ((const f32x4*)(X1 + (size_t)tok * D))[lane + 64 * j]; hv[4 * j] = v.x; hv[4 * j + 1] = v.y; hv[4 * j + 2] = v.z; hv[4 * j + 3] = v.w; s += (v.x * v.x + v.y * v.y) + (v.z * v.z + v.w * v.w); }
        const float rstd = 1.f / sqrtf(wave_sum(s) * (1.f / D) + RMS_EPS);
#pragma unroll
        for (int j = 0; j < 4; ++j)
#pragma unroll
            for (int q = 0; q < 4; ++q) hv[4 * j + q] *= rstd * p.g_ffn[256 * j + 4 * lane + q];
        float gl[4];
#pragma unroll
        for (int g = 0; g < 4; ++g) { float a = 0.f;
#pragma unroll
            for (int j = 0; j < 4; ++j)
#pragma unroll
                for (int q = 0; q < 4; ++q) a += hv[4 * j + q] * p.w_grp[(size_t)(256 * j + 4 * lane + q) * 4 + g];
            gl[g] = wave_sum(a) + p.b_grp[g]; }
        int gs = 0; float gm = gl[0];
#pragma unroll
        for (int g = 1; g < 4; ++g) if (gl[g] > gm) { gm = gl[g]; gs = g; }
        float gsum = 0.f;
#pragma unroll
        for (int g = 0; g < 4; ++g) gsum += __expf(gl[g] - gm);
        const float gwt = 1.f / gsum;
        float el[8];
#pragma unroll
        for (int e = 0; e < 8; ++e) { float a = 0.f;
#pragma unroll
            for (int j = 0; j < 4; ++j)
#pragma unroll
                for (int q = 0; q < 4; ++q) a += hv[4 * j + q] * p.w_er[((size_t)gs * 1024 + 256 * j + 4 * lane + q) * 8 + e];
            el[e] = wave_sum(a) + p.b_er[gs * 8 + e]; }
        int i0 = 0; float v0 = el[0];
#pragma unroll
        for (int e = 1; e < 8; ++e) if (el[e] > v0) { v0 = el[e]; i0 = e; }
        int i1 = -1; float v1 = -INFINITY;
#pragma unroll
        for (int e = 0; e < 8; ++e) if (e != i0 && el[e] > v1) { v1 = el[e]; i1 = e; }
        const float e1 = __expf(v1 - v0), w0 = gwt / (1.f + e1), w1 = gwt * e1 / (1.f + e1);
        if (lane == 0) {
            const int ea = gs * 8 + i0, eb = gs * 8 + i1;
            const unsigned sa = atomicAdd(&ctl[CW_CNT + 64 * ea], 1u); list[(size_t)ea * LIST_CAP + sa] = tok * 2;
            const unsigned sb = atomicAdd(&ctl[CW_CNT + 64 * eb], 1u); list[(size_t)eb * LIST_CAP + sb] = tok * 2 + 1;
            tokw[tok * 2] = w0; tokw[tok * 2 + 1] = w1; rstd_o[tok] = rstd; }
    }
}
__device__ __forceinline__ void final_body(Frame& F) {
    const Ptrs& p = F.p; const int lane = F.lane; float* X1 = p.out; const bf16_t* Y = (const bf16_t*)(p.ws + WS_Y);
    for (size_t tok = F.vcu * NWAVES + F.wave; tok < T; tok += F.G * NWAVES) {
        f32x4 v[4]; float s = 0.f;
#pragma unroll
        for (int j = 0; j < 4; ++j) { v[j] = ((const f32x4*)(X1 + tok * D))[lane + 64 * j];
            const u32x2 a = ((const u32x2*)(Y + (2 * tok) * D))[lane + 64 * j], b = ((const u32x2*)(Y + (2 * tok + 1) * D))[lane + 64 * j];
            v[j].x += bf2f(a.x & 0xffffu) + bf2f(b.x & 0xffffu); v[j].y += bf2f(a.x >> 16) + bf2f(b.x >> 16); v[j].z += bf2f(a.y & 0xffffu) + bf2f(b.y & 0xffffu); v[j].w += bf2f(a.y >> 16) + bf2f(b.y >> 16);
            s += (v[j].x * v[j].x + v[j].y * v[j].y) + (v[j].z * v[j].z + v[j].w * v[j].w); }
        const float rstd = 1.f / sqrtf(wave_sum(s) * (1.f / D) + RMS_EPS);
#pragma unroll
        for (int j = 0; j < 4; ++j) { const f32x4 g = ((const f32x4*)p.g_final)[lane + 64 * j]; ((f32x4*)(X1 + tok * D))[lane + 64 * j] = v[j] * rstd * g; }
    }
}
__device__ __forceinline__ void moe_tables(Frame& F) {
    LAS int* tab = (LAS int*)(F.lds + TAB_OFF);
    if (F.tid == 0) { int us = 0, ps = 0;
        for (int e = 0; e < NE; ++e) { const int c = (int)__hip_atomic_load(F.ctl + CW_CNT + 64 * e, RLX_AGENT); const int nb = (c + 255) >> 8;
            tab[e] = us; tab[64 + e] = ps; tab[128 + e] = c; us += nb * 4; ps += nb * 256; }
        tab[32] = us; tab[96] = ps; }
    __syncthreads();
}


namespace att {
typedef float f32x16 __attribute__((ext_vector_type(16)));
typedef short s16x4 __attribute__((ext_vector_type(4)));
constexpr int STAGE = 32768, VOFF = 16384, XCH_OFF = 65536;
constexpr int ROWB = NPROJ * 2;
__device__ __forceinline__ int crow(int r, int hi) { return (r & 3) + 8 * (r >> 2) + 4 * hi; }
__device__ __forceinline__ unsigned swz(unsigned row) { return ((row & 3u) << 2) | ((row >> 2) & 3u); }
__device__ __forceinline__ s16x4 trrd(const LAS unsigned char* p) { return __builtin_bit_cast(s16x4, __builtin_amdgcn_ds_read_tr16_b64_v4i16((LAS s16x4*)p)); }

__device__ __forceinline__ void attn_unit(Frame& F, int bh, int qb, float lam) {
    LAS unsigned char* lds = F.lds + RING_OFF;
    const int lane = F.lane, wid = F.wave, c = wid >> 2, wq = wid & 3, r32 = lane & 31, hi = lane >> 5;
    const int b = bh >> 2, h = bh & 3, q0 = qb * 128, qlo = q0 + 32 * wq;
    const char* projb = (const char*)(F.p.ws + WS_PROJ) + (size_t)(b * SEQ) * ROWB;
    const char* kg = projb + (C_KA + h * 128) * 2; const char* vg = projb + (C_VA + h * 128) * 2;
    unsigned srcoff[2];
#pragma unroll
    for (int n = 0; n < 2; ++n) { const unsigned row = 4u * (wid + 8 * n) + (lane >> 4), slot = lane & 15; srcoff[n] = row * ROWB + ((slot ^ swz(row)) << 4); }
#define ATT_DMA(t, st) do { _Pragma("unroll") for (int _n = 0; _n < 2; ++_n) { \
        __builtin_amdgcn_global_load_lds((const unsigned*)(kg + (size_t)(t) * 64 * ROWB + srcoff[_n]), (LAS unsigned*)(lds + (st) * STAGE + (wid + 8 * _n) * 1024), 16, 0, 0); \
        __builtin_amdgcn_global_load_lds((const unsigned*)(vg + (size_t)(t) * 64 * ROWB + srcoff[_n]), (LAS unsigned*)(lds + (st) * STAGE + VOFF + (wid + 8 * _n) * 1024), 16, 0, 0); } } while (0)
    bf16x8 qf[4];
    { const bf16_t* qp = (const bf16_t*)(projb + (size_t)(qlo + r32) * ROWB) + C_QA + h * 128 + c * 64 + 8 * hi;
#pragma unroll
      for (int s = 0; s < 4; ++s) qf[s] = *(const bf16x8*)(qp + 16 * s); }
    unsigned kaddr[4], vaddr[2][4];
#pragma unroll
    for (int s = 0; s < 4; ++s) kaddr[s] = 256u * r32 + 16u * ((unsigned)(8 * c + 2 * s + hi) ^ swz(r32));
    { const unsigned blk = (lane >> 4) & 1, q = (lane & 15) >> 2, p = lane & 3;
#pragma unroll
      for (int t2 = 0; t2 < 2; ++t2)
#pragma unroll
          for (int dt = 0; dt < 4; ++dt) { const unsigned row = 8u * t2 + 4u * hi + q; vaddr[t2][dt] = 256u * row + 16u * ((4u * dt + 2u * blk + (p >> 1)) ^ swz(row)) + 8u * (p & 1); } }
    f32x16 o[4];
#pragma unroll
    for (int dt = 0; dt < 4; ++dt)
#pragma unroll
        for (int r = 0; r < 16; ++r) o[dt][r] = 0.f;
    float m = -INFINITY, l = 0.f;
    const int NT = 2 * qb + 2;
    ATT_DMA(0, 0);
    for (int t = 0; t < NT; ++t) {
        asm volatile("s_waitcnt vmcnt(0)" ::: "memory"); __builtin_amdgcn_s_barrier(); asm volatile("" ::: "memory");
        if (t + 1 < NT) ATT_DMA(t + 1, (t + 1) & 1);
        if (64 * t <= qlo + 31) {
            const LAS unsigned char* kb = lds + (t & 1) * STAGE; const LAS unsigned char* vb = kb + VOFF;
            f32x16 p0, p1;
#pragma unroll
            for (int r = 0; r < 16; ++r) { p0[r] = 0.f; p1[r] = 0.f; }
#pragma unroll
            for (int s = 0; s < 4; ++s) { const bf16x8 k0 = *(const LAS bf16x8*)(kb + kaddr[s]), k1 = *(const LAS bf16x8*)(kb + 8192 + kaddr[s]);
                p0 = __builtin_amdgcn_mfma_f32_32x32x16_bf16(k0, qf[s], p0, 0, 0, 0); p1 = __builtin_amdgcn_mfma_f32_32x32x16_bf16(k1, qf[s], p1, 0, 0, 0); }
            if (64 * t + 63 > qlo) { const int qg = qlo + r32;
#pragma unroll
                for (int r = 0; r < 16; ++r) { const int key = 64 * t + crow(r, hi); if (key > qg) p0[r] = -INFINITY; if (key + 32 > qg) p1[r] = -INFINITY; } }
            float rm = fmaxf(p0[0], p1[0]);
#pragma unroll
            for (int r = 1; r < 16; ++r) rm = fmaxf(rm, fmaxf(p0[r], p1[r]));
            rm = fmaxf(rm, __shfl_xor(rm, 32));
            const float mn = fmaxf(m, rm), alpha = __builtin_amdgcn_exp2f(m - mn); m = mn;
            float rs = 0.f;
#pragma unroll
            for (int r = 0; r < 16; ++r) { p0[r] = __builtin_amdgcn_exp2f(p0[r] - mn); p1[r] = __builtin_amdgcn_exp2f(p1[r] - mn); rs += p0[r] + p1[r]; }
            l = l * alpha + rs;
#pragma unroll
            for (int dt = 0; dt < 4; ++dt)
#pragma unroll
                for (int r = 0; r < 16; ++r) o[dt][r] *= alpha;
            bf16x8 pf[4];
#pragma unroll
            for (int ks = 0; ks < 4; ++ks) { u32x4 w;
#pragma unroll
                for (int j = 0; j < 4; ++j) { const int r = 8 * (ks & 1) + 2 * j; w[j] = (ks < 2) ? pg8::cvt_pk_bf16(p0[r], p0[r + 1]) : pg8::cvt_pk_bf16(p1[r], p1[r + 1]); }
                pf[ks] = __builtin_bit_cast(bf16x8, w); }
#pragma unroll
            for (int dt = 0; dt < 4; ++dt)
#pragma unroll
                for (int ks = 0; ks < 4; ++ks) { const s16x4 lo = trrd(vb + vaddr[0][dt] + 4096 * ks), hh = trrd(vb + vaddr[1][dt] + 4096 * ks);
                    const bf16x8 vf = (bf16x8){lo[0], lo[1], lo[2], lo[3], hh[0], hh[1], hh[2], hh[3]};
                    o[dt] = __builtin_amdgcn_mfma_f32_32x32x16_bf16(vf, pf[ks], o[dt], 0, 0, 0); }
        }
    }
    asm volatile("s_waitcnt lgkmcnt(0)" ::: "memory"); __builtin_amdgcn_s_barrier(); asm volatile("" ::: "memory");
    l += __shfl_xor(l, 32);
    const float inv = 1.f / l;
    LAS float* xch = (LAS float*)(lds + XCH_OFF + wq * 16384);
    if (c == 1) {
#pragma unroll
        for (int dt = 0; dt < 4; ++dt)
#pragma unroll
            for (int r = 0; r < 16; ++r) xch[(dt * 16 + r) * 64 + lane] = o[dt][r] * inv;
    }
    asm volatile("s_waitcnt lgkmcnt(0)" ::: "memory"); __builtin_amdgcn_s_barrier(); asm volatile("" ::: "memory");
    if (c == 0) {
        float ss = 0.f;
#pragma unroll
        for (int dt = 0; dt < 4; ++dt)
#pragma unroll
            for (int r = 0; r < 16; ++r) { const float v = o[dt][r] * inv - lam * xch[(dt * 16 + r) * 64 + lane]; o[dt][r] = v; ss += v * v; }
        ss += __shfl_xor(ss, 32);
        const float rsn = (1.f - LAMBDA_INIT) / sqrtf(ss * (1.f / 128.f) + RMS_EPS);
        bf16_t* orow = (bf16_t*)(F.p.ws + WS_MIX) + (size_t)(b * SEQ + qlo + r32) * D + h * 128;
#pragma unroll
        for (int dt = 0; dt < 4; ++dt)
#pragma unroll
            for (int r4 = 0; r4 < 4; ++r4) { const int dv = 32 * dt + 8 * r4 + 4 * hi; const f32x4 g = *(const f32x4*)(F.p.subln_g + dv);
                u32x2 w; w.x = pg8::cvt_pk_bf16(o[dt][4 * r4] * rsn * g[0], o[dt][4 * r4 + 1] * rsn * g[1]); w.y = pg8::cvt_pk_bf16(o[dt][4 * r4 + 2] * rsn * g[2], o[dt][4 * r4 + 3] * rsn * g[3]);
                *(u32x2*)(orow + dv) = w; }
    }
#undef ATT_DMA
}

__device__ __forceinline__ void attn_phase(Frame& F) {
    const float* lq = F.p.lam_qk; const int lane = F.lane;
    const float lam = __expf(wave_sum(lq[lane] * lq[64 + lane])) - __expf(wave_sum(lq[128 + lane] * lq[192 + lane])) + LAMBDA_INIT;
    volatile LAS unsigned* qw = (volatile LAS unsigned*)(F.lds + LDSCTL_OFF + 32);
    for (;;) {
        if (F.tid == 0) *qw = __hip_atomic_fetch_add(F.ctl + CW_QATT, 1u, __ATOMIC_RELAXED, __HIP_MEMORY_SCOPE_AGENT);
        __syncthreads();
        const unsigned u = (unsigned)__builtin_amdgcn_readfirstlane((int)*qw);
        if (u >= 1024u) break;
        attn_unit(F, (int)(u & 63u), 15 - (int)(u >> 6), lam);
    }
}
}

namespace ml {
typedef short s16x4 __attribute__((ext_vector_type(4)));
constexpr int KI = 0, VI = 32768, CB = 65536, BARR = 102400, AARR = 110592, GARR = 118784, PC = 126976, CWL = 129024, ML_END = 134144;
constexpr int ROWB = NPROJ * 2;
__device__ __forceinline__ unsigned swz(unsigned row) { return ((row & 3u) << 2) | ((row >> 2) & 3u); }
__device__ __forceinline__ unsigned off_b(unsigned row, unsigned ch) { return 256u * row + 16u * (ch ^ swz(row)); }
__device__ __forceinline__ s16x4 trrd(const LAS unsigned char* p) { return __builtin_bit_cast(s16x4, __builtin_amdgcn_ds_read_tr16_b64_v4i16((LAS s16x4*)p)); }
__device__ __forceinline__ f32x4 mfma16(bf16x8 a, bf16x8 b, f32x4 c) { return __builtin_amdgcn_mfma_f32_16x16x32_bf16(a, b, c, 0, 0, 0); }

__device__ __forceinline__ void conv8(const bf16_t* src, int t, const LAS float* cw, const LAS float* cb, int lc, float scale, float (&out)[8]) {
    float y[8];
    { const f32x4 b0 = *(const LAS f32x4*)(cb + lc), b1 = *(const LAS f32x4*)(cb + lc + 4); y[0] = b0[0]; y[1] = b0[1]; y[2] = b0[2]; y[3] = b0[3]; y[4] = b1[0]; y[5] = b1[1]; y[6] = b1[2]; y[7] = b1[3]; }
#pragma unroll
    for (int j = 0; j < 4; ++j) { const int tt = t - 3 + j;
        if (tt >= 0) { const u32x4 raw = *(const u32x4*)(src + (ptrdiff_t)(j - 3) * NPROJ);
            const f32x4 w0 = *(const LAS f32x4*)(cw + j * 256 + lc), w1 = *(const LAS f32x4*)(cw + j * 256 + lc + 4);
            y[0] += w0[0] * bf2f(raw.x & 0xffffu); y[1] += w0[1] * bf2f(raw.x >> 16); y[2] += w0[2] * bf2f(raw.y & 0xffffu); y[3] += w0[3] * bf2f(raw.y >> 16);
            y[4] += w1[0] * bf2f(raw.z & 0xffffu); y[5] += w1[1] * bf2f(raw.z >> 16); y[6] += w1[2] * bf2f(raw.w & 0xffffu); y[7] += w1[3] * bf2f(raw.w >> 16); } }
#pragma unroll
    for (int e = 0; e < 8; ++e) out[e] = y[e] * scale / (1.f + __expf(-y[e]));
}
__device__ __forceinline__ bf16x8 pack8(const float (&v)[8]) { u32x4 w; w.x = pg8::cvt_pk_bf16(v[0], v[1]); w.y = pg8::cvt_pk_bf16(v[2], v[3]); w.z = pg8::cvt_pk_bf16(v[4], v[5]); w.w = pg8::cvt_pk_bf16(v[6], v[7]); return __builtin_bit_cast(bf16x8, w); }

__device__ __forceinline__ void mlstm_unit(Frame& F, int bh) {
    LAS unsigned char* lds = F.lds + RING_OFF;
    const int tid = F.tid, lane = F.lane, w = F.wave, l15 = lane & 15, g = lane >> 4, q = l15 >> 2, p = lane & 3;
    const int b = bh >> 2, h = bh & 3; const size_t rowb = (size_t)b * SEQ;
    const bf16_t* PROJ = (const bf16_t*)(F.p.ws + WS_PROJ); const float* GATES = (const float*)(F.p.ws + WS_GATES); bf16_t* MIX = (bf16_t*)(F.p.ws + WS_MIX);
    LAS float* barr = (LAS float*)(lds + BARR); LAS float* aarr = (LAS float*)(lds + AARR); LAS float* garr = (LAS float*)(lds + GARR);
    LAS float* pc_u = (LAS float*)(lds + PC); LAS float* pc_sci = pc_u + 128; LAS float* pc_ws = pc_u + 256; LAS float* pc_emr = pc_u + 384;
    LAS float* cw = (LAS float*)(lds + CWL); LAS float* cb = cw + 1024;
    for (int i = tid; i < 36864 / 16; i += 512) *(LAS u32x4*)(lds + CB + 16 * i) = (u32x4){0u, 0u, 0u, 0u};
    for (int i = tid; i < 1024; i += 512) { const int j = i >> 8, lc = i & 255; const int cc = (lc < 128) ? h * 128 + lc : 512 + h * 128 + (lc - 128); cw[i] = F.p.conv_w[j * 1024 + cc]; if (j == 0) cb[lc] = F.p.conv_b[cc]; }
    for (int i = tid; i < SEQ; i += 512) { aarr[i] = GATES[(rowb + i) * 8 + h]; garr[i] = GATES[(rowb + i) * 8 + 4 + h]; }
    __syncthreads();
    for (int i = tid; i < SEQ; i += 512) { float s = 0.f; for (int j = i & ~127; j <= i; ++j) s += garr[j]; barr[i] = s; }
    __syncthreads();
    for (int i = tid; i < SEQ; i += 512) aarr[i] = aarr[i] - barr[i];
    __syncthreads();
    for (int i = tid; i < SEQ; i += 512) { float mx = -INFINITY; for (int j = i & ~127; j <= i; ++j) mx = fmaxf(mx, aarr[j]); garr[i] = mx; }
    __syncthreads();
    f32x4 accC[9];
#pragma unroll
    for (int vt = 0; vt < 9; ++vt) accC[vt] = (f32x4){0.f, 0.f, 0.f, 0.f};
    float mcur = 0.f;
    const bf16x8 onesf = (l15 == 0) ? (bf16x8){0x3F80, 0x3F80, 0x3F80, 0x3F80, 0x3F80, 0x3F80, 0x3F80, 0x3F80} : (bf16x8){0, 0, 0, 0, 0, 0, 0, 0};
    unsigned vsrc[4];
#pragma unroll
    for (int n = 0; n < 4; ++n) { const unsigned row = 4u * (w + 8 * n) + (lane >> 4), slot = lane & 15; vsrc[n] = row * ROWB + ((slot ^ swz(row)) << 4); }

    for (int ci = 0; ci < 16; ++ci) {
        const int t0 = ci * 128;
        const float bL = barr[t0 + 127], gend = garr[t0 + 127];
        const float mnew = bL + fmaxf(mcur, gend), sc = __expf(bL + mcur - mnew);
        if (tid < 128) { const float bt = barr[t0 + tid], mrow = bt + fmaxf(mcur, garr[t0 + tid]);
            pc_u[tid] = bt - mrow; pc_sci[tid] = __expf(bt + mcur - mrow); pc_ws[tid] = __expf(bL - mnew + aarr[t0 + tid]); pc_emr[tid] = __expf(-mrow); }
        { const char* vg = (const char*)(PROJ + (rowb + t0) * NPROJ + C_VM + h * 128);
#pragma unroll
          for (int n = 0; n < 4; ++n) __builtin_amdgcn_global_load_lds((const unsigned*)(vg + vsrc[n]), (LAS unsigned*)(lds + VI + (w + 8 * n) * 1024), 16, 0, 0); }
        { const int s = tid & 127, kq = tid >> 7; const bf16_t* src = PROJ + (rowb + t0 + s) * NPROJ + C_KM + h * 128 + 32 * kq;
#pragma unroll
          for (int j = 0; j < 4; ++j) { float o8[8]; conv8(src + 8 * j, t0 + s, cw, cb, 128 + 32 * kq + 8 * j, 0.08838834764831845f, o8);
              *(LAS bf16x8*)(lds + KI + off_b(s, 4 * kq + j)) = pack8(o8); } }
        bf16x8 qf[4];
        { const int t = t0 + 16 * w + l15; const bf16_t* src = PROJ + (rowb + t) * NPROJ + C_QM + h * 128 + 8 * g;
#pragma unroll
          for (int ks = 0; ks < 4; ++ks) { float o8[8]; conv8(src + 32 * ks, t, cw, cb, 32 * ks + 8 * g, 1.f, o8); qf[ks] = pack8(o8); } }
        asm volatile("s_waitcnt vmcnt(0) lgkmcnt(0)" ::: "memory"); __builtin_amdgcn_s_barrier(); asm volatile("" ::: "memory");
        const float ut = pc_u[16 * w + l15];
        bf16x8 smf[4];
#pragma unroll
        for (int i = 0; i < 4; ++i) {
            float sv[8];
#pragma unroll
            for (int hh = 0; hh < 2; ++hh) { const int st = 2 * i + hh;
                if (st <= w) { f32x4 acc = (f32x4){0.f, 0.f, 0.f, 0.f};
#pragma unroll
                    for (int ks = 0; ks < 4; ++ks) acc = mfma16(*(const LAS bf16x8*)(lds + KI + off_b(16 * st + l15, 4 * ks + g)), qf[ks], acc);
                    const f32x4 a4 = *(const LAS f32x4*)(aarr + t0 + 16 * st + 4 * g);
#pragma unroll
                    for (int r = 0; r < 4; ++r) { float v = __expf(ut + a4[r]) * acc[r]; if (st == w && (4 * g + r) > l15) v = 0.f; sv[4 * hh + r] = v; } }
                else {
#pragma unroll
                    for (int r = 0; r < 4; ++r) sv[4 * hh + r] = 0.f; } }
            smf[i] = pack8(sv); }
        const float scit = pc_sci[16 * w + l15];
        f32x4 num[9];
#pragma unroll
        for (int vt = 0; vt < 9; ++vt) { f32x4 acc = (f32x4){0.f, 0.f, 0.f, 0.f};
#pragma unroll
            for (int ks = 0; ks < 4; ++ks) acc = mfma16(*(const LAS bf16x8*)(lds + CB + off_b(16 * vt + l15, 4 * ks + g)), qf[ks], acc);
            acc = acc * scit;
#pragma unroll
            for (int i = 0; i < 4; ++i) { if (2 * i <= w) { bf16x8 vf;
                    if (vt < 8) { const s16x4 lo = trrd(lds + VI + off_b(32 * i + 4 * g + q, 2 * vt + (p >> 1)) + 8 * (p & 1)), hi = trrd(lds + VI + off_b(32 * i + 16 + 4 * g + q, 2 * vt + (p >> 1)) + 8 * (p & 1));
                        vf = (bf16x8){lo[0], lo[1], lo[2], lo[3], hi[0], hi[1], hi[2], hi[3]}; }
                    else vf = onesf;
                    acc = mfma16(vf, smf[i], acc); } }
            num[vt] = acc; }
        { const int t = t0 + 16 * w + l15;
          const float den = __shfl(num[8][0], l15); const float hd = 1.f / fmaxf(fabsf(den), pc_emr[16 * w + l15]);
          const bf16_t* omp = PROJ + (rowb + t) * NPROJ + C_OM + h * 128 + 4 * g; float ss = 0.f;
#pragma unroll
          for (int vt = 0; vt < 8; ++vt) { const u32x2 ow = *(const u32x2*)(omp + 16 * vt);
              const float o0 = bf2f(ow.x & 0xffffu), o1 = bf2f(ow.x >> 16), o2 = bf2f(ow.y & 0xffffu), o3 = bf2f(ow.y >> 16);
              f32x4 hv = num[vt] * hd; hv[0] *= sigmoidf_(o0); hv[1] *= sigmoidf_(o1); hv[2] *= sigmoidf_(o2); hv[3] *= sigmoidf_(o3);
              num[vt] = hv; ss += (hv[0] * hv[0] + hv[1] * hv[1]) + (hv[2] * hv[2] + hv[3] * hv[3]); }
          ss += __shfl_xor(ss, 16); ss += __shfl_xor(ss, 32);
          const float rs = 1.f / sqrtf(ss * (1.f / 128.f) + RMS_EPS);
          bf16_t* op = MIX + (rowb + t) * D + 512 + h * 128 + 4 * g; const float* gp = F.p.mhnorm_g + h * 128 + 4 * g;
#pragma unroll
          for (int vt = 0; vt < 8; ++vt) { const f32x4 gg = *(const f32x4*)(gp + 16 * vt); const f32x4 hv = num[vt] * rs * gg;
              u32x2 ww; ww.x = pg8::cvt_pk_bf16(hv[0], hv[1]); ww.y = pg8::cvt_pk_bf16(hv[2], hv[3]); *(u32x2*)(op + 16 * vt) = ww; } }
        asm volatile("s_waitcnt lgkmcnt(0)" ::: "memory"); __builtin_amdgcn_s_barrier(); asm volatile("" ::: "memory");
        { bf16x8 kf[4];
#pragma unroll
          for (int i = 0; i < 4; ++i) { float kv[8];
#pragma unroll
              for (int t2 = 0; t2 < 2; ++t2) { const s16x4 raw = trrd(lds + KI + off_b(32 * i + 8 * g + 4 * t2 + q, 2 * w + (p >> 1)) + 8 * (p & 1)); const f32x4 w4 = *(const LAS f32x4*)(pc_ws + 32 * i + 8 * g + 4 * t2);
#pragma unroll
                  for (int e = 0; e < 4; ++e) kv[4 * t2 + e] = bf2f((unsigned)(unsigned short)raw[e]) * w4[e]; }
              kf[i] = pack8(kv); }
#pragma unroll
          for (int vt = 0; vt < 9; ++vt) { f32x4 acc = accC[vt] * sc;
#pragma unroll
              for (int i = 0; i < 4; ++i) { bf16x8 vf;
                  if (vt < 8) { const s16x4 lo = trrd(lds + VI + off_b(32 * i + 8 * g + q, 2 * vt + (p >> 1)) + 8 * (p & 1)), hi = trrd(lds + VI + off_b(32 * i + 8 * g + 4 + q, 2 * vt + (p >> 1)) + 8 * (p & 1));
                      vf = (bf16x8){lo[0], lo[1], lo[2], lo[3], hi[0], hi[1], hi[2], hi[3]}; }
                  else vf = onesf;
                  acc = mfma16(kf[i], vf, acc); }
              accC[vt] = acc;
              u32x2 ww; ww.x = pg8::cvt_pk_bf16(acc[0], acc[1]); ww.y = pg8::cvt_pk_bf16(acc[2], acc[3]);
              *(LAS u32x2*)(lds + CB + off_b(16 * vt + l15, 2 * w + (g >> 1)) + 8 * (g & 1)) = ww; } }
        mcur = mnew;
        asm volatile("s_waitcnt lgkmcnt(0)" ::: "memory"); __builtin_amdgcn_s_barrier(); asm volatile("" ::: "memory");
    }
}
}

namespace rt {
constexpr int WROW = 2064;
constexpr int LOGI_OFF = 100352, HIST_OFF = 124928;
__device__ __forceinline__ void router_phase(Frame& F) {
    const Ptrs& p = F.p; LAS unsigned char* lds = F.lds + RING_OFF;
    const int tid = F.tid, lane = F.lane, w = F.wave, l15 = lane & 15, g = lane >> 4;
    const bf16_t* WR = (const bf16_t*)(p.ws + WS_WR); const bf16_t* X1B = (const bf16_t*)(p.ws + WS_X1B);
    int* list = (int*)(p.ws + WS_LIST); float* tokw = (float*)(p.ws + WS_TOKW); float* rstd_o = (float*)(p.ws + WS_RSTD);
    LAS int* hist = (LAS int*)(lds + HIST_OFF); LAS int* base = hist + 32;
    LAS float* lg = (LAS float*)(lds + LOGI_OFF + w * 3072);
    for (int i = tid; i < 48 * 128; i += 512) { const int row = i >> 7, ch = i & 127; *(LAS u32x4*)(lds + row * WROW + ch * 16) = *(const u32x4*)(WR + row * 1024 + ch * 8); }
    for (int blk = F.vcu; blk < T / 128; blk += F.G) {
        if (tid < 32) hist[tid] = 0;
        __syncthreads();
        const int row0 = blk * 128 + 16 * w;
        f32x4 acc[3]; float ss = 0.f;
#pragma unroll
        for (int ct = 0; ct < 3; ++ct) acc[ct] = (f32x4){0.f, 0.f, 0.f, 0.f};
        const bf16_t* ap = X1B + (size_t)(row0 + l15) * D + 8 * g;
#pragma unroll 4
        for (int ks = 0; ks < 32; ++ks) { const bf16x8 a = *(const bf16x8*)(ap + 32 * ks);
#pragma unroll
            for (int e = 0; e < 8; ++e) { const float v = bf2f((unsigned)(unsigned short)a[e]); ss += v * v; }
#pragma unroll
            for (int ct = 0; ct < 3; ++ct) acc[ct] = __builtin_amdgcn_mfma_f32_16x16x32_bf16(a, *(const LAS bf16x8*)(lds + (16 * ct + l15) * WROW + (32 * ks + 8 * g) * 2), acc[ct], 0, 0, 0); }
        ss += __shfl_xor(ss, 16); ss += __shfl_xor(ss, 32);
        const float rstd = 1.f / sqrtf(ss * (1.f / D) + RMS_EPS);
#pragma unroll
        for (int ct = 0; ct < 3; ++ct)
#pragma unroll
            for (int r = 0; r < 4; ++r) lg[(4 * g + r) * 48 + 16 * ct + l15] = acc[ct][r];
        asm volatile("s_waitcnt lgkmcnt(0)" ::: "memory");
        int ea = 0, eb = 0, ra = 0, rb = 0; float w0 = 0.f, w1 = 0.f; const int tok = row0 + lane;
        if (lane < 16) {
            const LAS float* ll = lg + lane * 48;
            float gl[4];
#pragma unroll
            for (int j = 0; j < 4; ++j) gl[j] = ll[j] * rstd + p.b_grp[j];
            int gs = 0; float gm = gl[0];
#pragma unroll
            for (int j = 1; j < 4; ++j) if (gl[j] > gm) { gm = gl[j]; gs = j; }
            float gsum = 0.f;
#pragma unroll
            for (int j = 0; j < 4; ++j) gsum += __expf(gl[j] - gm);
            const float gwt = 1.f / gsum;
            float el[8];
#pragma unroll
            for (int e = 0; e < 8; ++e) el[e] = ll[4 + gs * 8 + e] * rstd + p.b_er[gs * 8 + e];
            int i0 = 0; float v0 = el[0];
#pragma unroll
            for (int e = 1; e < 8; ++e) if (el[e] > v0) { v0 = el[e]; i0 = e; }
            int i1 = 0; float v1 = -INFINITY;
#pragma unroll
            for (int e = 0; e < 8; ++e) if (e != i0 && el[e] > v1) { v1 = el[e]; i1 = e; }
            const float e1 = __expf(v1 - v0); w0 = gwt / (1.f + e1); w1 = gwt * e1 / (1.f + e1);
            ea = gs * 8 + i0; eb = gs * 8 + i1;
            ra = __hip_atomic_fetch_add(hist + ea, 1, __ATOMIC_RELAXED, __HIP_MEMORY_SCOPE_WORKGROUP);
            rb = __hip_atomic_fetch_add(hist + eb, 1, __ATOMIC_RELAXED, __HIP_MEMORY_SCOPE_WORKGROUP);
            rstd_o[tok] = rstd;
        }
        __syncthreads();
        if (tid < 32) base[tid] = (int)__hip_atomic_fetch_add(F.ctl + CW_CNT + 64 * tid, (unsigned)hist[tid], __ATOMIC_RELAXED, __HIP_MEMORY_SCOPE_AGENT);
        __syncthreads();
        if (lane < 16) {
            list[(size_t)ea * LIST_CAP + base[ea] + ra] = tok * 2; list[(size_t)eb * LIST_CAP + base[eb] + rb] = tok * 2 + 1;
            tokw[tok * 2] = w0; tokw[tok * 2 + 1] = w1; }
        __syncthreads();
    }
}
}
#ifndef ATT_FAST
#define ATT_FAST 1
#endif
#ifndef ML_FAST
#define ML_FAST 1
#endif
#ifndef RT_FAST
#define RT_FAST 1
#endif
struct Args { Ptrs p; int ph_lo, ph_hi; };
constexpr int N_PHASES = 9;
__global__ void __launch_bounds__(NWAVES * 64, 2) mk_fwd(Args args) {
    extern __shared__ __attribute__((aligned(16))) unsigned char lds_raw[];
    Frame F;
    F.lds = (LAS unsigned char*)lds_raw; F.p = args.p;
    F.tid = threadIdx.x; F.lane = F.tid & 63; F.wave = __builtin_amdgcn_readfirstlane(F.tid >> 6);
    F.G = gridDim.x; { const int bx = blockIdx.x; F.vcu = (F.G % 8 == 0) ? (bx % 8) * (F.G / 8) + bx / 8 : bx; }
    F.ctl = (unsigned*)(args.p.ws + WS_CTL);
    for (int u = F.tid; u < (LDS_BYTES - LDSCTL_OFF) / 4; u += NWAVES * 64) ((LAS unsigned*)(F.lds + LDSCTL_OFF))[u] = 0u;
    __syncthreads();
    XcdBarrier bar = xcd_barrier_post(F.ctl + CW_BAR, (volatile LAS unsigned*)(F.lds + MISC_OFF) + 8);
    const int lo = args.ph_lo, hi = args.ph_hi;
    unsigned char* ws = args.p.ws;
#define IN(k) (lo <= (k) && (k) < hi)
#define SEAM(k) do { if (IN(k) && IN((k) + 1)) xcd_barrier(bar); } while (0)

    if (IN(0)) { p0_prologue(F); }
    SEAM(0);
    if (IN(1)) {
        pg8::StaticOrder S; S.init(ws + WS_HB, ws + WS_WIN, T, NPROJ, D, F.G, (int)blockIdx.x);
        const float* cs = (const float*)(ws + WS_ROPE);
        pg8::EpiProj E{(bf16_t*)(ws + WS_PROJ), cs, cs + 2048 * 32};
        pg8::gemm_phase<pg8::EpiProj, pg8::StaticOrder, true, false>(F.lds + RING_OFF, D, S, E);
    }
    SEAM(1);
#if ATT_FAST
#if ML_FAST
    if (IN(2)) { if (blockIdx.x < BATCH * 4) { ml::mlstm_unit(F, (int)blockIdx.x); __syncthreads(); } att::attn_phase(F); }
#else
    if (IN(2)) { att::attn_phase(F); }
    SEAM(2);
    if (IN(3)) { if (blockIdx.x < BATCH * 4) mlstm_ref_body(F, (int)blockIdx.x); }
#endif
#else
    if (IN(2)) { attn_ref_body(F); }
    SEAM(2);
    if (IN(3)) { attn_combine_body(F); if (blockIdx.x < BATCH * 4) mlstm_ref_body(F, (int)blockIdx.x); }
#endif
    SEAM(3);
    if (IN(4)) {
        pg8::StaticOrder S; S.init(ws + WS_MIX, ws + WS_WOUT, T, D, D, F.G, (int)blockIdx.x);
        pg8::EpiOut E{F.p.x, F.p.out, (bf16_t*)(ws + WS_X1B)};
        pg8::gemm_phase<pg8::EpiOut, pg8::StaticOrder, true, false>(F.lds + RING_OFF, D, S, E);
    }
    SEAM(4);
#if RT_FAST
    if (IN(5)) { rt::router_phase(F); }
#else
    if (IN(5)) { router_ref_body(F); }
#endif
    SEAM(5);
    if (IN(6)) {
        moe_tables(F);
        pg8::MoeOrder S{(const LAS int*)(F.lds + TAB_OFF), F.G, F.vcu, (const char*)(ws + WS_X1B), (const char*)(ws + WS_W13), (size_t)1024 * 1024 * 2, (size_t)256 * 1024 * 2, 0, true, (const int*)(ws + WS_LIST), D};
        pg8::EpiUp E{(bf16_t*)(ws + WS_HD), (const float*)(ws + WS_RSTD), (const int*)(ws + WS_LIST)};
        pg8::gemm_phase<pg8::EpiUp, pg8::MoeOrder, true, true>(F.lds + RING_OFF, D, S, E);
    }
    SEAM(6);
    if (IN(7)) {
        moe_tables(F);
        pg8::MoeOrder S{(const LAS int*)(F.lds + TAB_OFF), F.G, F.vcu, (const char*)(ws + WS_HD), (const char*)(ws + WS_W2), (size_t)1024 * 512 * 2, (size_t)256 * 512 * 2, (size_t)DE * 2, false, (const int*)(ws + WS_LIST), DE};
        pg8::EpiDown E{(bf16_t*)(ws + WS_Y), (const float*)(ws + WS_TOKW), (const int*)(ws + WS_LIST)};
        pg8::gemm_phase<pg8::EpiDown, pg8::MoeOrder, true, false>(F.lds + RING_OFF, DE, S, E);
    }
    SEAM(7);
    if (IN(8)) { final_body(F); }
#undef IN
#undef SEAM
}

extern "C" void kernel_launch(void* const* d_in, const int* in_sizes, int n_in, void* d_out, int out_size, void* d_ws, size_t ws_size, hipStream_t stream) {
    static int grid = 0;
    if (grid == 0) {
        if (n_in != 19 || out_size != T * D || ws_size < WS_END) { fprintf(stderr, "kernel_launch: unexpected shapes (n_in %d out %d ws %zu)\n", n_in, out_size, ws_size); grid = -1; return; }
        int dev = 0, cus = 0, per_cu = 0;
        if (hipGetDevice(&dev) != hipSuccess || hipDeviceGetAttribute(&cus, hipDeviceAttributeMultiprocessorCount, dev) != hipSuccess) { grid = -1; return; }
        if (hipFuncSetAttribute((const void*)mk_fwd, hipFuncAttributeMaxDynamicSharedMemorySize, LDS_BYTES) != hipSuccess) { fprintf(stderr, "kernel_launch: hipFuncSetAttribute failed\n"); grid = -1; return; }
        if (hipOccupancyMaxActiveBlocksPerMultiprocessor(&per_cu, (const void*)mk_fwd, NWAVES * 64, LDS_BYTES) != hipSuccess || per_cu < 1) { fprintf(stderr, "kernel_launch: occupancy query says %d\n", per_cu); }
        (void)hipGetLastError();
        grid = cus;
    }
    if (grid < 0) return;
    Args a{};
    Ptrs& p = a.p;
    p.x = (const float*)d_in[0]; p.w_in = (const float*)d_in[1]; p.conv_w = (const float*)d_in[2]; p.conv_b = (const float*)d_in[3]; p.gate_b = (const float*)d_in[4];
    p.lam_qk = (const float*)d_in[5]; p.subln_g = (const float*)d_in[6]; p.mhnorm_g = (const float*)d_in[7]; p.w_out = (const float*)d_in[8]; p.g_mix = (const float*)d_in[9];
    p.g_ffn = (const float*)d_in[10]; p.w_grp = (const float*)d_in[11]; p.b_grp = (const float*)d_in[12]; p.w_er = (const float*)d_in[13]; p.b_er = (const float*)d_in[14];
    p.w1 = (const float*)d_in[15]; p.w3 = (const float*)d_in[16]; p.w2 = (const float*)d_in[17]; p.g_final = (const float*)d_in[18];
    p.out = (float*)d_out; p.ws = (unsigned char*)d_ws;
    if (hipMemsetAsync((char*)d_ws + WS_CTL, 0, CTL_ZERO_BYTES, stream) != hipSuccess) return;
    a.ph_lo = 0; a.ph_hi = N_PHASES;
    hipLaunchKernelGGL(mk_fwd, dim3(grid), dim3(NWAVES * 64), LDS_BYTES, stream, a);
}
```

```cpp
#include <hip/hip_runtime.h>
#include <cstdio>
#include <cstdint>

constexpr int BATCH = 16, SEQ = 2048, D = 1024, T = BATCH * SEQ;
constexpr int DIN = 3592, NPROJ = 3584;
constexpr int C_QA = 0, C_KA = 512, C_VA = 1024, C_QM = 1536, C_KM = 2048, C_VM = 2560, C_OM = 3072, C_IG = 3584, C_FG = 3588;
constexpr int NE = 32, EPG = 8, DE = 512;
constexpr float RMS_EPS = 1e-6f;
constexpr float LAMBDA_INIT = 0.2f;
constexpr float C2Q = 0.125f * 1.4426950408889634f;
constexpr int LIST_CAP = T;

constexpr size_t MiB = 1u << 20;
constexpr size_t WS_CTL = 0, CTL_ZERO_BYTES = 1 * MiB;
constexpr size_t WS_ROPE = 1 * MiB;
constexpr size_t WS_TOKW = 2 * MiB;
constexpr size_t WS_RSTD = 2 * MiB + 512 * 1024;
constexpr size_t WS_WR = 3 * MiB;
constexpr size_t WS_GSC = 468 * MiB;
constexpr size_t WS_LIST = 4 * MiB;
constexpr size_t WS_GATES = 8 * MiB;
constexpr size_t WS_WIN = 10 * MiB;
constexpr size_t WS_WOUT = 17 * MiB;
constexpr size_t WS_W13 = 20 * MiB;
constexpr size_t WS_W2 = 84 * MiB;
constexpr size_t WS_PROJ = 116 * MiB;
constexpr size_t WS_MIX = 340 * MiB;
constexpr size_t WS_X1B = 404 * MiB;
constexpr size_t WS_HB = 404 * MiB;
constexpr size_t WS_HD = 116 * MiB;
constexpr size_t WS_Y = 188 * MiB;
constexpr size_t WS_END = 470 * MiB;
constexpr int CW_TMO = 0, CW_CODE = 1;
constexpr int CW_CNT = 1024;
constexpr int CW_BAR = 4096;
constexpr int CW_QATT = 16384;

#define LAS __attribute__((address_space(3)))
typedef unsigned short bf16_t;
typedef short bf16x8 __attribute__((ext_vector_type(8)));
typedef float f32x4 __attribute__((ext_vector_type(4)));
typedef unsigned u32x4 __attribute__((ext_vector_type(4)));
typedef unsigned u32x2 __attribute__((ext_vector_type(2)));

__device__ __forceinline__ unsigned f2bf(float f) { unsigned u = __float_as_uint(f); return (u + 0x7fffu + ((u >> 16) & 1u)) >> 16; }
__device__ __forceinline__ unsigned pk2(float lo, float hi) { return f2bf(lo) | (f2bf(hi) << 16); }
__device__ __forceinline__ float bf2f(unsigned b) { return __uint_as_float(b << 16); }
__device__ __forceinline__ float wave_sum(float v) {
#pragma unroll
    for (int o = 1; o < 64; o <<= 1) v += __shfl_xor(v, o);
    return v;
}
__device__ __forceinline__ float sigmoidf_(float x) { return 1.f / (1.f + __expf(-x)); }

struct MapId { __device__ __forceinline__ int operator()(int n) const { return n; } };
struct MapRope {
    __device__ __forceinline__ int operator()(int c) const { if (c >= 1024) return c; const int g = c & ~63, d = c & 63; return g + 8 * ((d & 31) >> 2) + 4 * (d >> 5) + (d & 3); } };
struct MapW1 { __device__ __forceinline__ int operator()(int c) const { return 256 * (c >> 7) + (c & 127); } };
struct MapW3 { __device__ __forceinline__ int operator()(int c) const { return 256 * (c >> 7) + 128 + (c & 127); } };
template <class Map>
__device__ __forceinline__ void transpose_item(const float* W, int ldw, bf16_t* WT, int K, int k0, int n0, const Map& map, const float* kscale, LAS float* scr, int lane) {
#pragma unroll 8
    for (int i = 0; i < 32; ++i) { const int kk = 2 * i + (lane >> 5); scr[kk * 33 + (lane & 31)] = W[(size_t)(k0 + kk) * ldw + n0 + (lane & 31)]; }
    asm volatile("s_waitcnt vmcnt(0) lgkmcnt(0)" ::: "memory");
    const int c = lane & 7;
    float ks[8];
#pragma unroll
    for (int i = 0; i < 8; ++i) ks[i] = kscale ? kscale[k0 + 8 * c + i] : 1.f;
#pragma unroll
    for (int j = 0; j < 4; ++j) { const int n = (lane >> 3) + 8 * j; const LAS float* s = scr + (8 * c) * 33 + n;
        u32x4 o; o.x = pk2(s[0 * 33] * ks[0], s[1 * 33] * ks[1]); o.y = pk2(s[2 * 33] * ks[2], s[3 * 33] * ks[3]); o.z = pk2(s[4 * 33] * ks[4], s[5 * 33] * ks[5]); o.w = pk2(s[6 * 33] * ks[6], s[7 * 33] * ks[7]);
        *(u32x4*)(WT + (size_t)map(n0 + n) * K + k0 + 8 * c) = o; }
    asm volatile("s_waitcnt lgkmcnt(0)" ::: "memory");
}

struct Ptrs {
    const float *x, *w_in, *conv_w, *conv_b, *gate_b, *lam_qk, *subln_g, *mhnorm_g, *w_out, *g_mix, *g_ffn, *w_grp, *b_grp, *w_er, *b_er, *w1, *w3, *w2, *g_final;
    float* out; unsigned char* ws;
};


namespace pg8 {
#define PG8_LAS __attribute__((address_space(3)))
constexpr int BM = 256, BK = 64, HALF = 128, HTB = HALF * BK * 2, STAGE_BYTES = 8 * HTB, NXCD = 8, WGM = 8;
__host__ __device__ __forceinline__ int lds_byte(int r, int c) { const int st = (r >> 4) * 2 + (c >> 5), rr = r & 15, cc = c & 31, ob = rr * 64 + cc * 2; return st * 1024 + (ob ^ (((ob >> 9) & 1) << 5)); }
__host__ __device__ __forceinline__ void stage_rc(int b, int& R, int& C) { const int st = b / 1024, sb = b % 1024, swz = sb ^ (((sb >> 9) & 1) << 5); R = (st >> 1) * 16 + swz / 64; C = (st & 1) * 32 + (swz % 64) / 2; }
__host__ __device__ __forceinline__ int perm32(int rho) { const int n = rho >> 4, i = rho & 15; return 8 * (i >> 2) + 4 * n + (i & 3); }

struct Unit { int pm, pn; const char* a; const char* b; int e, cnt, ps; };

struct StaticOrder {
    int nM, nN, nwg, G, c; const char* A; const char* Bt; size_t tstep;
    __device__ void init(const void* A_, const void* Bt_, int M, int N, int K, int G_, int c_) { A = (const char*)A_; Bt = (const char*)Bt_; nM = M / BM; nN = N / BM; nwg = nM * nN; G = G_; c = c_; tstep = (size_t)BM * K * 2; }
    __device__ bool next(int i, Unit& u) const {
        const long L = (long)i * G + c; if (L >= nwg) return false;
        int wgid = (int)L; { const int q = nwg / NXCD, r = nwg % NXCD, xcd = wgid % NXCD, off = wgid / NXCD; wgid = (xcd < r ? xcd * (q + 1) : r * (q + 1) + (xcd - r) * q) + off; }
        const int nig = WGM * nN, gid = wgid / nig, fm = gid * WGM, gsz = (nM - fm) < WGM ? (nM - fm) : WGM;
        u.pm = fm + ((wgid % nig) % gsz); u.pn = (wgid % nig) / gsz; u.a = A + (size_t)u.pm * tstep; u.b = Bt + (size_t)u.pn * tstep; u.e = 0; u.cnt = 0; u.ps = 0; return true;
    }
    __device__ __forceinline__ unsigned row_off(const Unit&, int) const { return 0u; }
};
struct MoeOrder {
    const PG8_LAS int* tab; int G, vcu; const char* A; const char* Bt; size_t bstep_e, bstep_n, astep; bool gather; const int* list; int K;
    __device__ bool next(int i, Unit& u) const {
        const int L = i * G + vcu; if (L >= tab[32]) return false;
        int e = 0;
#pragma unroll 1
        for (int j = 1; j < 32; ++j) e = (L >= tab[j]) ? j : e;
        const int loc = L - tab[e]; u.e = e; u.pn = loc & 3; u.pm = loc >> 2; u.cnt = tab[128 + e]; u.ps = tab[64 + e];
        u.b = Bt + (size_t)e * bstep_e + (size_t)u.pn * bstep_n;
        u.a = gather ? A : A + (size_t)(u.ps + u.pm * BM) * astep;
        return true;
    }
    __device__ __forceinline__ unsigned row_off(const Unit& u, int r) const {
        const int s = u.pm * BM + r; const int a = (s < u.cnt) ? list[(size_t)u.e * LIST_CAP + s] : 0; return (unsigned)(a >> 1) * (unsigned)(K * 2);
    }
};

typedef float f32x2_t __attribute__((ext_vector_type(2))); typedef __bf16 bf16x2_t __attribute__((ext_vector_type(2)));
__device__ __forceinline__ unsigned cvt_pk_bf16(float lo, float hi) { const f32x2_t v = {lo, hi}; const bf16x2_t b = __builtin_convertvector(v, bf16x2_t); return __builtin_bit_cast(unsigned, b); }

struct EpiProj {
    static constexpr bool PERM = true;
    bf16_t* O; const float* cs; const float* sn;
    __device__ __forceinline__ void operator()(const f32x4 (&acc)[2][2][4][2], const Unit& u, int wr, int wc, int fr, int fq) const {
        const int row0 = u.pm * BM + wr * 64 + fr, colt = u.pn * BM;
        if (u.pn < 4) {
            const float sc = (u.pn < 2) ? C2Q : 1.f; const int q8 = 4 * (wc & 1) + fq;
#pragma unroll
            for (int ai = 0; ai < 2; ++ai)
#pragma unroll
                for (int m = 0; m < 4; ++m) { const int row = row0 + ai * HALF + m * 16, pos = row & (SEQ - 1);
                    const f32x4 c4 = *(const f32x4*)(cs + pos * 32 + 4 * q8) * sc, s4 = *(const f32x4*)(sn + pos * 32 + 4 * q8) * sc;
                    bf16_t* rowp = O + (size_t)row * NPROJ + colt + 64 * (wc >> 1) + 4 * q8;
#pragma unroll
                    for (int bj = 0; bj < 2; ++bj) { const f32x4 x1 = acc[ai][bj][m][0], x2 = acc[ai][bj][m][1]; const f32x4 o1 = x1 * c4 - x2 * s4, o2 = x1 * s4 + x2 * c4;
                        u32x2 w1, w2; w1.x = cvt_pk_bf16(o1[0], o1[1]); w1.y = cvt_pk_bf16(o1[2], o1[3]); w2.x = cvt_pk_bf16(o2[0], o2[1]); w2.y = cvt_pk_bf16(o2[2], o2[3]);
                        *(u32x2*)(rowp + bj * HALF) = w1; *(u32x2*)(rowp + bj * HALF + 32) = w2; } }
        } else {
            const int col0 = colt + wc * 32 + 8 * fq;
#pragma unroll
            for (int ai = 0; ai < 2; ++ai)
#pragma unroll
                for (int m = 0; m < 4; ++m) { bf16_t* rowp = O + (size_t)(row0 + ai * HALF + m * 16) * NPROJ + col0;
#pragma unroll
                    for (int bj = 0; bj < 2; ++bj) { const f32x4 v0 = acc[ai][bj][m][0], v1 = acc[ai][bj][m][1];
                        u32x4 w; w.x = cvt_pk_bf16(v0[0], v0[1]); w.y = cvt_pk_bf16(v0[2], v0[3]); w.z = cvt_pk_bf16(v1[0], v1[1]); w.w = cvt_pk_bf16(v1[2], v1[3]);
                        *(u32x4*)(rowp + bj * HALF) = w; } }
        }
    }
};
struct EpiOut {
    static constexpr bool PERM = true;
    const float* x; float* X1; bf16_t* X1B;
    __device__ __forceinline__ void operator()(const f32x4 (&acc)[2][2][4][2], const Unit& u, int wr, int wc, int fr, int fq) const {
        const int row0 = u.pm * BM + wr * 64 + fr, col0 = u.pn * BM + wc * 32 + 8 * fq;
#pragma unroll
        for (int ai = 0; ai < 2; ++ai)
#pragma unroll
            for (int m = 0; m < 4; ++m) { const size_t off = (size_t)(row0 + ai * HALF + m * 16) * D + col0;
#pragma unroll
                for (int bj = 0; bj < 2; ++bj) { const f32x4 v0 = acc[ai][bj][m][0] + *(const f32x4*)(x + off + bj * HALF), v1 = acc[ai][bj][m][1] + *(const f32x4*)(x + off + bj * HALF + 4);
                    *(f32x4*)(X1 + off + bj * HALF) = v0; *(f32x4*)(X1 + off + bj * HALF + 4) = v1;
                    u32x4 w; w.x = cvt_pk_bf16(v0[0], v0[1]); w.y = cvt_pk_bf16(v0[2], v0[3]); w.z = cvt_pk_bf16(v1[0], v1[1]); w.w = cvt_pk_bf16(v1[2], v1[3]);
                    *(u32x4*)(X1B + off + bj * HALF) = w; }
                asm volatile("" ::: "memory"); }
    }
};
struct EpiUp {
    static constexpr bool PERM = true;
    bf16_t* HD; const float* rstd; const int* list;
    __device__ __forceinline__ void operator()(const f32x4 (&acc)[2][2][4][2], const Unit& u, int wr, int wc, int fr, int fq) const {
        const int r0 = u.pm * BM + wr * 64 + fr, col0 = u.pn * HALF + wc * 32 + 8 * fq;
#pragma unroll
        for (int ai = 0; ai < 2; ++ai)
#pragma unroll
            for (int m = 0; m < 4; ++m) { const int s = r0 + ai * HALF + m * 16; if (s < u.cnt) { const float rs = rstd[list[(size_t)u.e * LIST_CAP + s] >> 1];
                    float h[8];
#pragma unroll
                    for (int n = 0; n < 2; ++n)
#pragma unroll
                        for (int i = 0; i < 4; ++i) { const float a = acc[ai][0][m][n][i] * rs, b = acc[ai][1][m][n][i] * rs; h[4 * n + i] = a * b / (1.f + __expf(-a)); }
                    u32x4 w; w.x = cvt_pk_bf16(h[0], h[1]); w.y = cvt_pk_bf16(h[2], h[3]); w.z = cvt_pk_bf16(h[4], h[5]); w.w = cvt_pk_bf16(h[6], h[7]);
                    *(u32x4*)(HD + (size_t)(u.ps + s) * DE + col0) = w; } }
    }
};
struct EpiDown {
    static constexpr bool PERM = true;
    bf16_t* Y; const float* tokw; const int* list;
    __device__ __forceinline__ void operator()(const f32x4 (&acc)[2][2][4][2], const Unit& u, int wr, int wc, int fr, int fq) const {
        const int r0 = u.pm * BM + wr * 64 + fr, col0 = u.pn * BM + wc * 32 + 8 * fq;
#pragma unroll
        for (int ai = 0; ai < 2; ++ai)
#pragma unroll
            for (int m = 0; m < 4; ++m) { const int s = r0 + ai * HALF + m * 16; if (s < u.cnt) { const int a = list[(size_t)u.e * LIST_CAP + s]; const float w8 = tokw[a];
                    bf16_t* rowp = Y + (size_t)a * D + col0;
#pragma unroll
                    for (int bj = 0; bj < 2; ++bj) { const f32x4 v0 = acc[ai][bj][m][0] * w8, v1 = acc[ai][bj][m][1] * w8;
                        u32x4 w; w.x = cvt_pk_bf16(v0[0], v0[1]); w.y = cvt_pk_bf16(v0[2], v0[3]); w.z = cvt_pk_bf16(v1[0], v1[1]); w.w = cvt_pk_bf16(v1[2], v1[3]);
                        *(u32x4*)(rowp + bj * HALF) = w; } } }
    }
};

template <class Epi, class Sched, bool ALIGN_EPI, bool GATHER>
__device__ __forceinline__ void gemm_phase(PG8_LAS unsigned char* lds, const int K, const Sched& S, const Epi& E) {
    const int tid = threadIdx.x, wid = __builtin_amdgcn_readfirstlane(tid >> 6), lane = tid & 63, wr = wid >> 2, wc = wid & 3, fr = lane & 15, fq = lane >> 4;
    const int nt = K / BK;
    unsigned voffB[2], ga[2][2], gn[2][2]; int RA[2], CA[2];
#pragma unroll
    for (int i = 0; i < 2; ++i) { int R, C; stage_rc(tid * 16 + i * 8192, R, C); const int Rb = Epi::PERM ? ((R & ~31) + perm32(R & 31)) : R;
        RA[i] = R; CA[i] = C; voffB[i] = (unsigned)(Rb * K + C) * 2u; }
    const size_t kstep = (size_t)(BK * 2);
    const size_t hstep = (size_t)HALF * K * 2;
    const unsigned ldsw = (unsigned)wid * 1024u;
    const int aoff = lds_byte(wr * 64 + fr, fq * 8), boff = lds_byte(wc * 32 + fr, fq * 8);
#define PG8_SA(b, h) (((b) * 2 + (h)) * HTB)
#define PG8_SB(b, h) ((4 + (b) * 2 + (h)) * HTB)
#define PG8_STAGE(bufoff, gbase, voff) do { _Pragma("unroll") for (int _i = 0; _i < 2; ++_i) \
        __builtin_amdgcn_global_load_lds((const unsigned*)((const char*)(gbase) + (voff)[_i]), (PG8_LAS unsigned*)(lds + (bufoff) + ldsw + _i * 8192), 16, 0, 0); } while (0)
#define PG8_LDA(dst, b, h) do { _Pragma("unroll") for (int m = 0; m < 4; ++m) _Pragma("unroll") for (int k = 0; k < 2; ++k) dst[m][k] = *(const PG8_LAS bf16x8*)(lds + PG8_SA(b, h) + aoff + m * 2048 + k * 1024); } while (0)
#define PG8_LDB(dst, b, h) do { _Pragma("unroll") for (int n = 0; n < 2; ++n) _Pragma("unroll") for (int k = 0; k < 2; ++k) dst[n][k] = *(const PG8_LAS bf16x8*)(lds + PG8_SB(b, h) + boff + n * 2048 + k * 1024); } while (0)
#define PG8_MMA(ai, bj, At, Bt) do { __builtin_amdgcn_s_setprio(1); _Pragma("unroll") for (int m = 0; m < 4; ++m) _Pragma("unroll") for (int n = 0; n < 2; ++n) _Pragma("unroll") for (int k = 0; k < 2; ++k) \
        acc[ai][bj][m][n] = __builtin_amdgcn_mfma_f32_16x16x32_bf16(Bt[n][k], At[m][k], acc[ai][bj][m][n], 0, 0, 0); __builtin_amdgcn_s_setprio(0); } while (0)
#define PG8_WAIT_V(n) asm volatile("s_waitcnt vmcnt(" #n ")" ::: "memory")
#define PG8_WAIT_L(n) asm volatile("s_waitcnt lgkmcnt(" #n ")" ::: "memory")
#define PG8_BAR __builtin_amdgcn_s_barrier()
#define PG8_SCHED __builtin_amdgcn_sched_barrier(0)
    Unit cur, nxt; int ui = 0;
    if (!S.next(0, cur)) return;
#pragma unroll
    for (int h = 0; h < 2; ++h)
#pragma unroll
        for (int i = 0; i < 2; ++i) { ga[h][i] = (GATHER ? S.row_off(cur, h * HALF + RA[i]) : (unsigned)((h * HALF + RA[i]) * K) * 2u) + (unsigned)CA[i] * 2u; gn[h][i] = ga[h][i]; }
    f32x4 acc[2][2][4][2];
#pragma unroll
    for (int a = 0; a < 2; ++a)
#pragma unroll
        for (int b = 0; b < 2; ++b)
#pragma unroll
            for (int m = 0; m < 4; ++m)
#pragma unroll
                for (int n = 0; n < 2; ++n) acc[a][b][m][n] = (f32x4){0.f, 0.f, 0.f, 0.f};
    bf16x8 At[4][2], B0[2][2], B1[2][2];
    const char* cA = cur.a; const char* cB = cur.b;
    PG8_STAGE(PG8_SB(0, 0), cB, voffB); PG8_STAGE(PG8_SB(0, 1), cB + hstep, voffB); PG8_STAGE(PG8_SA(0, 0), cA, ga[0]); PG8_STAGE(PG8_SA(0, 1), cA, ga[1]);
    if (wr == 1) PG8_BAR;
    PG8_WAIT_V(2); PG8_BAR;
    PG8_STAGE(PG8_SB(1, 0), cB + kstep, voffB); PG8_STAGE(PG8_SA(1, 0), cA + kstep, ga[0]); PG8_STAGE(PG8_SB(1, 1), cB + hstep + kstep, voffB);
    PG8_WAIT_V(6); PG8_BAR;
    for (;;) {
        const bool has_next = S.next(ui + 1, nxt);
        const char* nA = has_next ? nxt.a : cA; const char* nB = has_next ? nxt.b : cB;
        if (GATHER && has_next) {
#pragma unroll
            for (int h = 0; h < 2; ++h)
#pragma unroll
                for (int i = 0; i < 2; ++i) gn[h][i] = S.row_off(nxt, h * HALF + RA[i]) + (unsigned)CA[i] * 2u;
        }
        for (int t = 0; t < nt; t += 2) {
            const bool last = (t == nt - 2);
            const char* a1 = cA + (size_t)(t + 1) * kstep;
            const char* a2 = last ? nA : cA + (size_t)(t + 2) * kstep; const char* b2 = last ? nB : cB + (size_t)(t + 2) * kstep;
            const char* a3 = a2 + kstep; const char* b3 = b2 + kstep;
            unsigned g2[2][2];
#pragma unroll
            for (int h = 0; h < 2; ++h)
#pragma unroll
                for (int i = 0; i < 2; ++i) g2[h][i] = (GATHER && last) ? gn[h][i] : ga[h][i];
            PG8_LDB(B0, 0, 0); PG8_LDB(B1, 0, 1); PG8_SCHED; PG8_LDA(At, 0, 0); PG8_STAGE(PG8_SA(1, 1), a1, ga[1]);
            PG8_WAIT_V(8); PG8_WAIT_L(0); PG8_BAR; PG8_MMA(0, 0, At, B0); PG8_MMA(0, 1, At, B1); PG8_BAR; PG8_SCHED;
            PG8_LDA(At, 0, 1); PG8_STAGE(PG8_SB(0, 0), b2, voffB); PG8_STAGE(PG8_SB(0, 1), b2 + hstep, voffB); PG8_STAGE(PG8_SA(0, 0), a2, g2[0]);
            PG8_WAIT_V(8); PG8_WAIT_L(0); PG8_BAR; PG8_MMA(1, 0, At, B0); PG8_MMA(1, 1, At, B1); PG8_BAR; PG8_SCHED;
            PG8_LDB(B0, 1, 0); PG8_LDB(B1, 1, 1); PG8_SCHED; PG8_LDA(At, 1, 0); PG8_STAGE(PG8_SA(0, 1), a2, g2[1]);
            PG8_WAIT_V(8); PG8_WAIT_L(0); PG8_BAR; PG8_MMA(0, 0, At, B0); PG8_MMA(0, 1, At, B1); PG8_BAR; PG8_SCHED;
            PG8_LDA(At, 1, 1); PG8_STAGE(PG8_SB(1, 0), b3, voffB); PG8_STAGE(PG8_SB(1, 1), b3 + hstep, voffB); PG8_STAGE(PG8_SA(1, 0), a3, g2[0]);
            PG8_WAIT_V(8); PG8_WAIT_L(0); PG8_BAR; PG8_MMA(1, 0, At, B0); PG8_MMA(1, 1, At, B1); PG8_BAR; PG8_SCHED;
        }
        if constexpr (ALIGN_EPI) { if (wr == 0) PG8_BAR; }
        E(acc, cur, wr, wc, fr, fq);
        if (!has_next) break;
#pragma unroll
        for (int a = 0; a < 2; ++a)
#pragma unroll
            for (int b = 0; b < 2; ++b)
#pragma unroll
                for (int m = 0; m < 4; ++m)
#pragma unroll
                    for (int n = 0; n < 2; ++n) acc[a][b][m][n] = (f32x4){0.f, 0.f, 0.f, 0.f};
        cur = nxt; cA = nA; cB = nB; ++ui;
#pragma unroll
        for (int h = 0; h < 2; ++h)
#pragma unroll
            for (int i = 0; i < 2; ++i) ga[h][i] = gn[h][i];
        if constexpr (ALIGN_EPI) { if (wr == 1) PG8_BAR; }
    }
    PG8_WAIT_V(0);
    if constexpr (!ALIGN_EPI) { if (wr == 0) PG8_BAR; }
    PG8_BAR;
#undef PG8_SA
#undef PG8_SB
#undef PG8_STAGE
#undef PG8_LDA
#undef PG8_LDB
#undef PG8_MMA
#undef PG8_WAIT_V
#undef PG8_WAIT_L
#undef PG8_BAR
#undef PG8_SCHED
}
}

constexpr int NWAVES = 8;
constexpr int RING_OFF = 0, RING_BYTES = 143360;
constexpr int LDSCTL_OFF = RING_BYTES;
constexpr int MISC_OFF = LDSCTL_OFF + 64;
constexpr int TAB_OFF = LDSCTL_OFF + 256;
constexpr int LDS_BYTES = RING_BYTES + 2048;

#define GAS __attribute__((address_space(1)))
typedef GAS unsigned gu32;
#define RLX_AGENT __ATOMIC_RELAXED, __HIP_MEMORY_SCOPE_AGENT
#define LDS_WAIT() asm volatile("s_waitcnt lgkmcnt(0)" ::: "memory")
#define VM_WAIT() asm volatile("s_waitcnt vmcnt(0)" ::: "memory")

#define XB_TMO      128
#define XB_XCNT(j)  (256  + 64 * (j))
#define XB_XSUB(j)  (1280 + 64 * (j))
#define XB_XGEN(j)  (2304 + 64 * (j))
#define XB_TOP      3328
#define XB_TOPGEN   3392
#define XCD_BAR_WORDS 3456
#define XB_SPIN_CAP (1u << 18)

__device__ __forceinline__ unsigned xb_ld(unsigned* p)              { return __hip_atomic_load(p, __ATOMIC_RELAXED, __HIP_MEMORY_SCOPE_AGENT); }
__device__ __forceinline__ unsigned xb_add(unsigned* p, unsigned v) { return __hip_atomic_fetch_add(p, v, __ATOMIC_RELAXED, __HIP_MEMORY_SCOPE_AGENT); }
__device__ __forceinline__ unsigned xb_xcc_id() { return (unsigned)__builtin_amdgcn_s_getreg((3 << 11) | 20) & 0xFu; }
#define XB_SPIN(cond, bar) do { unsigned _sp = 0; while (cond) { __builtin_amdgcn_s_sleep(1); \
    if ((++_sp & 255u) == 0u) { if (xb_ld(&(bar)[XB_TMO])) break; if (_sp > XB_SPIN_CAP) { atomicAdd(&(bar)[XB_TMO], 1u); break; } } } } while (0)

struct XcdBarrier { unsigned* bar; unsigned x; volatile LAS unsigned* st; };

__device__ __forceinline__ XcdBarrier xcd_barrier_post(unsigned* bar, volatile LAS unsigned* st) {
    XcdBarrier b; b.bar = bar; b.x = xb_xcc_id(); b.st = st;
    if (threadIdx.x == 0) (void)xb_add(&bar[XB_XCNT(b.x)], 1u);
    return b;
}
__device__ __forceinline__ void xcd_barrier_complete(unsigned* bar, unsigned x, unsigned& nloc, unsigned& nx) {
    const unsigned G = gridDim.x * gridDim.y * gridDim.z;
    unsigned sum, cnt, mine, sp = 0u;
    for (;;) {
        sum = 0u; cnt = 0u; mine = 0u;
#pragma unroll
        for (unsigned j = 0; j < 16; ++j) { const unsigned c = xb_ld(&bar[XB_XCNT(j)]); sum += c; cnt += (c > 0u) ? 1u : 0u; mine = (j == x) ? c : mine; }
        if (sum == G) break;
        __builtin_amdgcn_s_sleep(1);
        if ((++sp & 255u) == 0u) { if (xb_ld(&bar[XB_TMO])) break; if (sp > XB_SPIN_CAP) { atomicAdd(&bar[XB_TMO], 1u); break; } }
    }
    nloc = mine > 0u ? mine : 1u; nx = cnt > 0u ? cnt : 1u;
}
__device__ __forceinline__ void xcd_barrier(const XcdBarrier& b) {
    asm volatile("s_waitcnt vmcnt(0)" ::: "memory");
    __syncthreads();
    if (threadIdx.x == 0) {
        unsigned* bar = b.bar;
        __builtin_amdgcn_s_waitcnt(0);
        unsigned nloc = b.st[0], nx = b.st[1];
        if (nloc == 0u) { xcd_barrier_complete(bar, b.x, nloc, nx); b.st[0] = nloc; b.st[1] = nx; }
        const unsigned old = xb_add(&bar[XB_XSUB(b.x)], 1u);
        const unsigned gen = old / nloc;
        if (old + 1u == (gen + 1u) * nloc) {
            __builtin_amdgcn_fence(__ATOMIC_RELEASE, "agent");
            asm volatile("s_waitcnt vmcnt(0)" ::: "memory");
            const unsigned og = xb_add(&bar[XB_TOP], 1u);
            const unsigned tg = og / nx;
            if (og + 1u == (tg + 1u) * nx) xb_add(&bar[XB_TOPGEN], 1u);
            else XB_SPIN(xb_ld(&bar[XB_TOPGEN]) == tg, bar);
            __builtin_amdgcn_fence(__ATOMIC_ACQUIRE, "agent");
            xb_add(&bar[XB_XGEN(b.x)], 1u);
            asm volatile("s_waitcnt vmcnt(0)" ::: "memory");
        } else {
            XB_SPIN(xb_ld(&bar[XB_XGEN(b.x)]) == gen, bar);
            __builtin_amdgcn_fence(__ATOMIC_ACQUIRE, "agent");
            asm volatile("s_waitcnt vmcnt(0)" ::: "memory");
        }
    }
    __syncthreads();
}

struct Frame {
    LAS unsigned char* lds;
    unsigned* ctl;
    int tid, lane, wave, vcu, G;
    Ptrs p;
};

__device__ __forceinline__ void p0_prologue(Frame& F) {
    const Ptrs& p = F.p; const int tid = F.tid, lane = F.lane, wave = F.wave;
    LAS float* scr = (LAS float*)(F.lds + RING_OFF) + wave * 64 * 33;
    LAS float* gw = (LAS float*)(F.lds + RING_OFF + 8 * 64 * 33 * 4);
    const int gw_id = F.vcu * NWAVES + wave, NGW = F.G * NWAVES;
    bf16_t* WIN = (bf16_t*)(p.ws + WS_WIN); bf16_t* WOUT = (bf16_t*)(p.ws + WS_WOUT); bf16_t* W13 = (bf16_t*)(p.ws + WS_W13); bf16_t* W2 = (bf16_t*)(p.ws + WS_W2);
    for (int i = tid; i < 1024 * 8; i += NWAVES * 64) gw[i] = p.w_in[(size_t)(i >> 3) * DIN + C_IG + (i & 7)];
    __syncthreads();
    constexpr int I_IN = 16 * 112, I_OUT = 16 * 32, I_13 = 16 * 16 * 32, I_2 = 8 * 32 * 32;
    constexpr int NITEMS = I_IN + I_OUT + 2 * I_13 + I_2;
    for (int it = gw_id; it < NITEMS; it += NGW) {
        int r = it;
        if (r < I_IN) { const int kb = r / 112, nb = r % 112; transpose_item(p.w_in, DIN, WIN, 1024, 64 * kb, 32 * nb, MapRope(), nullptr, scr, lane); continue; } r -= I_IN;
        if (r < I_OUT) { const int kb = r / 32, nb = r % 32; transpose_item(p.w_out, 1024, WOUT, 1024, 64 * kb, 32 * nb, MapId(), nullptr, scr, lane); continue; } r -= I_OUT;
        if (r < I_13) { const int e = r / 256, q = r % 256, kb = q / 16, nb = q % 16; transpose_item(p.w1 + (size_t)e * 1024 * 512, 512, W13 + (size_t)e * 1024 * 1024, 1024, 64 * kb, 32 * nb, MapW1(), p.g_ffn, scr, lane); continue; } r -= I_13;
        if (r < I_13) { const int e = r / 256, q = r % 256, kb = q / 16, nb = q % 16; transpose_item(p.w3 + (size_t)e * 1024 * 512, 512, W13 + (size_t)e * 1024 * 1024, 1024, 64 * kb, 32 * nb, MapW3(), p.g_ffn, scr, lane); continue; } r -= I_13;
        { const int e = r / 256, q = r % 256, kb = q / 32, nb = q % 32; transpose_item(p.w2 + (size_t)e * 512 * 1024, 1024, W2 + (size_t)e * 1024 * 512, 512, 64 * kb, 32 * nb, MapId(), nullptr, scr, lane); }
    }
    { float* cs = (float*)(p.ws + WS_ROPE); float* sn = cs + 2048 * 32;
      for (int i = blockIdx.x * 512 + tid; i < 2048 * 32; i += F.G * 512) { const int pos = i >> 5, j = i & 31;
          const float inv = 1.0f / exp2f((float)(2 * j) * (1.f / 64.f) * 13.287712379549449f);
          const float ang = (float)pos * inv; const double rev = (double)ang * 0.15915494309189535; const float fr = (float)(rev - rint(rev));
          cs[i] = __builtin_amdgcn_cosf(fr); sn[i] = __builtin_amdgcn_sinf(fr); } }
    { bf16_t* WR = (bf16_t*)(p.ws + WS_WR);
      for (int i = blockIdx.x * 512 + tid; i < 48 * 1024; i += F.G * 512) { const int c = i >> 10, k = i & 1023; float v = 0.f;
          if (c < 4) v = p.w_grp[k * 4 + c]; else if (c < 36) v = p.w_er[((size_t)((c - 4) >> 3) * 1024 + k) * 8 + ((c - 4) & 7)];
          WR[i] = (bf16_t)f2bf(v * p.g_ffn[k]); } }
    bf16_t* HB = (bf16_t*)(p.ws + WS_HB); float* GATES = (float*)(p.ws + WS_GATES);
    for (int m = gw_id; m < T; m += NGW) {
        const f32x4* xr = (const f32x4*)(p.x + (size_t)m * D) + lane; const f32x4* gr = (const f32x4*)p.g_mix + lane;
        f32x4 v[4]; float s = 0.f;
#pragma unroll
        for (int j = 0; j < 4; ++j) { v[j] = xr[64 * j]; s += (v[j].x * v[j].x + v[j].y * v[j].y) + (v[j].z * v[j].z + v[j].w * v[j].w); }
        const float rstd = 1.f / sqrtf(wave_sum(s) * (1.f / D) + RMS_EPS);
        float ga[8];
#pragma unroll
        for (int e = 0; e < 8; ++e) ga[e] = 0.f;
        unsigned long long* o8 = (unsigned long long*)(HB + (size_t)m * D) + lane;
#pragma unroll
        for (int j = 0; j < 4; ++j) { const f32x4 g = gr[64 * j]; f32x4 h = v[j] * rstd * g;
            o8[64 * j] = (unsigned long long)pk2(h.x, h.y) | ((unsigned long long)pk2(h.z, h.w) << 32);
            const int k0 = 256 * j + 4 * lane;
#pragma unroll
            for (int q = 0; q < 4; ++q) { const float hv = h[q]; const LAS float* w = gw + (k0 + q) * 8;
#pragma unroll
                for (int e = 0; e < 8; ++e) ga[e] += hv * w[e]; } }
#pragma unroll
        for (int e = 0; e < 8; ++e) ga[e] = wave_sum(ga[e]);
        if (lane < 8) { float gv = 0.f;
#pragma unroll
            for (int e = 0; e < 8; ++e) gv = (lane == e) ? ga[e] : gv;
            gv += p.gate_b[lane];
            if (lane >= 4) gv = fminf(gv, 0.f) - log1pf(__expf(-fabsf(gv)));
            GATES[(size_t)m * 8 + lane] = gv; }
    }
}

__device__ __forceinline__ void final_body(Frame& F) {
    const Ptrs& p = F.p; const int lane = F.lane; float* X1 = p.out; const bf16_t* Y = (const bf16_t*)(p.ws + WS_Y);
    for (size_t tok = F.vcu * NWAVES + F.wave; tok < T; tok += F.G * NWAVES) {
        f32x4 v[4]; float s = 0.f;
#pragma unroll
        for (int j = 0; j < 4; ++j) { v[j] = ((const f32x4*)(X1 + tok * D))[lane + 64 * j];
            const u32x2 a = ((const u32x2*)(Y + (2 * tok) * D))[lane + 64 * j], b = ((const u32x2*)(Y + (2 * tok + 1) * D))[lane + 64 * j];
            v[j].x += bf2f(a.x & 0xffffu) + bf2f(b.x & 0xffffu); v[j].y += bf2f(a.x >> 16) + bf2f(b.x >> 16); v[j].z += bf2f(a.y & 0xffffu) + bf2f(b.y & 0xffffu); v[j].w += bf2f(a.y >> 16) + bf2f(b.y >> 16);
            s += (v[j].x * v[j].x + v[j].y * v[j].y) + (v[j].z * v[j].z + v[j].w * v[j].w); }
        const float rstd = 1.f / sqrtf(wave_sum(s) * (1.f / D) + RMS_EPS);
#pragma unroll
        for (int j = 0; j < 4; ++j) { const f32x4 g = ((const f32x4*)p.g_final)[lane + 64 * j]; ((f32x4*)(X1 + tok * D))[lane + 64 * j] = v[j] * rstd * g; }
    }
}
__device__ __forceinline__ void moe_tables(Frame& F) {
    LAS int* tab = (LAS int*)(F.lds + TAB_OFF);
    if (F.tid == 0) { int us = 0, ps = 0;
        for (int e = 0; e < NE; ++e) { const int c = (int)__hip_atomic_load(F.ctl + CW_CNT + 64 * e, RLX_AGENT); const int nb = (c + 255) >> 8;
            tab[e] = us; tab[64 + e] = ps; tab[128 + e] = c; us += nb * 4; ps += nb * 256; }
        tab[32] = us; tab[96] = ps; }
    __syncthreads();
}


namespace att {
typedef float f32x16 __attribute__((ext_vector_type(16)));
typedef short s16x4 __attribute__((ext_vector_type(4)));
constexpr int STAGE = 32768, VOFF = 16384, XCH_OFF = 65536;
constexpr int ROWB = NPROJ * 2;
__device__ __forceinline__ int crow(int r, int hi) { return (r & 3) + 8 * (r >> 2) + 4 * hi; }
__device__ __forceinline__ unsigned swz(unsigned row) { return ((row & 3u) << 2) | ((row >> 2) & 3u); }
__device__ __forceinline__ s16x4 trrd(const LAS unsigned char* p) { return __builtin_bit_cast(s16x4, __builtin_amdgcn_ds_read_tr16_b64_v4i16((LAS s16x4*)p)); }

__device__ __forceinline__ void attn_unit(Frame& F, int bh, int qb, float lam) {
    LAS unsigned char* lds = F.lds + RING_OFF;
    const int lane = F.lane, wid = F.wave, c = wid >> 2, wq = wid & 3, r32 = lane & 31, hi = lane >> 5;
    const int b = bh >> 2, h = bh & 3, q0 = qb * 128, qlo = q0 + 32 * wq;
    const char* projb = (const char*)(F.p.ws + WS_PROJ) + (size_t)(b * SEQ) * ROWB;
    const char* kg = projb + (C_KA + h * 128) * 2; const char* vg = projb + (C_VA + h * 128) * 2;
    unsigned srcoff[2];
#pragma unroll
    for (int n = 0; n < 2; ++n) { const unsigned row = 4u * (wid + 8 * n) + (lane >> 4), slot = lane & 15; srcoff[n] = row * ROWB + ((slot ^ swz(row)) << 4); }
#define ATT_DMA(t, st) do { _Pragma("unroll") for (int _n = 0; _n < 2; ++_n) { \
        __builtin_amdgcn_global_load_lds((const unsigned*)(kg + (size_t)(t) * 64 * ROWB + srcoff[_n]), (LAS unsigned*)(lds + (st) * STAGE + (wid + 8 * _n) * 1024), 16, 0, 0); \
        __builtin_amdgcn_global_load_lds((const unsigned*)(vg + (size_t)(t) * 64 * ROWB + srcoff[_n]), (LAS unsigned*)(lds + (st) * STAGE + VOFF + (wid + 8 * _n) * 1024), 16, 0, 0); } } while (0)
    bf16x8 qf[4];
    { const bf16_t* qp = (const bf16_t*)(projb + (size_t)(qlo + r32) * ROWB) + C_QA + h * 128 + c * 64 + 8 * hi;
#pragma unroll
      for (int s = 0; s < 4; ++s) qf[s] = *(const bf16x8*)(qp + 16 * s); }
    unsigned kaddr[4], vaddr[2][4];
#pragma unroll
    for (int s = 0; s < 4; ++s) kaddr[s] = 256u * r32 + 16u * ((unsigned)(8 * c + 2 * s + hi) ^ swz(r32));
    { const unsigned blk = (lane >> 4) & 1, q = (lane & 15) >> 2, p = lane & 3;
#pragma unroll
      for (int t2 = 0; t2 < 2; ++t2)
#pragma unroll
          for (int dt = 0; dt < 4; ++dt) { const unsigned row = 8u * t2 + 4u * hi + q; vaddr[t2][dt] = 256u * row + 16u * ((4u * dt + 2u * blk + (p >> 1)) ^ swz(row)) + 8u * (p & 1); } }
    f32x16 o[4];
#pragma unroll
    for (int dt = 0; dt < 4; ++dt)
#pragma unroll
        for (int r = 0; r < 16; ++r) o[dt][r] = 0.f;
    float m = -INFINITY, l = 0.f;
    const int NT = 2 * qb + 2;
    ATT_DMA(0, 0);
    for (int t = 0; t < NT; ++t) {
        asm volatile("s_waitcnt vmcnt(0)" ::: "memory"); __builtin_amdgcn_s_barrier(); asm volatile("" ::: "memory");
        if (t + 1 < NT) ATT_DMA(t + 1, (t + 1) & 1);
        if (64 * t <= qlo + 31) {
            const LAS unsigned char* kb = lds + (t & 1) * STAGE; const LAS unsigned char* vb = kb + VOFF;
            f32x16 p0, p1;
#pragma unroll
            for (int r = 0; r < 16; ++r) { p0[r] = 0.f; p1[r] = 0.f; }
#pragma unroll
            for (int s = 0; s < 4; ++s) { const bf16x8 k0 = *(const LAS bf16x8*)(kb + kaddr[s]), k1 = *(const LAS bf16x8*)(kb + 8192 + kaddr[s]);
                p0 = __builtin_amdgcn_mfma_f32_32x32x16_bf16(k0, qf[s], p0, 0, 0, 0); p1 = __builtin_amdgcn_mfma_f32_32x32x16_bf16(k1, qf[s], p1, 0, 0, 0); }
            if (64 * t + 63 > qlo) { const int qg = qlo + r32;
#pragma unroll
                for (int r = 0; r < 16; ++r) { const int key = 64 * t + crow(r, hi); if (key > qg) p0[r] = -INFINITY; if (key + 32 > qg) p1[r] = -INFINITY; } }
            float rm = fmaxf(p0[0], p1[0]);
#pragma unroll
            for (int r = 1; r < 16; ++r) rm = fmaxf(rm, fmaxf(p0[r], p1[r]));
            rm = fmaxf(rm, __shfl_xor(rm, 32));
            const float mn = fmaxf(m, rm), alpha = __builtin_amdgcn_exp2f(m - mn); m = mn;
            float rs = 0.f;
#pragma unroll
            for (int r = 0; r < 16; ++r) { p0[r] = __builtin_amdgcn_exp2f(p0[r] - mn); p1[r] = __builtin_amdgcn_exp2f(p1[r] - mn); rs += p0[r] + p1[r]; }
            l = l * alpha + rs;
#pragma unroll
            for (int dt = 0; dt < 4; ++dt)
#pragma unroll
                for (int r = 0; r < 16; ++r) o[dt][r] *= alpha;
            bf16x8 pf[4];
#pragma unroll
            for (int ks = 0; ks < 4; ++ks) { u32x4 w;
#pragma unroll
                for (int j = 0; j < 4; ++j) { const int r = 8 * (ks & 1) + 2 * j; w[j] = (ks < 2) ? pg8::cvt_pk_bf16(p0[r], p0[r + 1]) : pg8::cvt_pk_bf16(p1[r], p1[r + 1]); }
                pf[ks] = __builtin_bit_cast(bf16x8, w); }
#pragma unroll
            for (int dt = 0; dt < 4; ++dt)
#pragma unroll
                for (int ks = 0; ks < 4; ++ks) { const s16x4 lo = trrd(vb + vaddr[0][dt] + 4096 * ks), hh = trrd(vb + vaddr[1][dt] + 4096 * ks);
                    const bf16x8 vf = (bf16x8){lo[0], lo[1], lo[2], lo[3], hh[0], hh[1], hh[2], hh[3]};
                    o[dt] = __builtin_amdgcn_mfma_f32_32x32x16_bf16(vf, pf[ks], o[dt], 0, 0, 0); }
        }
    }
    asm volatile("s_waitcnt lgkmcnt(0)" ::: "memory"); __builtin_amdgcn_s_barrier(); asm volatile("" ::: "memory");
    l += __shfl_xor(l, 32);
    const float inv = 1.f / l;
    LAS float* xch = (LAS float*)(lds + XCH_OFF + wq * 16384);
    if (c == 1) {
#pragma unroll
        for (int dt = 0; dt < 4; ++dt)
#pragma unroll
            for (int r = 0; r < 16; ++r) xch[(dt * 16 + r) * 64 + lane] = o[dt][r] * inv;
    }
    asm volatile("s_waitcnt lgkmcnt(0)" ::: "memory"); __builtin_amdgcn_s_barrier(); asm volatile("" ::: "memory");
    if (c == 0) {
        float ss = 0.f;
#pragma unroll
        for (int dt = 0; dt < 4; ++dt)
#pragma unroll
            for (int r = 0; r < 16; ++r) { const float v = o[dt][r] * inv - lam * xch[(dt * 16 + r) * 64 + lane]; o[dt][r] = v; ss += v * v; }
        ss += __shfl_xor(ss, 32);
        const float rsn = (1.f - LAMBDA_INIT) / sqrtf(ss * (1.f / 128.f) + RMS_EPS);
        bf16_t* orow = (bf16_t*)(F.p.ws + WS_MIX) + (size_t)(b * SEQ + qlo + r32) * D + h * 128;
#pragma unroll
        for (int dt = 0; dt < 4; ++dt)
#pragma unroll
            for (int r4 = 0; r4 < 4; ++r4) { const int dv = 32 * dt + 8 * r4 + 4 * hi; const f32x4 g = *(const f32x4*)(F.p.subln_g + dv);
                u32x2 w; w.x = pg8::cvt_pk_bf16(o[dt][4 * r4] * rsn * g[0], o[dt][4 * r4 + 1] * rsn * g[1]); w.y = pg8::cvt_pk_bf16(o[dt][4 * r4 + 2] * rsn * g[2], o[dt][4 * r4 + 3] * rsn * g[3]);
                *(u32x2*)(orow + dv) = w; }
    }
#undef ATT_DMA
}

__device__ __forceinline__ void attn_phase(Frame& F, int qword) {
    const float* lq = F.p.lam_qk; const int lane = F.lane;
    const float lam = __expf(wave_sum(lq[lane] * lq[64 + lane])) - __expf(wave_sum(lq[128 + lane] * lq[192 + lane])) + LAMBDA_INIT;
    volatile LAS unsigned* qw = (volatile LAS unsigned*)(F.lds + LDSCTL_OFF + 32);
    for (;;) {
        if (F.tid == 0) *qw = __hip_atomic_fetch_add(F.ctl + qword, 1u, __ATOMIC_RELAXED, __HIP_MEMORY_SCOPE_AGENT);
        __syncthreads();
        const unsigned u = (unsigned)__builtin_amdgcn_readfirstlane((int)*qw);
        if (u >= 1024u) break;
        attn_unit(F, (int)(u & 63u), 15 - (int)(u >> 6), lam);
    }
}
}

namespace ml {
typedef short s16x4 __attribute__((ext_vector_type(4)));
constexpr int KI = 0, VI = 32768, CB = 65536, QI = 102400, PC = 135168, CWL = 137728, ML_END = 142848;
constexpr int ROWB = NPROJ * 2;
__device__ __forceinline__ unsigned swz(unsigned row) { return ((row & 3u) << 2) | ((row >> 2) & 3u); }
__device__ __forceinline__ unsigned off_b(unsigned row, unsigned ch) { return 256u * row + 16u * (ch ^ swz(row)); }
__device__ __forceinline__ s16x4 trrd(const LAS unsigned char* p) { return __builtin_bit_cast(s16x4, __builtin_amdgcn_ds_read_tr16_b64_v4i16((LAS s16x4*)p)); }
__device__ __forceinline__ f32x4 mfma16(bf16x8 a, bf16x8 b, f32x4 c) { return __builtin_amdgcn_mfma_f32_16x16x32_bf16(a, b, c, 0, 0, 0); }

__device__ __forceinline__ void conv4x8(const bf16_t* src, int t, const LAS float* cw, const LAS float* cb, int lc, float scale, LAS unsigned char* img, int row0, int pc) {
    u32x4 raw[7];
#pragma unroll
    for (int jj = 0; jj < 7; ++jj) raw[jj] = *(const u32x4*)(src + (ptrdiff_t)((t - 3 + jj >= 0) ? (jj - 3) : 0) * NPROJ);
    f32x4 wt[4][2];
#pragma unroll
    for (int j = 0; j < 4; ++j) { wt[j][0] = *(const LAS f32x4*)(cw + j * 256 + lc); wt[j][1] = *(const LAS f32x4*)(cw + j * 256 + lc + 4); }
    const f32x4 b0 = *(const LAS f32x4*)(cb + lc), b1 = *(const LAS f32x4*)(cb + lc + 4);
    float x[7][8];
#pragma unroll
    for (int jj = 0; jj < 7; ++jj) { const float ok = (t - 3 + jj >= 0) ? 1.f : 0.f;
        x[jj][0] = ok * bf2f(raw[jj].x & 0xffffu); x[jj][1] = ok * bf2f(raw[jj].x >> 16); x[jj][2] = ok * bf2f(raw[jj].y & 0xffffu); x[jj][3] = ok * bf2f(raw[jj].y >> 16);
        x[jj][4] = ok * bf2f(raw[jj].z & 0xffffu); x[jj][5] = ok * bf2f(raw[jj].z >> 16); x[jj][6] = ok * bf2f(raw[jj].w & 0xffffu); x[jj][7] = ok * bf2f(raw[jj].w >> 16); }
#pragma unroll
    for (int rr = 0; rr < 4; ++rr) { float y[8];
#pragma unroll
        for (int e = 0; e < 8; ++e) { float a = (e < 4) ? b0[e & 3] : b1[e & 3];
#pragma unroll
            for (int j = 0; j < 4; ++j) a += ((e < 4) ? wt[j][0][e & 3] : wt[j][1][e & 3]) * x[rr + j][e];
            y[e] = a * scale / (1.f + __expf(-a)); }
        u32x4 w; w.x = pg8::cvt_pk_bf16(y[0], y[1]); w.y = pg8::cvt_pk_bf16(y[2], y[3]); w.z = pg8::cvt_pk_bf16(y[4], y[5]); w.w = pg8::cvt_pk_bf16(y[6], y[7]);
        *(LAS u32x4*)(img + off_b(row0 + rr, pc)) = w; }
}
__device__ __forceinline__ bf16x8 pack8(const float (&v)[8]) { u32x4 w; w.x = pg8::cvt_pk_bf16(v[0], v[1]); w.y = pg8::cvt_pk_bf16(v[2], v[3]); w.z = pg8::cvt_pk_bf16(v[4], v[5]); w.w = pg8::cvt_pk_bf16(v[6], v[7]); return __builtin_bit_cast(bf16x8, w); }

__device__ __forceinline__ void mlstm_unit(Frame& F, int bh) {
    LAS unsigned char* lds = F.lds + RING_OFF;
    const int tid = F.tid, lane = F.lane, w = F.wave; int l15 = lane & 15, g = lane >> 4, q = l15 >> 2, p = lane & 3;
    const int b = bh >> 2, h = bh & 3; const size_t rowb = (size_t)b * SEQ;
    const bf16_t* PROJ = (const bf16_t*)(F.p.ws + WS_PROJ); const float* GATES = (const float*)(F.p.ws + WS_GATES); bf16_t* MIX = (bf16_t*)(F.p.ws + WS_MIX);
    float* gsc = (float*)(F.p.ws + WS_GSC) + (size_t)bh * 3 * SEQ;
    LAS float* pc_u = (LAS float*)(lds + PC); LAS float* pc_sci = pc_u + 128; LAS float* pc_ws = pc_u + 256; LAS float* pc_emr = pc_u + 384; LAS float* pc_a = pc_u + 512;
    LAS float* cw = (LAS float*)(lds + CWL); LAS float* cb = cw + 1024;
    for (int i = tid; i < 36864 / 16; i += 512) *(LAS u32x4*)(lds + CB + 16 * i) = (u32x4){0u, 0u, 0u, 0u};
    for (int i = tid; i < 1024; i += 512) { const int j = i >> 8, lc = i & 255; const int cc = (lc < 128) ? h * 128 + lc : 512 + h * 128 + (lc - 128); cw[i] = F.p.conv_w[j * 1024 + cc]; if (j == 0) cb[lc] = F.p.conv_b[cc]; }
#pragma unroll
    for (int cc2 = 0; cc2 < 2; ++cc2) { const int i0 = (2 * w + cc2) * 128 + 2 * lane;
        const float li0 = GATES[(rowb + i0) * 8 + h], lf0 = GATES[(rowb + i0) * 8 + 4 + h], li1 = GATES[(rowb + i0 + 1) * 8 + h], lf1 = GATES[(rowb + i0 + 1) * 8 + 4 + h];
        float s = lf0 + lf1;
#pragma unroll
        for (int o = 1; o < 64; o <<= 1) { const float y = __shfl_up(s, o); if (lane >= o) s += y; }
        const float b1v = s, b0v = s - lf1, a0 = li0 - b0v, a1 = li1 - b1v;
        float mx = fmaxf(a0, a1);
#pragma unroll
        for (int o = 1; o < 64; o <<= 1) { const float y = __shfl_up(mx, o); if (lane >= o) mx = fmaxf(mx, y); }
        float mprev = __shfl_up(mx, 1); if (lane == 0) mprev = -INFINITY;
        gsc[i0] = b0v; gsc[i0 + 1] = b1v; gsc[SEQ + i0] = a0; gsc[SEQ + i0 + 1] = a1; gsc[2 * SEQ + i0] = fmaxf(mprev, a0); gsc[2 * SEQ + i0 + 1] = mx; }
    __threadfence_block();
    asm volatile("s_waitcnt vmcnt(0)" ::: "memory");
    __syncthreads();
    f32x4 accC[9];
#pragma unroll
    for (int vt = 0; vt < 9; ++vt) accC[vt] = (f32x4){0.f, 0.f, 0.f, 0.f};
    float mcur = 0.f;
    const bf16x8 onesf = (l15 == 0) ? (bf16x8){0x3F80, 0x3F80, 0x3F80, 0x3F80, 0x3F80, 0x3F80, 0x3F80, 0x3F80} : (bf16x8){0, 0, 0, 0, 0, 0, 0, 0};
    unsigned vsrc[4];
#pragma unroll
    for (int n = 0; n < 4; ++n) { const unsigned row = 4u * (w + 8 * n) + (lane >> 4), slot = lane & 15; vsrc[n] = row * ROWB + ((slot ^ swz(row)) << 4); }
    const int tq = tid & 127;
    float gb = gsc[tq], gaa = gsc[SEQ + tq], gg = gsc[2 * SEQ + tq], gbl = gsc[127], gge = gsc[2 * SEQ + 127];

#define ML_LAUNDER() asm volatile("" : "+v"(l15), "+v"(g), "+v"(q), "+v"(p))
    for (int ci = 0; ci < 16; ++ci) {
        const int t0 = ci * 128;
        ML_LAUNDER();
        const float bL = gbl, gend = gge;
        const float mnew = bL + fmaxf(mcur, gend), sc = __expf(bL + mcur - mnew);
        if (tid < 128) { const float bt = gb, mrow = bt + fmaxf(mcur, gg);
            pc_u[tid] = bt - mrow; pc_sci[tid] = __expf(bt + mcur - mrow); pc_ws[tid] = __expf(bL - mnew + gaa); pc_emr[tid] = __expf(-mrow); pc_a[tid] = gaa; }
        { const char* vg = (const char*)(PROJ + (rowb + t0) * NPROJ + C_VM + h * 128);
#pragma unroll
          for (int n = 0; n < 4; ++n) __builtin_amdgcn_global_load_lds((const unsigned*)(vg + vsrc[n]), (LAS unsigned*)(lds + VI + (w + 8 * n) * 1024), 16, 0, 0); }
        u32x2 omr[8];
        { const bf16_t* omp = PROJ + (rowb + t0 + 16 * w + l15) * NPROJ + C_OM + h * 128 + 4 * g;
#pragma unroll
          for (int vt = 0; vt < 8; ++vt) omr[vt] = *(const u32x2*)(omp + 16 * vt); }
        if (ci < 15) { const int n0 = t0 + 128; gb = gsc[n0 + tq]; gaa = gsc[SEQ + n0 + tq]; gg = gsc[2 * SEQ + n0 + tq]; gbl = gsc[n0 + 127]; gge = gsc[2 * SEQ + n0 + 127]; }
        { const int rg = tid >> 4, pcc = tid & 15; const int t = t0 + 4 * rg;
          conv4x8(PROJ + (rowb + t) * NPROJ + C_KM + h * 128 + 8 * pcc, t, cw, cb, 128 + 8 * pcc, 0.08838834764831845f, lds + KI, 4 * rg, pcc);
          asm volatile("" ::: "memory");
          conv4x8(PROJ + (rowb + t) * NPROJ + C_QM + h * 128 + 8 * pcc, t, cw, cb, 8 * pcc, 1.f, lds + QI, 4 * rg, pcc); }
        asm volatile("s_waitcnt vmcnt(0) lgkmcnt(0)" ::: "memory"); __builtin_amdgcn_s_barrier(); asm volatile("" ::: "memory");
        ML_LAUNDER();
        bf16x8 qf[4];
#pragma unroll
        for (int ks = 0; ks < 4; ++ks) qf[ks] = *(const LAS bf16x8*)(lds + QI + off_b(16 * w + l15, 4 * ks + g));
        const float ut = pc_u[16 * w + l15];
        bf16x8 smf[4];
#pragma unroll
        for (int i = 0; i < 4; ++i) {
            float sv[8];
#pragma unroll
            for (int hh = 0; hh < 2; ++hh) { const int st = 2 * i + hh;
                f32x4 acc = (f32x4){0.f, 0.f, 0.f, 0.f};
#pragma unroll
                for (int ks = 0; ks < 4; ++ks) acc = mfma16(*(const LAS bf16x8*)(lds + KI + off_b(16 * st + l15, 4 * ks + g)), qf[ks], acc);
                const f32x4 a4 = *(const LAS f32x4*)(pc_a + 16 * st + 4 * g);
#pragma unroll
                for (int r = 0; r < 4; ++r) { float v = __expf(ut + a4[r]) * acc[r]; if ((16 * st + 4 * g + r) > (16 * w + l15)) v = 0.f; sv[4 * hh + r] = v; } }
            smf[i] = pack8(sv); }
        ML_LAUNDER();
        const float scit = pc_sci[16 * w + l15];
        f32x4 num[9];
#pragma unroll
        for (int vt = 0; vt < 9; ++vt) { f32x4 acc = (f32x4){0.f, 0.f, 0.f, 0.f};
#pragma unroll
            for (int ks = 0; ks < 4; ++ks) acc = mfma16(*(const LAS bf16x8*)(lds + CB + off_b(16 * vt + l15, 4 * ks + g)), qf[ks], acc);
            acc = acc * scit;
#pragma unroll
            for (int i = 0; i < 4; ++i) { bf16x8 vf;
                if (vt < 8) { const s16x4 lo = trrd(lds + VI + off_b(32 * i + 4 * g + q, 2 * vt + (p >> 1)) + 8 * (p & 1)), hi = trrd(lds + VI + off_b(32 * i + 16 + 4 * g + q, 2 * vt + (p >> 1)) + 8 * (p & 1));
                    vf = (bf16x8){lo[0], lo[1], lo[2], lo[3], hi[0], hi[1], hi[2], hi[3]}; }
                else vf = onesf;
                acc = mfma16(vf, smf[i], acc); }
            num[vt] = acc; }
        { const int t = t0 + 16 * w + l15;
          const float den = __shfl(num[8][0], l15); const float hd = 1.f / fmaxf(fabsf(den), pc_emr[16 * w + l15]);
          float ss = 0.f;
#pragma unroll
          for (int vt = 0; vt < 8; ++vt) { const u32x2 ow = omr[vt];
              const float o0 = bf2f(ow.x & 0xffffu), o1 = bf2f(ow.x >> 16), o2 = bf2f(ow.y & 0xffffu), o3 = bf2f(ow.y >> 16);
              f32x4 hv = num[vt] * hd; hv[0] *= sigmoidf_(o0); hv[1] *= sigmoidf_(o1); hv[2] *= sigmoidf_(o2); hv[3] *= sigmoidf_(o3);
              num[vt] = hv; ss += (hv[0] * hv[0] + hv[1] * hv[1]) + (hv[2] * hv[2] + hv[3] * hv[3]); }
          ss += __shfl_xor(ss, 16); ss += __shfl_xor(ss, 32);
          const float rs = 1.f / sqrtf(ss * (1.f / 128.f) + RMS_EPS);
          bf16_t* op = MIX + (rowb + t) * D + 512 + h * 128 + 4 * g; const float* gp = F.p.mhnorm_g + h * 128 + 4 * g;
#pragma unroll
          for (int vt = 0; vt < 8; ++vt) { const f32x4 gg4 = *(const f32x4*)(gp + 16 * vt); const f32x4 hv = num[vt] * rs * gg4;
              u32x2 ww; ww.x = pg8::cvt_pk_bf16(hv[0], hv[1]); ww.y = pg8::cvt_pk_bf16(hv[2], hv[3]); *(u32x2*)(op + 16 * vt) = ww; } }
        asm volatile("s_waitcnt lgkmcnt(0)" ::: "memory"); __builtin_amdgcn_s_barrier(); asm volatile("" ::: "memory");
        ML_LAUNDER();
        { bf16x8 kf[4];
#pragma unroll
          for (int i = 0; i < 4; ++i) { float kv[8];
#pragma unroll
              for (int t2 = 0; t2 < 2; ++t2) { const s16x4 raw = trrd(lds + KI + off_b(32 * i + 8 * g + 4 * t2 + q, 2 * w + (p >> 1)) + 8 * (p & 1)); const f32x4 w4 = *(const LAS f32x4*)(pc_ws + 32 * i + 8 * g + 4 * t2);
#pragma unroll
                  for (int e = 0; e < 4; ++e) kv[4 * t2 + e] = bf2f((unsigned)(unsigned short)raw[e]) * w4[e]; }
              kf[i] = pack8(kv); }
#pragma unroll
          for (int vt = 0; vt < 9; ++vt) { f32x4 acc = accC[vt] * sc;
#pragma unroll
              for (int i = 0; i < 4; ++i) { bf16x8 vf;
                  if (vt < 8) { const s16x4 lo = trrd(lds + VI + off_b(32 * i + 8 * g + q, 2 * vt + (p >> 1)) + 8 * (p & 1)), hi = trrd(lds + VI + off_b(32 * i + 8 * g + 4 + q, 2 * vt + (p >> 1)) + 8 * (p & 1));
                      vf = (bf16x8){lo[0], lo[1], lo[2], lo[3], hi[0], hi[1], hi[2], hi[3]}; }
                  else vf = onesf;
                  acc = mfma16(kf[i], vf, acc); }
              accC[vt] = acc;
              u32x2 ww; ww.x = pg8::cvt_pk_bf16(acc[0], acc[1]); ww.y = pg8::cvt_pk_bf16(acc[2], acc[3]);
              *(LAS u32x2*)(lds + CB + off_b(16 * vt + l15, 2 * w + (g >> 1)) + 8 * (g & 1)) = ww; } }
        mcur = mnew;
        asm volatile("s_waitcnt lgkmcnt(0)" ::: "memory"); __builtin_amdgcn_s_barrier(); asm volatile("" ::: "memory");
    }
}
}

namespace rt {
constexpr int WROW = 2064;
constexpr int LOGI_OFF = 100352, HIST_OFF = 124928;
__device__ __forceinline__ void router_phase(Frame& F) {
    const Ptrs& p = F.p; LAS unsigned char* lds = F.lds + RING_OFF;
    const int tid = F.tid, lane = F.lane, w = F.wave, l15 = lane & 15, g = lane >> 4;
    const bf16_t* WR = (const bf16_t*)(p.ws + WS_WR); const bf16_t* X1B = (const bf16_t*)(p.ws + WS_X1B);
    int* list = (int*)(p.ws + WS_LIST); float* tokw = (float*)(p.ws + WS_TOKW); float* rstd_o = (float*)(p.ws + WS_RSTD);
    LAS int* hist = (LAS int*)(lds + HIST_OFF); LAS int* base = hist + 32;
    LAS float* lg = (LAS float*)(lds + LOGI_OFF + w * 3072);
    for (int i = tid; i < 48 * 128; i += 512) { const int row = i >> 7, ch = i & 127; *(LAS u32x4*)(lds + row * WROW + ch * 16) = *(const u32x4*)(WR + row * 1024 + ch * 8); }
    for (int blk = F.vcu; blk < T / 128; blk += F.G) {
        if (tid < 32) hist[tid] = 0;
        __syncthreads();
        const int row0 = blk * 128 + 16 * w;
        f32x4 acc[3]; float ss = 0.f;
#pragma unroll
        for (int ct = 0; ct < 3; ++ct) acc[ct] = (f32x4){0.f, 0.f, 0.f, 0.f};
        const bf16_t* ap = X1B + (size_t)(row0 + l15) * D + 8 * g;
#pragma unroll 4
        for (int ks = 0; ks < 32; ++ks) { const bf16x8 a = *(const bf16x8*)(ap + 32 * ks);
#pragma unroll
            for (int e = 0; e < 8; ++e) { const float v = bf2f((unsigned)(unsigned short)a[e]); ss += v * v; }
#pragma unroll
            for (int ct = 0; ct < 3; ++ct) acc[ct] = __builtin_amdgcn_mfma_f32_16x16x32_bf16(a, *(const LAS bf16x8*)(lds + (16 * ct + l15) * WROW + (32 * ks + 8 * g) * 2), acc[ct], 0, 0, 0); }
        ss += __shfl_xor(ss, 16); ss += __shfl_xor(ss, 32);
        const float rstd = 1.f / sqrtf(ss * (1.f / D) + RMS_EPS);
#pragma unroll
        for (int ct = 0; ct < 3; ++ct)
#pragma unroll
            for (int r = 0; r < 4; ++r) lg[(4 * g + r) * 48 + 16 * ct + l15] = acc[ct][r];
        asm volatile("s_waitcnt lgkmcnt(0)" ::: "memory");
        int ea = 0, eb = 0, ra = 0, rb = 0; float w0 = 0.f, w1 = 0.f; const int tok = row0 + lane;
        if (lane < 16) {
            const LAS float* ll = lg + lane * 48;
            float gl[4];
#pragma unroll
            for (int j = 0; j < 4; ++j) gl[j] = ll[j] * rstd + p.b_grp[j];
            int gs = 0; float gm = gl[0];
#pragma unroll
            for (int j = 1; j < 4; ++j) if (gl[j] > gm) { gm = gl[j]; gs = j; }
            float gsum = 0.f;
#pragma unroll
            for (int j = 0; j < 4; ++j) gsum += __expf(gl[j] - gm);
            const float gwt = 1.f / gsum;
            float el[8];
#pragma unroll
            for (int e = 0; e < 8; ++e) el[e] = ll[4 + gs * 8 + e] * rstd + p.b_er[gs * 8 + e];
            int i0 = 0; float v0 = el[0];
#pragma unroll
            for (int e = 1; e < 8; ++e) if (el[e] > v0) { v0 = el[e]; i0 = e; }
            int i1 = 0; float v1 = -INFINITY;
#pragma unroll
            for (int e = 0; e < 8; ++e) if (e != i0 && el[e] > v1) { v1 = el[e]; i1 = e; }
            const float e1 = __expf(v1 - v0); w0 = gwt / (1.f + e1); w1 = gwt * e1 / (1.f + e1);
            ea = gs * 8 + i0; eb = gs * 8 + i1;
            ra = __hip_atomic_fetch_add(hist + ea, 1, __ATOMIC_RELAXED, __HIP_MEMORY_SCOPE_WORKGROUP);
            rb = __hip_atomic_fetch_add(hist + eb, 1, __ATOMIC_RELAXED, __HIP_MEMORY_SCOPE_WORKGROUP);
            rstd_o[tok] = rstd;
        }
        __syncthreads();
        if (tid < 32) base[tid] = (int)__hip_atomic_fetch_add(F.ctl + CW_CNT + 64 * tid, (unsigned)hist[tid], __ATOMIC_RELAXED, __HIP_MEMORY_SCOPE_AGENT);
        __syncthreads();
        if (lane < 16) {
            list[(size_t)ea * LIST_CAP + base[ea] + ra] = tok * 2; list[(size_t)eb * LIST_CAP + base[eb] + rb] = tok * 2 + 1;
            tokw[tok * 2] = w0; tokw[tok * 2 + 1] = w1; }
        __syncthreads();
    }
}
}
#ifndef PROBE_FLAGS
#define PROBE_FLAGS 1
#endif
#ifndef PROBE_REP
#define PROBE_REP -1
#endif
struct Args { Ptrs p; int ph_lo, ph_hi, rep, li; };
constexpr int N_PHASES = 8;
__global__ void __launch_bounds__(NWAVES * 64, 2) mk_fwd(Args args) {
    extern __shared__ __attribute__((aligned(16))) unsigned char lds_raw[];
    Frame F;
    F.lds = (LAS unsigned char*)lds_raw; F.p = args.p;
    F.tid = threadIdx.x; F.lane = F.tid & 63; F.wave = __builtin_amdgcn_readfirstlane(F.tid >> 6);
    F.G = gridDim.x; { const int bx = blockIdx.x; F.vcu = (F.G % 8 == 0) ? (bx % 8) * (F.G / 8) + bx / 8 : bx; }
    F.ctl = (unsigned*)(args.p.ws + WS_CTL);
    for (int u = F.tid; u < (LDS_BYTES - LDSCTL_OFF) / 4; u += NWAVES * 64) ((LAS unsigned*)(F.lds + LDSCTL_OFF))[u] = 0u;
    __syncthreads();
    XcdBarrier bar = xcd_barrier_post(F.ctl + CW_BAR + args.li * XCD_BAR_WORDS, (volatile LAS unsigned*)(F.lds + MISC_OFF) + 8);
    const int lo = args.ph_lo, hi = args.ph_hi;
    unsigned char* ws = args.p.ws;
#define IN(k) (lo <= (k) && (k) < hi)
#define SEAM(k) do { if (IN(k) && IN((k) + 1)) xcd_barrier(bar); } while (0)
#define PH1 { pg8::StaticOrder S; S.init(ws + WS_HB, ws + WS_WIN, T, NPROJ, D, F.G, (int)blockIdx.x); const float* cs = (const float*)(ws + WS_ROPE); \
        pg8::EpiProj E{(bf16_t*)(ws + WS_PROJ), cs, cs + 2048 * 32}; pg8::gemm_phase<pg8::EpiProj, pg8::StaticOrder, true, false>(F.lds + RING_OFF, D, S, E); }
#define PH2(rep) { if (blockIdx.x < BATCH * 4 && !((rep) & 2)) { ml::mlstm_unit(F, (int)blockIdx.x); __syncthreads(); } if (!((rep) & 4)) att::attn_phase(F, CW_QATT + 64 * ((rep) & 1)); }
#define PH3 { pg8::StaticOrder S; S.init(ws + WS_MIX, ws + WS_WOUT, T, D, D, F.G, (int)blockIdx.x); pg8::EpiOut E{F.p.x, F.p.out, (bf16_t*)(ws + WS_X1B)}; \
        pg8::gemm_phase<pg8::EpiOut, pg8::StaticOrder, true, false>(F.lds + RING_OFF, D, S, E); }
#define PH5 { moe_tables(F); \
        pg8::MoeOrder S{(const LAS int*)(F.lds + TAB_OFF), F.G, F.vcu, (const char*)(ws + WS_X1B), (const char*)(ws + WS_W13), (size_t)1024 * 1024 * 2, (size_t)256 * 1024 * 2, 0, true, (const int*)(ws + WS_LIST), D}; \
        pg8::EpiUp E{(bf16_t*)(ws + WS_HD), (const float*)(ws + WS_RSTD), (const int*)(ws + WS_LIST)}; pg8::gemm_phase<pg8::EpiUp, pg8::MoeOrder, true, true>(F.lds + RING_OFF, D, S, E); }
#define PH6 { moe_tables(F); \
        pg8::MoeOrder S{(const LAS int*)(F.lds + TAB_OFF), F.G, F.vcu, (const char*)(ws + WS_HD), (const char*)(ws + WS_W2), (size_t)1024 * 512 * 2, (size_t)256 * 512 * 2, (size_t)DE * 2, false, (const int*)(ws + WS_LIST), DE}; \
        pg8::EpiDown E{(bf16_t*)(ws + WS_Y), (const float*)(ws + WS_TOKW), (const int*)(ws + WS_LIST)}; pg8::gemm_phase<pg8::EpiDown, pg8::MoeOrder, true, false>(F.lds + RING_OFF, DE, S, E); }

    if (IN(0)) p0_prologue(F);
    SEAM(0);
    if (IN(1)) PH1;
    SEAM(1);
    if (IN(2)) PH2(args.rep);
    SEAM(2);
    if (IN(3)) PH3;
    SEAM(3);
    if (IN(4)) rt::router_phase(F);
    SEAM(4);
    if (IN(5)) PH5;
    SEAM(5);
    if (IN(6)) PH6;
    SEAM(6);
    if (IN(7)) final_body(F);
#undef IN
#undef SEAM
}

extern "C" void kernel_launch(void* const* d_in, const int* in_sizes, int n_in, void* d_out, int out_size, void* d_ws, size_t ws_size, hipStream_t stream) {
    static int grid = 0;
    if (grid == 0) {
        if (n_in != 19 || out_size != T * D || ws_size < WS_END) { fprintf(stderr, "kernel_launch: unexpected shapes (n_in %d out %d ws %zu)\n", n_in, out_size, ws_size); grid = -1; return; }
        int dev = 0, cus = 0, per_cu = 0;
        if (hipGetDevice(&dev) != hipSuccess || hipDeviceGetAttribute(&cus, hipDeviceAttributeMultiprocessorCount, dev) != hipSuccess) { grid = -1; return; }
        if (hipFuncSetAttribute((const void*)mk_fwd, hipFuncAttributeMaxDynamicSharedMemorySize, LDS_BYTES) != hipSuccess) { fprintf(stderr, "kernel_launch: hipFuncSetAttribute failed\n"); grid = -1; return; }
        if (hipOccupancyMaxActiveBlocksPerMultiprocessor(&per_cu, (const void*)mk_fwd, NWAVES * 64, LDS_BYTES) != hipSuccess || per_cu < 1) { fprintf(stderr, "kernel_launch: occupancy query says %d\n", per_cu); }
        (void)hipGetLastError();
        grid = cus;
    }
    if (grid < 0) return;
    Args a{};
    Ptrs& p = a.p;
    p.x = (const float*)d_in[0]; p.w_in = (const float*)d_in[1]; p.conv_w = (const float*)d_in[2]; p.conv_b = (const float*)d_in[3]; p.gate_b = (const float*)d_in[4];
    p.lam_qk = (const float*)d_in[5]; p.subln_g = (const float*)d_in[6]; p.mhnorm_g = (const float*)d_in[7]; p.w_out = (const float*)d_in[8]; p.g_mix = (const float*)d_in[9];
    p.g_ffn = (const float*)d_in[10]; p.w_grp = (const float*)d_in[11]; p.b_grp = (const float*)d_in[12]; p.w_er = (const float*)d_in[13]; p.b_er = (const float*)d_in[14];
    p.w1 = (const float*)d_in[15]; p.w3 = (const float*)d_in[16]; p.w2 = (const float*)d_in[17]; p.g_final = (const float*)d_in[18];
    p.out = (float*)d_out; p.ws = (unsigned char*)d_ws;
    if (hipMemsetAsync((char*)d_ws + WS_CTL, 0, CTL_ZERO_BYTES, stream) != hipSuccess) return;
#if PROBE_REP >= 0
    const int cuts[4] = {0, PROBE_REP + 1, PROBE_REP + 1, N_PHASES};
    for (int li = 0; li < 3; ++li) { a.ph_lo = (li == 1) ? PROBE_REP : cuts[li]; a.ph_hi = cuts[li + 1]; a.rep = (li == 1) ? PROBE_FLAGS : 0; a.li = li;
        hipLaunchKernelGGL(mk_fwd, dim3(grid), dim3(NWAVES * 64), LDS_BYTES, stream, a); }
#else
    a.ph_lo = 0; a.ph_hi = N_PHASES; a.rep = 0; a.li = 0;
    hipLaunchKernelGGL(mk_fwd, dim3(grid), dim3(NWAVES * 64), LDS_BYTES, stream, a);
#endif
}
```

```cpp
#include <hip/hip_runtime.h>
#include <cstdio>
#include <cstdint>

constexpr int BATCH = 16, SEQ = 2048, D = 1024, T = BATCH * SEQ;
constexpr int DIN = 3592, NPROJ = 3584;
constexpr int C_QA = 0, C_KA = 512, C_VA = 1024, C_QM = 1536, C_KM = 2048, C_VM = 2560, C_OM = 3072, C_IG = 3584, C_FG = 3588;
constexpr int NE = 32, EPG = 8, DE = 512;
constexpr float RMS_EPS = 1e-6f;
constexpr float LAMBDA_INIT = 0.2f;
constexpr float C2Q = 0.125f * 1.4426950408889634f;
constexpr int LIST_CAP = T;

constexpr size_t MiB = 1u << 20;
constexpr size_t WS_CTL = 0, CTL_ZERO_BYTES = 1 * MiB;
constexpr size_t WS_ROPE = 1 * MiB;
constexpr size_t WS_TOKW = 2 * MiB;
constexpr size_t WS_RSTD = 2 * MiB + 512 * 1024;
constexpr size_t WS_WR = 3 * MiB;
constexpr size_t WS_GSC = 468 * MiB;
constexpr size_t WS_LIST = 4 * MiB;
constexpr size_t WS_GATES = 8 * MiB;
constexpr size_t WS_WIN = 10 * MiB;
constexpr size_t WS_WOUT = 17 * MiB;
constexpr size_t WS_W13 = 20 * MiB;
constexpr size_t WS_W2 = 84 * MiB;
constexpr size_t WS_PROJ = 116 * MiB;
constexpr size_t WS_MIX = 340 * MiB;
constexpr size_t WS_X1B = 404 * MiB;
constexpr size_t WS_HB = 404 * MiB;
constexpr size_t WS_HD = 116 * MiB;
constexpr size_t WS_Y = 188 * MiB;
constexpr size_t WS_END = 470 * MiB;
constexpr int CW_TMO = 0, CW_CODE = 1;
constexpr int CW_CNT = 1024;
constexpr int CW_BAR = 4096;
constexpr int CW_QATT = 16384;

#define LAS __attribute__((address_space(3)))
typedef unsigned short bf16_t;
typedef short bf16x8 __attribute__((ext_vector_type(8)));
typedef float f32x4 __attribute__((ext_vector_type(4)));
typedef unsigned u32x4 __attribute__((ext_vector_type(4)));
typedef unsigned u32x2 __attribute__((ext_vector_type(2)));

__device__ __forceinline__ unsigned f2bf(float f) { unsigned u = __float_as_uint(f); return (u + 0x7fffu + ((u >> 16) & 1u)) >> 16; }
__device__ __forceinline__ unsigned pk2(float lo, float hi) { return f2bf(lo) | (f2bf(hi) << 16); }
__device__ __forceinline__ float bf2f(unsigned b) { return __uint_as_float(b << 16); }
__device__ __forceinline__ float wave_sum(float v) {
#pragma unroll
    for (int o = 1; o < 64; o <<= 1) v += __shfl_xor(v, o);
    return v;
}
__device__ __forceinline__ float sigmoidf_(float x) { return 1.f / (1.f + __expf(-x)); }

struct MapId { __device__ __forceinline__ int operator()(int n) const { return n; } };
struct MapRope {
    __device__ __forceinline__ int operator()(int c) const { if (c >= 1024) return c; const int g = c & ~63, d = c & 63; return g + 8 * ((d & 31) >> 2) + 4 * (d >> 5) + (d & 3); } };
struct MapW1 { __device__ __forceinline__ int operator()(int c) const { return 256 * (c >> 7) + (c & 127); } };
struct MapW3 { __device__ __forceinline__ int operator()(int c) const { return 256 * (c >> 7) + 128 + (c & 127); } };
template <class Map>
__device__ __forceinline__ void transpose_item(const float* W, int ldw, bf16_t* WT, int K, int k0, int n0, const Map& map, const float* kscale, LAS float* scr, int lane) {
#pragma unroll 8
    for (int i = 0; i < 32; ++i) { const int kk = 2 * i + (lane >> 5); scr[kk * 33 + (lane & 31)] = W[(size_t)(k0 + kk) * ldw + n0 + (lane & 31)]; }
    asm volatile("s_waitcnt vmcnt(0) lgkmcnt(0)" ::: "memory");
    const int c = lane & 7;
    float ks[8];
#pragma unroll
    for (int i = 0; i < 8; ++i) ks[i] = kscale ? kscale[k0 + 8 * c + i] : 1.f;
#pragma unroll
    for (int j = 0; j < 4; ++j) { const int n = (lane >> 3) + 8 * j; const LAS float* s = scr + (8 * c) * 33 + n;
        u32x4 o; o.x = pk2(s[0 * 33] * ks[0], s[1 * 33] * ks[1]); o.y = pk2(s[2 * 33] * ks[2], s[3 * 33] * ks[3]); o.z = pk2(s[4 * 33] * ks[4], s[5 * 33] * ks[5]); o.w = pk2(s[6 * 33] * ks[6], s[7 * 33] * ks[7]);
        *(u32x4*)(WT + (size_t)map(n0 + n) * K + k0 + 8 * c) = o; }
    asm volatile("s_waitcnt lgkmcnt(0)" ::: "memory");
}

struct Ptrs {
    const float *x, *w_in, *conv_w, *conv_b, *gate_b, *lam_qk, *subln_g, *mhnorm_g, *w_out, *g_mix, *g_ffn, *w_grp, *b_grp, *w_er, *b_er, *w1, *w3, *w2, *g_final;
    float* out; unsigned char* ws;
};


namespace pg8 {
#define PG8_LAS __attribute__((address_space(3)))
constexpr int BM = 256, BK = 64, HALF = 128, HTB = HALF * BK * 2, STAGE_BYTES = 8 * HTB, NXCD = 8, WGM = 8;
__host__ __device__ __forceinline__ int lds_byte(int r, int c) { const int st = (r >> 4) * 2 + (c >> 5), rr = r & 15, cc = c & 31, ob = rr * 64 + cc * 2; return st * 1024 + (ob ^ (((ob >> 9) & 1) << 5)); }
__host__ __device__ __forceinline__ void stage_rc(int b, int& R, int& C) { const int st = b / 1024, sb = b % 1024, swz = sb ^ (((sb >> 9) & 1) << 5); R = (st >> 1) * 16 + swz / 64; C = (st & 1) * 32 + (swz % 64) / 2; }
__host__ __device__ __forceinline__ int perm32(int rho) { const int n = rho >> 4, i = rho & 15; return 8 * (i >> 2) + 4 * n + (i & 3); }

struct Unit { int pm, pn; const char* a; const char* b; int e, cnt, ps; };

struct StaticOrder {
    int nM, nN, nwg, G, c; const char* A; const char* Bt; size_t tstep;
    __device__ void init(const void* A_, const void* Bt_, int M, int N, int K, int G_, int c_) { A = (const char*)A_; Bt = (const char*)Bt_; nM = M / BM; nN = N / BM; nwg = nM * nN; G = G_; c = c_; tstep = (size_t)BM * K * 2; }
    __device__ bool next(int i, Unit& u) const {
        const long L = (long)i * G + c; if (L >= nwg) return false;
        int wgid = (int)L; { const int q = nwg / NXCD, r = nwg % NXCD, xcd = wgid % NXCD, off = wgid / NXCD; wgid = (xcd < r ? xcd * (q + 1) : r * (q + 1) + (xcd - r) * q) + off; }
        const int nig = WGM * nN, gid = wgid / nig, fm = gid * WGM, gsz = (nM - fm) < WGM ? (nM - fm) : WGM;
        u.pm = fm + ((wgid % nig) % gsz); u.pn = (wgid % nig) / gsz; u.a = A + (size_t)u.pm * tstep; u.b = Bt + (size_t)u.pn * tstep; u.e = 0; u.cnt = 0; u.ps = 0; return true;
    }
    __device__ __forceinline__ unsigned row_off(const Unit&, int) const { return 0u; }
};
struct MoeOrder {
    const PG8_LAS int* tab; int G, vcu; const char* A; const char* Bt; size_t bstep_e, bstep_n, astep; bool gather; const int* list; int K;
    __device__ bool next(int i, Unit& u) const {
        const int L = i * G + vcu; if (L >= tab[32]) return false;
        int e = 0;
#pragma unroll 1
        for (int j = 1; j < 32; ++j) e = (L >= tab[j]) ? j : e;
        const int loc = L - tab[e]; u.e = e; u.pn = loc & 3; u.pm = loc >> 2; u.cnt = tab[128 + e]; u.ps = tab[64 + e];
        u.b = Bt + (size_t)e * bstep_e + (size_t)u.pn * bstep_n;
        u.a = gather ? A : A + (size_t)(u.ps + u.pm * BM) * astep;
        return true;
    }
    __device__ __forceinline__ unsigned row_off(const Unit& u, int r) const {
        const int s = u.pm * BM + r; const int a = (s < u.cnt) ? list[(size_t)u.e * LIST_CAP + s] : 0; return (unsigned)(a >> 1) * (unsigned)(K * 2);
    }
};

typedef float f32x2_t __attribute__((ext_vector_type(2))); typedef __bf16 bf16x2_t __attribute__((ext_vector_type(2)));
__device__ __forceinline__ unsigned cvt_pk_bf16(float lo, float hi) { const f32x2_t v = {lo, hi}; const bf16x2_t b = __builtin_convertvector(v, bf16x2_t); return __builtin_bit_cast(unsigned, b); }

struct EpiProj {
    static constexpr bool PERM = true;
    bf16_t* O; const float* cs; const float* sn;
    __device__ __forceinline__ void operator()(const f32x4 (&acc)[2][2][4][2], const Unit& u, int wr, int wc, int fr, int fq) const {
        const int row0 = u.pm * BM + wr * 64 + fr, colt = u.pn * BM;
        if (u.pn < 4) {
            const float sc = (u.pn < 2) ? C2Q : 1.f; const int q8 = 4 * (wc & 1) + fq;
#pragma unroll
            for (int ai = 0; ai < 2; ++ai)
#pragma unroll
                for (int m = 0; m < 4; ++m) { const int row = row0 + ai * HALF + m * 16, pos = row & (SEQ - 1);
                    const f32x4 c4 = *(const f32x4*)(cs + pos * 32 + 4 * q8) * sc, s4 = *(const f32x4*)(sn + pos * 32 + 4 * q8) * sc;
                    bf16_t* rowp = O + (size_t)row * NPROJ + colt + 64 * (wc >> 1) + 4 * q8;
#pragma unroll
                    for (int bj = 0; bj < 2; ++bj) { const f32x4 x1 = acc[ai][bj][m][0], x2 = acc[ai][bj][m][1]; const f32x4 o1 = x1 * c4 - x2 * s4, o2 = x1 * s4 + x2 * c4;
                        u32x2 w1, w2; w1.x = cvt_pk_bf16(o1[0], o1[1]); w1.y = cvt_pk_bf16(o1[2], o1[3]); w2.x = cvt_pk_bf16(o2[0], o2[1]); w2.y = cvt_pk_bf16(o2[2], o2[3]);
                        *(u32x2*)(rowp + bj * HALF) = w1; *(u32x2*)(rowp + bj * HALF + 32) = w2; } }
        } else {
            const int col0 = colt + wc * 32 + 8 * fq;
#pragma unroll
            for (int ai = 0; ai < 2; ++ai)
#pragma unroll
                for (int m = 0; m < 4; ++m) { bf16_t* rowp = O + (size_t)(row0 + ai * HALF + m * 16) * NPROJ + col0;
#pragma unroll
                    for (int bj = 0; bj < 2; ++bj) { const f32x4 v0 = acc[ai][bj][m][0], v1 = acc[ai][bj][m][1];
                        u32x4 w; w.x = cvt_pk_bf16(v0[0], v0[1]); w.y = cvt_pk_bf16(v0[2], v0[3]); w.z = cvt_pk_bf16(v1[0], v1[1]); w.w = cvt_pk_bf16(v1[2], v1[3]);
                        *(u32x4*)(rowp + bj * HALF) = w; } }
        }
    }
};
struct EpiOut {
    static constexpr bool PERM = true;
    const float* x; bf16_t* X1B;
    __device__ __forceinline__ void operator()(const f32x4 (&acc)[2][2][4][2], const Unit& u, int wr, int wc, int fr, int fq) const {
        const int row0 = u.pm * BM + wr * 64 + fr, col0 = u.pn * BM + wc * 32 + 8 * fq;
#pragma unroll
        for (int ai = 0; ai < 2; ++ai)
#pragma unroll
            for (int m = 0; m < 4; ++m) { const size_t off = (size_t)(row0 + ai * HALF + m * 16) * D + col0;
#pragma unroll
                for (int bj = 0; bj < 2; ++bj) { const f32x4 v0 = acc[ai][bj][m][0] + *(const f32x4*)(x + off + bj * HALF), v1 = acc[ai][bj][m][1] + *(const f32x4*)(x + off + bj * HALF + 4);
                    u32x4 w; w.x = cvt_pk_bf16(v0[0], v0[1]); w.y = cvt_pk_bf16(v0[2], v0[3]); w.z = cvt_pk_bf16(v1[0], v1[1]); w.w = cvt_pk_bf16(v1[2], v1[3]);
                    *(u32x4*)(X1B + off + bj * HALF) = w; }
                asm volatile("" ::: "memory"); }
    }
};
struct EpiUp {
    static constexpr bool PERM = true;
    bf16_t* HD; const float* rstd; const int* list;
    __device__ __forceinline__ void operator()(const f32x4 (&acc)[2][2][4][2], const Unit& u, int wr, int wc, int fr, int fq) const {
        const int r0 = u.pm * BM + wr * 64 + fr, col0 = u.pn * HALF + wc * 32 + 8 * fq;
#pragma unroll
        for (int ai = 0; ai < 2; ++ai)
#pragma unroll
            for (int m = 0; m < 4; ++m) { const int s = r0 + ai * HALF + m * 16; if (s < u.cnt) { const float rs = rstd[list[(size_t)u.e * LIST_CAP + s] >> 1];
                    float h[8];
#pragma unroll
                    for (int n = 0; n < 2; ++n)
#pragma unroll
                        for (int i = 0; i < 4; ++i) { const float a = acc[ai][0][m][n][i] * rs, b = acc[ai][1][m][n][i] * rs; h[4 * n + i] = a * b / (1.f + __expf(-a)); }
                    u32x4 w; w.x = cvt_pk_bf16(h[0], h[1]); w.y = cvt_pk_bf16(h[2], h[3]); w.z = cvt_pk_bf16(h[4], h[5]); w.w = cvt_pk_bf16(h[6], h[7]);
                    *(u32x4*)(HD + (size_t)(u.ps + s) * DE + col0) = w; } }
    }
};
struct EpiDown {
    static constexpr bool PERM = true;
    bf16_t* Y; const float* tokw; const int* list;
    __device__ __forceinline__ void operator()(const f32x4 (&acc)[2][2][4][2], const Unit& u, int wr, int wc, int fr, int fq) const {
        const int r0 = u.pm * BM + wr * 64 + fr, col0 = u.pn * BM + wc * 32 + 8 * fq;
#pragma unroll
        for (int ai = 0; ai < 2; ++ai)
#pragma unroll
            for (int m = 0; m < 4; ++m) { const int s = r0 + ai * HALF + m * 16; if (s < u.cnt) { const int a = list[(size_t)u.e * LIST_CAP + s]; const float w8 = tokw[a];
                    bf16_t* rowp = Y + (size_t)a * D + col0;
#pragma unroll
                    for (int bj = 0; bj < 2; ++bj) { const f32x4 v0 = acc[ai][bj][m][0] * w8, v1 = acc[ai][bj][m][1] * w8;
                        u32x4 w; w.x = cvt_pk_bf16(v0[0], v0[1]); w.y = cvt_pk_bf16(v0[2], v0[3]); w.z = cvt_pk_bf16(v1[0], v1[1]); w.w = cvt_pk_bf16(v1[2], v1[3]);
                        *(u32x4*)(rowp + bj * HALF) = w; } } }
    }
};

template <class Epi, class Sched, bool ALIGN_EPI, bool GATHER>
__device__ __forceinline__ void gemm_phase(PG8_LAS unsigned char* lds, const int K, const Sched& S, const Epi& E) {
    const int tid = threadIdx.x, wid = __builtin_amdgcn_readfirstlane(tid >> 6), lane = tid & 63, wr = wid >> 2, wc = wid & 3, fr = lane & 15, fq = lane >> 4;
    const int nt = K / BK;
    unsigned voffB[2], ga[2][2], gn[2][2]; int RA[2], CA[2];
#pragma unroll
    for (int i = 0; i < 2; ++i) { int R, C; stage_rc(tid * 16 + i * 8192, R, C); const int Rb = Epi::PERM ? ((R & ~31) + perm32(R & 31)) : R;
        RA[i] = R; CA[i] = C; voffB[i] = (unsigned)(Rb * K + C) * 2u; }
    const size_t kstep = (size_t)(BK * 2);
    const size_t hstep = (size_t)HALF * K * 2;
    const unsigned ldsw = (unsigned)wid * 1024u;
    const int aoff = lds_byte(wr * 64 + fr, fq * 8), boff = lds_byte(wc * 32 + fr, fq * 8);
#define PG8_SA(b, h) (((b) * 2 + (h)) * HTB)
#define PG8_SB(b, h) ((4 + (b) * 2 + (h)) * HTB)
#define PG8_STAGE(bufoff, gbase, voff) do { _Pragma("unroll") for (int _i = 0; _i < 2; ++_i) \
        __builtin_amdgcn_global_load_lds((const unsigned*)((const char*)(gbase) + (voff)[_i]), (PG8_LAS unsigned*)(lds + (bufoff) + ldsw + _i * 8192), 16, 0, 0); } while (0)
#define PG8_LDA(dst, b, h) do { _Pragma("unroll") for (int m = 0; m < 4; ++m) _Pragma("unroll") for (int k = 0; k < 2; ++k) dst[m][k] = *(const PG8_LAS bf16x8*)(lds + PG8_SA(b, h) + aoff + m * 2048 + k * 1024); } while (0)
#define PG8_LDB(dst, b, h) do { _Pragma("unroll") for (int n = 0; n < 2; ++n) _Pragma("unroll") for (int k = 0; k < 2; ++k) dst[n][k] = *(const PG8_LAS bf16x8*)(lds + PG8_SB(b, h) + boff + n * 2048 + k * 1024); } while (0)
#define PG8_MMA(ai, bj, At, Bt) do { __builtin_amdgcn_s_setprio(1); _Pragma("unroll") for (int m = 0; m < 4; ++m) _Pragma("unroll") for (int n = 0; n < 2; ++n) _Pragma("unroll") for (int k = 0; k < 2; ++k) \
        acc[ai][bj][m][n] = __builtin_amdgcn_mfma_f32_16x16x32_bf16(Bt[n][k], At[m][k], acc[ai][bj][m][n], 0, 0, 0); __builtin_amdgcn_s_setprio(0); } while (0)
#define PG8_WAIT_V(n) asm volatile("s_waitcnt vmcnt(" #n ")" ::: "memory")
#define PG8_WAIT_L(n) asm volatile("s_waitcnt lgkmcnt(" #n ")" ::: "memory")
#define PG8_BAR __builtin_amdgcn_s_barrier()
#define PG8_SCHED __builtin_amdgcn_sched_barrier(0)
    Unit cur, nxt; int ui = 0;
    if (!S.next(0, cur)) return;
#pragma unroll
    for (int h = 0; h < 2; ++h)
#pragma unroll
        for (int i = 0; i < 2; ++i) { ga[h][i] = (GATHER ? S.row_off(cur, h * HALF + RA[i]) : (unsigned)((h * HALF + RA[i]) * K) * 2u) + (unsigned)CA[i] * 2u; gn[h][i] = ga[h][i]; }
    f32x4 acc[2][2][4][2];
#pragma unroll
    for (int a = 0; a < 2; ++a)
#pragma unroll
        for (int b = 0; b < 2; ++b)
#pragma unroll
            for (int m = 0; m < 4; ++m)
#pragma unroll
                for (int n = 0; n < 2; ++n) acc[a][b][m][n] = (f32x4){0.f, 0.f, 0.f, 0.f};
    bf16x8 At[4][2], B0[2][2], B1[2][2];
    const char* cA = cur.a; const char* cB = cur.b;
    PG8_STAGE(PG8_SB(0, 0), cB, voffB); PG8_STAGE(PG8_SB(0, 1), cB + hstep, voffB); PG8_STAGE(PG8_SA(0, 0), cA, ga[0]); PG8_STAGE(PG8_SA(0, 1), cA, ga[1]);
    if (wr == 1) PG8_BAR;
    PG8_WAIT_V(2); PG8_BAR;
    PG8_STAGE(PG8_SB(1, 0), cB + kstep, voffB); PG8_STAGE(PG8_SA(1, 0), cA + kstep, ga[0]); PG8_STAGE(PG8_SB(1, 1), cB + hstep + kstep, voffB);
    PG8_WAIT_V(6); PG8_BAR;
    for (;;) {
        const bool has_next = S.next(ui + 1, nxt);
        const char* nA = has_next ? nxt.a : cA; const char* nB = has_next ? nxt.b : cB;
        if (GATHER && has_next) {
#pragma unroll
            for (int h = 0; h < 2; ++h)
#pragma unroll
                for (int i = 0; i < 2; ++i) gn[h][i] = S.row_off(nxt, h * HALF + RA[i]) + (unsigned)CA[i] * 2u;
        }
        for (int t = 0; t < nt; t += 2) {
            const bool last = (t == nt - 2);
            const char* a1 = cA + (size_t)(t + 1) * kstep;
            const char* a2 = last ? nA : cA + (size_t)(t + 2) * kstep; const char* b2 = last ? nB : cB + (size_t)(t + 2) * kstep;
            const char* a3 = a2 + kstep; const char* b3 = b2 + kstep;
            unsigned g2[2][2];
#pragma unroll
            for (int h = 0; h < 2; ++h)
#pragma unroll
                for (int i = 0; i < 2; ++i) g2[h][i] = (GATHER && last) ? gn[h][i] : ga[h][i];
            PG8_LDB(B0, 0, 0); PG8_LDB(B1, 0, 1); PG8_SCHED; PG8_LDA(At, 0, 0); PG8_STAGE(PG8_SA(1, 1), a1, ga[1]);
            PG8_WAIT_V(8); PG8_WAIT_L(0); PG8_BAR; PG8_MMA(0, 0, At, B0); PG8_MMA(0, 1, At, B1); PG8_BAR; PG8_SCHED;
            PG8_LDA(At, 0, 1); PG8_STAGE(PG8_SB(0, 0), b2, voffB); PG8_STAGE(PG8_SB(0, 1), b2 + hstep, voffB); PG8_STAGE(PG8_SA(0, 0), a2, g2[0]);
            PG8_WAIT_V(8); PG8_WAIT_L(0); PG8_BAR; PG8_MMA(1, 0, At, B0); PG8_MMA(1, 1, At, B1); PG8_BAR; PG8_SCHED;
            PG8_LDB(B0, 1, 0); PG8_LDB(B1, 1, 1); PG8_SCHED; PG8_LDA(At, 1, 0); PG8_STAGE(PG8_SA(0, 1), a2, g2[1]);
            PG8_WAIT_V(8); PG8_WAIT_L(0); PG8_BAR; PG8_MMA(0, 0, At, B0); PG8_MMA(0, 1, At, B1); PG8_BAR; PG8_SCHED;
            PG8_LDA(At, 1, 1); PG8_STAGE(PG8_SB(1, 0), b3, voffB); PG8_STAGE(PG8_SB(1, 1), b3 + hstep, voffB); PG8_STAGE(PG8_SA(1, 0), a3, g2[0]);
            PG8_WAIT_V(8); PG8_WAIT_L(0); PG8_BAR; PG8_MMA(1, 0, At, B0); PG8_MMA(1, 1, At, B1); PG8_BAR; PG8_SCHED;
        }
        if constexpr (ALIGN_EPI) { if (wr == 0) PG8_BAR; }
        E(acc, cur, wr, wc, fr, fq);
        if (!has_next) break;
#pragma unroll
        for (int a = 0; a < 2; ++a)
#pragma unroll
            for (int b = 0; b < 2; ++b)
#pragma unroll
                for (int m = 0; m < 4; ++m)
#pragma unroll
                    for (int n = 0; n < 2; ++n) acc[a][b][m][n] = (f32x4){0.f, 0.f, 0.f, 0.f};
        cur = nxt; cA = nA; cB = nB; ++ui;
#pragma unroll
        for (int h = 0; h < 2; ++h)
#pragma unroll
            for (int i = 0; i < 2; ++i) ga[h][i] = gn[h][i];
        if constexpr (ALIGN_EPI) { if (wr == 1) PG8_BAR; }
    }
    PG8_WAIT_V(0);
    if constexpr (!ALIGN_EPI) { if (wr == 0) PG8_BAR; }
    PG8_BAR;
#undef PG8_SA
#undef PG8_SB
#undef PG8_STAGE
#undef PG8_LDA
#undef PG8_LDB
#undef PG8_MMA
#undef PG8_WAIT_V
#undef PG8_WAIT_L
#undef PG8_BAR
#undef PG8_SCHED
}
}

constexpr int NWAVES = 8;
constexpr int RING_OFF = 0, RING_BYTES = 143360;
constexpr int LDSCTL_OFF = RING_BYTES;
constexpr int MISC_OFF = LDSCTL_OFF + 64;
constexpr int TAB_OFF = LDSCTL_OFF + 256;
constexpr int LDS_BYTES = RING_BYTES + 2048;

#define GAS __attribute__((address_space(1)))
typedef GAS unsigned gu32;
#define RLX_AGENT __ATOMIC_RELAXED, __HIP_MEMORY_SCOPE_AGENT
#define LDS_WAIT() asm volatile("s_waitcnt lgkmcnt(0)" ::: "memory")
#define VM_WAIT() asm volatile("s_waitcnt vmcnt(0)" ::: "memory")

#define XB_TMO      128
#define XB_XCNT(j)  (256  + 64 * (j))
#define XB_XSUB(j)  (1280 + 64 * (j))
#define XB_XGEN(j)  (2304 + 64 * (j))
#define XB_TOP      3328
#define XB_TOPGEN   3392
#define XCD_BAR_WORDS 3456
#define XB_SPIN_CAP (1u << 18)

__device__ __forceinline__ unsigned xb_ld(unsigned* p)              { return __hip_atomic_load(p, __ATOMIC_RELAXED, __HIP_MEMORY_SCOPE_AGENT); }
__device__ __forceinline__ unsigned xb_add(unsigned* p, unsigned v) { return __hip_atomic_fetch_add(p, v, __ATOMIC_RELAXED, __HIP_MEMORY_SCOPE_AGENT); }
__device__ __forceinline__ unsigned xb_xcc_id() { return (unsigned)__builtin_amdgcn_s_getreg((3 << 11) | 20) & 0xFu; }
#define XB_SPIN(cond, bar) do { unsigned _sp = 0; while (cond) { __builtin_amdgcn_s_sleep(1); \
    if ((++_sp & 255u) == 0u) { if (xb_ld(&(bar)[XB_TMO])) break; if (_sp > XB_SPIN_CAP) { atomicAdd(&(bar)[XB_TMO], 1u); break; } } } } while (0)

struct XcdBarrier { unsigned* bar; unsigned x; volatile LAS unsigned* st; };

__device__ __forceinline__ XcdBarrier xcd_barrier_post(unsigned* bar, volatile LAS unsigned* st) {
    XcdBarrier b; b.bar = bar; b.x = xb_xcc_id(); b.st = st;
    if (threadIdx.x == 0) (void)xb_add(&bar[XB_XCNT(b.x)], 1u);
    return b;
}
__device__ __forceinline__ void xcd_barrier_complete(unsigned* bar, unsigned x, unsigned& nloc, unsigned& nx) {
    const unsigned G = gridDim.x * gridDim.y * gridDim.z;
    unsigned sum, cnt, mine, sp = 0u;
    for (;;) {
        sum = 0u; cnt = 0u; mine = 0u;
#pragma unroll
        for (unsigned j = 0; j < 16; ++j) { const unsigned c = xb_ld(&bar[XB_XCNT(j)]); sum += c; cnt += (c > 0u) ? 1u : 0u; mine = (j == x) ? c : mine; }
        if (sum == G) break;
        __builtin_amdgcn_s_sleep(1);
        if ((++sp & 255u) == 0u) { if (xb_ld(&bar[XB_TMO])) break; if (sp > XB_SPIN_CAP) { atomicAdd(&bar[XB_TMO], 1u); break; } }
    }
    nloc = mine > 0u ? mine : 1u; nx = cnt > 0u ? cnt : 1u;
}
__device__ __forceinline__ void xcd_barrier(const XcdBarrier& b) {
    asm volatile("s_waitcnt vmcnt(0)" ::: "memory");
    __syncthreads();
    if (threadIdx.x == 0) {
        unsigned* bar = b.bar;
        __builtin_amdgcn_s_waitcnt(0);
        unsigned nloc = b.st[0], nx = b.st[1];
        if (nloc == 0u) { xcd_barrier_complete(bar, b.x, nloc, nx); b.st[0] = nloc; b.st[1] = nx; }
        const unsigned old = xb_add(&bar[XB_XSUB(b.x)], 1u);
        const unsigned gen = old / nloc;
        if (old + 1u == (gen + 1u) * nloc) {
            __builtin_amdgcn_fence(__ATOMIC_RELEASE, "agent");
            asm volatile("s_waitcnt vmcnt(0)" ::: "memory");
            const unsigned og = xb_add(&bar[XB_TOP], 1u);
            const unsigned tg = og / nx;
            if (og + 1u == (tg + 1u) * nx) xb_add(&bar[XB_TOPGEN], 1u);
            else XB_SPIN(xb_ld(&bar[XB_TOPGEN]) == tg, bar);
            __builtin_amdgcn_fence(__ATOMIC_ACQUIRE, "agent");
            xb_add(&bar[XB_XGEN(b.x)], 1u);
            asm volatile("s_waitcnt vmcnt(0)" ::: "memory");
        } else {
            XB_SPIN(xb_ld(&bar[XB_XGEN(b.x)]) == gen, bar);
            __builtin_amdgcn_fence(__ATOMIC_ACQUIRE, "agent");
            asm volatile("s_waitcnt vmcnt(0)" ::: "memory");
        }
    }
    __syncthreads();
}

struct Frame {
    LAS unsigned char* lds;
    unsigned* ctl;
    int tid, lane, wave, vcu, G;
    Ptrs p;
};

__device__ __forceinline__ void p0_prologue(Frame& F) {
    const Ptrs& p = F.p; const int tid = F.tid, lane = F.lane, wave = F.wave;
    LAS float* scr = (LAS float*)(F.lds + RING_OFF) + wave * 64 * 33;
    LAS float* gw = (LAS float*)(F.lds + RING_OFF + 8 * 64 * 33 * 4);
    const int gw_id = F.vcu * NWAVES + wave, NGW = F.G * NWAVES;
    bf16_t* WIN = (bf16_t*)(p.ws + WS_WIN); bf16_t* WOUT = (bf16_t*)(p.ws + WS_WOUT); bf16_t* W13 = (bf16_t*)(p.ws + WS_W13); bf16_t* W2 = (bf16_t*)(p.ws + WS_W2);
    for (int i = tid; i < 1024 * 8; i += NWAVES * 64) gw[i] = p.w_in[(size_t)(i >> 3) * DIN + C_IG + (i & 7)];
    __syncthreads();
    constexpr int I_IN = 16 * 112, I_OUT = 16 * 32, I_13 = 16 * 16 * 32, I_2 = 8 * 32 * 32;
    constexpr int NITEMS = I_IN + I_OUT + 2 * I_13 + I_2;
    for (int it = gw_id; it < NITEMS; it += NGW) {
        int r = it;
        if (r < I_IN) { const int kb = r / 112, nb = r % 112; transpose_item(p.w_in, DIN, WIN, 1024, 64 * kb, 32 * nb, MapRope(), nullptr, scr, lane); continue; } r -= I_IN;
        if (r < I_OUT) { const int kb = r / 32, nb = r % 32; transpose_item(p.w_out, 1024, WOUT, 1024, 64 * kb, 32 * nb, MapId(), nullptr, scr, lane); continue; } r -= I_OUT;
        if (r < I_13) { const int e = r / 256, q = r % 256, kb = q / 16, nb = q % 16; transpose_item(p.w1 + (size_t)e * 1024 * 512, 512, W13 + (size_t)e * 1024 * 1024, 1024, 64 * kb, 32 * nb, MapW1(), p.g_ffn, scr, lane); continue; } r -= I_13;
        if (r < I_13) { const int e = r / 256, q = r % 256, kb = q / 16, nb = q % 16; transpose_item(p.w3 + (size_t)e * 1024 * 512, 512, W13 + (size_t)e * 1024 * 1024, 1024, 64 * kb, 32 * nb, MapW3(), p.g_ffn, scr, lane); continue; } r -= I_13;
        { const int e = r / 256, q = r % 256, kb = q / 32, nb = q % 32; transpose_item(p.w2 + (size_t)e * 512 * 1024, 1024, W2 + (size_t)e * 1024 * 512, 512, 64 * kb, 32 * nb, MapId(), nullptr, scr, lane); }
    }
    { float* cs = (float*)(p.ws + WS_ROPE); float* sn = cs + 2048 * 32;
      for (int i = blockIdx.x * 512 + tid; i < 2048 * 32; i += F.G * 512) { const int pos = i >> 5, j = i & 31;
          const float inv = 1.0f / exp2f((float)(2 * j) * (1.f / 64.f) * 13.287712379549449f);
          const float ang = (float)pos * inv; const double rev = (double)ang * 0.15915494309189535; const float fr = (float)(rev - rint(rev));
          cs[i] = __builtin_amdgcn_cosf(fr); sn[i] = __builtin_amdgcn_sinf(fr); } }
    { bf16_t* WR = (bf16_t*)(p.ws + WS_WR);
      for (int i = blockIdx.x * 512 + tid; i < 48 * 1024; i += F.G * 512) { const int c = i >> 10, k = i & 1023; float v = 0.f;
          if (c < 4) v = p.w_grp[k * 4 + c]; else if (c < 36) v = p.w_er[((size_t)((c - 4) >> 3) * 1024 + k) * 8 + ((c - 4) & 7)];
          WR[i] = (bf16_t)f2bf(v * p.g_ffn[k]); } }
    bf16_t* HB = (bf16_t*)(p.ws + WS_HB); float* GATES = (float*)(p.ws + WS_GATES);
    for (int m = gw_id; m < T; m += NGW) {
        const f32x4* xr = (const f32x4*)(p.x + (size_t)m * D) + lane; const f32x4* gr = (const f32x4*)p.g_mix + lane;
        f32x4 v[4]; float s = 0.f;
#pragma unroll
        for (int j = 0; j < 4; ++j) { v[j] = xr[64 * j]; s += (v[j].x * v[j].x + v[j].y * v[j].y) + (v[j].z * v[j].z + v[j].w * v[j].w); }
        const float rstd = 1.f / sqrtf(wave_sum(s) * (1.f / D) + RMS_EPS);
        float ga[8];
#pragma unroll
        for (int e = 0; e < 8; ++e) ga[e] = 0.f;
        unsigned long long* o8 = (unsigned long long*)(HB + (size_t)m * D) + lane;
#pragma unroll
        for (int j = 0; j < 4; ++j) { const f32x4 g = gr[64 * j]; f32x4 h = v[j] * rstd * g;
            o8[64 * j] = (unsigned long long)pk2(h.x, h.y) | ((unsigned long long)pk2(h.z, h.w) << 32);
            const int k0 = 256 * j + 4 * lane;
#pragma unroll
            for (int q = 0; q < 4; ++q) { const float hv = h[q]; const LAS float* w = gw + (k0 + q) * 8;
#pragma unroll
                for (int e = 0; e < 8; ++e) ga[e] += hv * w[e]; } }
#pragma unroll
        for (int e = 0; e < 8; ++e) ga[e] = wave_sum(ga[e]);
        if (lane < 8) { float gv = 0.f;
#pragma unroll
            for (int e = 0; e < 8; ++e) gv = (lane == e) ? ga[e] : gv;
            gv += p.gate_b[lane];
            if (lane >= 4) gv = fminf(gv, 0.f) - log1pf(__expf(-fabsf(gv)));
            GATES[(size_t)m * 8 + lane] = gv; }
    }
}

__device__ __forceinline__ void final_body(Frame& F) {
    const Ptrs& p = F.p; const int lane = F.lane; const bf16_t* X1B = (const bf16_t*)(p.ws + WS_X1B); const bf16_t* Y = (const bf16_t*)(p.ws + WS_Y);
    for (size_t tok = F.vcu * NWAVES + F.wave; tok < T; tok += F.G * NWAVES) {
        f32x4 v[4]; float s = 0.f;
#pragma unroll
        for (int j = 0; j < 4; ++j) { const u32x2 x = ((const u32x2*)(X1B + tok * D))[lane + 64 * j];
            const u32x2 a = ((const u32x2*)(Y + (2 * tok) * D))[lane + 64 * j], b = ((const u32x2*)(Y + (2 * tok + 1) * D))[lane + 64 * j];
            v[j].x = bf2f(x.x & 0xffffu) + (bf2f(a.x & 0xffffu) + bf2f(b.x & 0xffffu)); v[j].y = bf2f(x.x >> 16) + (bf2f(a.x >> 16) + bf2f(b.x >> 16));
            v[j].z = bf2f(x.y & 0xffffu) + (bf2f(a.y & 0xffffu) + bf2f(b.y & 0xffffu)); v[j].w = bf2f(x.y >> 16) + (bf2f(a.y >> 16) + bf2f(b.y >> 16));
            s += (v[j].x * v[j].x + v[j].y * v[j].y) + (v[j].z * v[j].z + v[j].w * v[j].w); }
        const float rstd = 1.f / sqrtf(wave_sum(s) * (1.f / D) + RMS_EPS);
#pragma unroll
        for (int j = 0; j < 4; ++j) { const f32x4 g = ((const f32x4*)p.g_final)[lane + 64 * j]; ((f32x4*)(p.out + tok * D))[lane + 64 * j] = v[j] * rstd * g; }
    }
}
__device__ __forceinline__ void moe_tables(Frame& F) {
    LAS int* tab = (LAS int*)(F.lds + TAB_OFF);
    if (F.tid == 0) { int us = 0, ps = 0;
        for (int e = 0; e < NE; ++e) { const int c = (int)__hip_atomic_load(F.ctl + CW_CNT + 64 * e, RLX_AGENT); const int nb = (c + 255) >> 8;
            tab[e] = us; tab[64 + e] = ps; tab[128 + e] = c; us += nb * 4; ps += nb * 256; }
        tab[32] = us; tab[96] = ps; }
    __syncthreads();
}


namespace att {
typedef float f32x16 __attribute__((ext_vector_type(16)));
typedef short s16x4 __attribute__((ext_vector_type(4)));
constexpr int STAGE = 32768, VOFF = 16384, XCH_OFF = 65536;
constexpr int ROWB = NPROJ * 2;
__device__ __forceinline__ int crow(int r, int hi) { return (r & 3) + 8 * (r >> 2) + 4 * hi; }
__device__ __forceinline__ unsigned swz(unsigned row) { return ((row & 3u) << 2) | ((row >> 2) & 3u); }
__device__ __forceinline__ s16x4 trrd(const LAS unsigned char* p) { return __builtin_bit_cast(s16x4, __builtin_amdgcn_ds_read_tr16_b64_v4i16((LAS s16x4*)p)); }

__device__ __forceinline__ void attn_unit(Frame& F, int bh, int qb, float lam) {
    LAS unsigned char* lds = F.lds + RING_OFF;
    const int lane = F.lane, wid = F.wave, c = wid >> 2, wq = wid & 3, r32 = lane & 31, hi = lane >> 5;
    const int b = bh >> 2, h = bh & 3, q0 = qb * 128, qlo = q0 + 32 * wq;
    const char* projb = (const char*)(F.p.ws + WS_PROJ) + (size_t)(b * SEQ) * ROWB;
    const char* kg = projb + (C_KA + h * 128) * 2; const char* vg = projb + (C_VA + h * 128) * 2;
    unsigned srcoff[2];
#pragma unroll
    for (int n = 0; n < 2; ++n) { const unsigned row = 4u * (wid + 8 * n) + (lane >> 4), slot = lane & 15; srcoff[n] = row * ROWB + ((slot ^ swz(row)) << 4); }
#define ATT_DMA(t, st) do { _Pragma("unroll") for (int _n = 0; _n < 2; ++_n) { \
        __builtin_amdgcn_global_load_lds((const unsigned*)(kg + (size_t)(t) * 64 * ROWB + srcoff[_n]), (LAS unsigned*)(lds + (st) * STAGE + (wid + 8 * _n) * 1024), 16, 0, 0); \
        __builtin_amdgcn_global_load_lds((const unsigned*)(vg + (size_t)(t) * 64 * ROWB + srcoff[_n]), (LAS unsigned*)(lds + (st) * STAGE + VOFF + (wid + 8 * _n) * 1024), 16, 0, 0); } } while (0)
    bf16x8 qf[4];
    { const bf16_t* qp = (const bf16_t*)(projb + (size_t)(qlo + r32) * ROWB) + C_QA + h * 128 + c * 64 + 8 * hi;
#pragma unroll
      for (int s = 0; s < 4; ++s) qf[s] = *(const bf16x8*)(qp + 16 * s); }
    unsigned kaddr[4], vaddr[2][4];
#pragma unroll
    for (int s = 0; s < 4; ++s) kaddr[s] = 256u * r32 + 16u * ((unsigned)(8 * c + 2 * s + hi) ^ swz(r32));
    { const unsigned blk = (lane >> 4) & 1, q = (lane & 15) >> 2, p = lane & 3;
#pragma unroll
      for (int t2 = 0; t2 < 2; ++t2)
#pragma unroll
          for (int dt = 0; dt < 4; ++dt) { const unsigned row = 8u * t2 + 4u * hi + q; vaddr[t2][dt] = 256u * row + 16u * ((4u * dt + 2u * blk + (p >> 1)) ^ swz(row)) + 8u * (p & 1); } }
    f32x16 o[4];
#pragma unroll
    for (int dt = 0; dt < 4; ++dt)
#pragma unroll
        for (int r = 0; r < 16; ++r) o[dt][r] = 0.f;
    float m = -INFINITY, l = 0.f;
    const int NT = 2 * qb + 2;
    ATT_DMA(0, 0);
    for (int t = 0; t < NT; ++t) {
        asm volatile("s_waitcnt vmcnt(0)" ::: "memory"); __builtin_amdgcn_s_barrier(); asm volatile("" ::: "memory");
        if (t + 1 < NT) ATT_DMA(t + 1, (t + 1) & 1);
        if (64 * t <= qlo + 31) {
            const LAS unsigned char* kb = lds + (t & 1) * STAGE; const LAS unsigned char* vb = kb + VOFF;
            f32x16 p0, p1;
#pragma unroll
            for (int r = 0; r < 16; ++r) { p0[r] = 0.f; p1[r] = 0.f; }
#pragma unroll
            for (int s = 0; s < 4; ++s) { const bf16x8 k0 = *(const LAS bf16x8*)(kb + kaddr[s]), k1 = *(const LAS bf16x8*)(kb + 8192 + kaddr[s]);
                p0 = __builtin_amdgcn_mfma_f32_32x32x16_bf16(k0, qf[s], p0, 0, 0, 0); p1 = __builtin_amdgcn_mfma_f32_32x32x16_bf16(k1, qf[s], p1, 0, 0, 0); }
            if (64 * t + 63 > qlo) { const int qg = qlo + r32;
#pragma unroll
                for (int r = 0; r < 16; ++r) { const int key = 64 * t + crow(r, hi); if (key > qg) p0[r] = -INFINITY; if (key + 32 > qg) p1[r] = -INFINITY; } }
            float rm = fmaxf(p0[0], p1[0]);
#pragma unroll
            for (int r = 1; r < 16; ++r) rm = fmaxf(rm, fmaxf(p0[r], p1[r]));
            rm = fmaxf(rm, __shfl_xor(rm, 32));
            const float mn = fmaxf(m, rm), alpha = __builtin_amdgcn_exp2f(m - mn); m = mn;
            float rs = 0.f;
#pragma unroll
            for (int r = 0; r < 16; ++r) { p0[r] = __builtin_amdgcn_exp2f(p0[r] - mn); p1[r] = __builtin_amdgcn_exp2f(p1[r] - mn); rs += p0[r] + p1[r]; }
            l = l * alpha + rs;
#pragma unroll
            for (int dt = 0; dt < 4; ++dt)
#pragma unroll
                for (int r = 0; r < 16; ++r) o[dt][r] *= alpha;
            bf16x8 pf[4];
#pragma unroll
            for (int ks = 0; ks < 4; ++ks) { u32x4 w;
#pragma unroll
                for (int j = 0; j < 4; ++j) { const int r = 8 * (ks & 1) + 2 * j; w[j] = (ks < 2) ? pg8::cvt_pk_bf16(p0[r], p0[r + 1]) : pg8::cvt_pk_bf16(p1[r], p1[r + 1]); }
                pf[ks] = __builtin_bit_cast(bf16x8, w); }
#pragma unroll
            for (int dt = 0; dt < 4; ++dt)
#pragma unroll
                for (int ks = 0; ks < 4; ++ks) { const s16x4 lo = trrd(vb + vaddr[0][dt] + 4096 * ks), hh = trrd(vb + vaddr[1][dt] + 4096 * ks);
                    const bf16x8 vf = (bf16x8){lo[0], lo[1], lo[2], lo[3], hh[0], hh[1], hh[2], hh[3]};
                    o[dt] = __builtin_amdgcn_mfma_f32_32x32x16_bf16(vf, pf[ks], o[dt], 0, 0, 0); }
        }
    }
    asm volatile("s_waitcnt lgkmcnt(0)" ::: "memory"); __builtin_amdgcn_s_barrier(); asm volatile("" ::: "memory");
    l += __shfl_xor(l, 32);
    const float inv = 1.f / l;
    LAS float* xch = (LAS float*)(lds + XCH_OFF + wq * 16384);
    if (c == 1) {
#pragma unroll
        for (int dt = 0; dt < 4; ++dt)
#pragma unroll
            for (int r = 0; r < 16; ++r) xch[(dt * 16 + r) * 64 + lane] = o[dt][r] * inv;
    }
    asm volatile("s_waitcnt lgkmcnt(0)" ::: "memory"); __builtin_amdgcn_s_barrier(); asm volatile("" ::: "memory");
    if (c == 0) {
        float ss = 0.f;
#pragma unroll
        for (int dt = 0; dt < 4; ++dt)
#pragma unroll
            for (int r = 0; r < 16; ++r) { const float v = o[dt][r] * inv - lam * xch[(dt * 16 + r) * 64 + lane]; o[dt][r] = v; ss += v * v; }
        ss += __shfl_xor(ss, 32);
        const float rsn = (1.f - LAMBDA_INIT) / sqrtf(ss * (1.f / 128.f) + RMS_EPS);
        bf16_t* orow = (bf16_t*)(F.p.ws + WS_MIX) + (size_t)(b * SEQ + qlo + r32) * D + h * 128;
#pragma unroll
        for (int dt = 0; dt < 4; ++dt)
#pragma unroll
            for (int r4 = 0; r4 < 4; ++r4) { const int dv = 32 * dt + 8 * r4 + 4 * hi; const f32x4 g = *(const f32x4*)(F.p.subln_g + dv);
                u32x2 w; w.x = pg8::cvt_pk_bf16(o[dt][4 * r4] * rsn * g[0], o[dt][4 * r4 + 1] * rsn * g[1]); w.y = pg8::cvt_pk_bf16(o[dt][4 * r4 + 2] * rsn * g[2], o[dt][4 * r4 + 3] * rsn * g[3]);
                *(u32x2*)(orow + dv) = w; }
    }
#undef ATT_DMA
}

__device__ __forceinline__ void attn_phase(Frame& F, int qword) {
    const float* lq = F.p.lam_qk; const int lane = F.lane;
    const float lam = __expf(wave_sum(lq[lane] * lq[64 + lane])) - __expf(wave_sum(lq[128 + lane] * lq[192 + lane])) + LAMBDA_INIT;
    volatile LAS unsigned* qw = (volatile LAS unsigned*)(F.lds + LDSCTL_OFF + 32);
    for (;;) {
        if (F.tid == 0) *qw = __hip_atomic_fetch_add(F.ctl + qword, 1u, __ATOMIC_RELAXED, __HIP_MEMORY_SCOPE_AGENT);
        __syncthreads();
        const unsigned u = (unsigned)__builtin_amdgcn_readfirstlane((int)*qw);
        if (u >= 1024u) break;
        attn_unit(F, (int)(u & 63u), 15 - (int)(u >> 6), lam);
    }
}
}

namespace ml {
typedef short s16x4 __attribute__((ext_vector_type(4)));
constexpr int KI = 0, VI = 32768, CB = 65536, QI = 102400, PC = 135168, CWL = 137728, ML_END = 142848;
constexpr int ROWB = NPROJ * 2;
__device__ __forceinline__ unsigned swz(unsigned row) { return ((row & 3u) << 2) | ((row >> 2) & 3u); }
__device__ __forceinline__ unsigned off_b(unsigned row, unsigned ch) { return 256u * row + 16u * (ch ^ swz(row)); }
__device__ __forceinline__ s16x4 trrd(const LAS unsigned char* p) { return __builtin_bit_cast(s16x4, __builtin_amdgcn_ds_read_tr16_b64_v4i16((LAS s16x4*)p)); }
__device__ __forceinline__ f32x4 mfma16(bf16x8 a, bf16x8 b, f32x4 c) { return __builtin_amdgcn_mfma_f32_16x16x32_bf16(a, b, c, 0, 0, 0); }

__device__ __forceinline__ void conv_load(const bf16_t* src, int t, u32x4 (&raw)[7]) {
#pragma unroll
    for (int jj = 0; jj < 7; ++jj) raw[jj] = *(const u32x4*)(src + (ptrdiff_t)((t - 3 + jj >= 0) ? (jj - 3) : 0) * NPROJ);
}
__device__ __forceinline__ void conv_store(const u32x4 (&raw)[7], int t, const LAS float* cw, const LAS float* cb, int lc, float scale, LAS unsigned char* img, int row0, int pc) {
    f32x4 wt[4][2];
#pragma unroll
    for (int j = 0; j < 4; ++j) { wt[j][0] = *(const LAS f32x4*)(cw + j * 256 + lc); wt[j][1] = *(const LAS f32x4*)(cw + j * 256 + lc + 4); }
    const f32x4 b0 = *(const LAS f32x4*)(cb + lc), b1 = *(const LAS f32x4*)(cb + lc + 4);
    float x[7][8];
#pragma unroll
    for (int jj = 0; jj < 7; ++jj) { const float ok = (t - 3 + jj >= 0) ? 1.f : 0.f;
        x[jj][0] = ok * bf2f(raw[jj].x & 0xffffu); x[jj][1] = ok * bf2f(raw[jj].x >> 16); x[jj][2] = ok * bf2f(raw[jj].y & 0xffffu); x[jj][3] = ok * bf2f(raw[jj].y >> 16);
        x[jj][4] = ok * bf2f(raw[jj].z & 0xffffu); x[jj][5] = ok * bf2f(raw[jj].z >> 16); x[jj][6] = ok * bf2f(raw[jj].w & 0xffffu); x[jj][7] = ok * bf2f(raw[jj].w >> 16); }
#pragma unroll
    for (int rr = 0; rr < 4; ++rr) { float y[8];
#pragma unroll
        for (int e = 0; e < 8; ++e) { float a = (e < 4) ? b0[e & 3] : b1[e & 3];
#pragma unroll
            for (int j = 0; j < 4; ++j) a += ((e < 4) ? wt[j][0][e & 3] : wt[j][1][e & 3]) * x[rr + j][e];
            y[e] = a * scale * __builtin_amdgcn_rcpf(1.f + __expf(-a)); }
        u32x4 w; w.x = pg8::cvt_pk_bf16(y[0], y[1]); w.y = pg8::cvt_pk_bf16(y[2], y[3]); w.z = pg8::cvt_pk_bf16(y[4], y[5]); w.w = pg8::cvt_pk_bf16(y[6], y[7]);
        *(LAS u32x4*)(img + off_b(row0 + rr, pc)) = w; }
}
__device__ __forceinline__ bf16x8 pack8(const float (&v)[8]) { u32x4 w; w.x = pg8::cvt_pk_bf16(v[0], v[1]); w.y = pg8::cvt_pk_bf16(v[2], v[3]); w.z = pg8::cvt_pk_bf16(v[4], v[5]); w.w = pg8::cvt_pk_bf16(v[6], v[7]); return __builtin_bit_cast(bf16x8, w); }

__device__ __forceinline__ void mlstm_unit(Frame& F, int bh) {
    LAS unsigned char* lds = F.lds + RING_OFF;
    const int tid = F.tid, lane = F.lane, w = F.wave; int l15 = lane & 15, g = lane >> 4, q = l15 >> 2, p = lane & 3;
    const int b = bh >> 2, h = bh & 3; const size_t rowb = (size_t)b * SEQ;
    const bf16_t* PROJ = (const bf16_t*)(F.p.ws + WS_PROJ); const float* GATES = (const float*)(F.p.ws + WS_GATES); bf16_t* MIX = (bf16_t*)(F.p.ws + WS_MIX);
    float* gsc = (float*)(F.p.ws + WS_GSC) + (size_t)bh * 3 * SEQ;
    LAS float* pc_u = (LAS float*)(lds + PC); LAS float* pc_sci = pc_u + 128; LAS float* pc_ws = pc_u + 256; LAS float* pc_emr = pc_u + 384; LAS float* pc_a = pc_u + 512;
    LAS float* cw = (LAS float*)(lds + CWL); LAS float* cb = cw + 1024;
    for (int i = tid; i < 36864 / 16; i += 512) *(LAS u32x4*)(lds + CB + 16 * i) = (u32x4){0u, 0u, 0u, 0u};
    for (int i = tid; i < 1024; i += 512) { const int j = i >> 8, lc = i & 255; const int cc = (lc < 128) ? h * 128 + lc : 512 + h * 128 + (lc - 128); cw[i] = F.p.conv_w[j * 1024 + cc]; if (j == 0) cb[lc] = F.p.conv_b[cc]; }
#pragma unroll
    for (int cc2 = 0; cc2 < 2; ++cc2) { const int i0 = (2 * w + cc2) * 128 + 2 * lane;
        const float li0 = GATES[(rowb + i0) * 8 + h], lf0 = GATES[(rowb + i0) * 8 + 4 + h], li1 = GATES[(rowb + i0 + 1) * 8 + h], lf1 = GATES[(rowb + i0 + 1) * 8 + 4 + h];
        float s = lf0 + lf1;
#pragma unroll
        for (int o = 1; o < 64; o <<= 1) { const float y = __shfl_up(s, o); if (lane >= o) s += y; }
        const float b1v = s, b0v = s - lf1, a0 = li0 - b0v, a1 = li1 - b1v;
        float mx = fmaxf(a0, a1);
#pragma unroll
        for (int o = 1; o < 64; o <<= 1) { const float y = __shfl_up(mx, o); if (lane >= o) mx = fmaxf(mx, y); }
        float mprev = __shfl_up(mx, 1); if (lane == 0) mprev = -INFINITY;
        gsc[i0] = b0v; gsc[i0 + 1] = b1v; gsc[SEQ + i0] = a0; gsc[SEQ + i0 + 1] = a1; gsc[2 * SEQ + i0] = fmaxf(mprev, a0); gsc[2 * SEQ + i0 + 1] = mx; }
    __threadfence_block();
    asm volatile("s_waitcnt vmcnt(0)" ::: "memory");
    __syncthreads();
    f32x4 accC[9];
#pragma unroll
    for (int vt = 0; vt < 9; ++vt) accC[vt] = (f32x4){0.f, 0.f, 0.f, 0.f};
    float mcur = 0.f;
    const bf16x8 onesf = (l15 == 0) ? (bf16x8){0x3F80, 0x3F80, 0x3F80, 0x3F80, 0x3F80, 0x3F80, 0x3F80, 0x3F80} : (bf16x8){0, 0, 0, 0, 0, 0, 0, 0};
    const int tq = tid & 127;
    float gb = gsc[tq], gaa = gsc[SEQ + tq], gg = gsc[2 * SEQ + tq], gbl = gsc[127], gge = gsc[2 * SEQ + 127];

#define ML_LAUNDER() asm volatile("" : "+v"(l15), "+v"(g), "+v"(q), "+v"(p))
    u32x4 rawk[7], rawq[7]; u32x2 omr[8];
#define ML_STAGE(CI) do { const int t0_ = (CI) * 128; int tl_ = tid; asm volatile("" : "+v"(tl_)); const int rg = tl_ >> 4, pcc = tl_ & 15, ln_ = tl_ & 63; \
        { const float bL_ = gbl, mnew_ = bL_ + fmaxf(mcur, gge); \
          if (tl_ < 128) { const float bt = gb, mrow = bt + fmaxf(mcur, gg); \
              pc_u[tl_] = bt - mrow; pc_sci[tl_] = __expf(bt + mcur - mrow); pc_ws[tl_] = __expf(bL_ - mnew_ + gaa); pc_emr[tl_] = __expf(-mrow); pc_a[tl_] = gaa; } } \
        { const char* vg = (const char*)(PROJ + (rowb + t0_) * NPROJ + C_VM + h * 128); \
          _Pragma("unroll") for (int n = 0; n < 4; ++n) { const unsigned row_ = 4u * (w + 8 * n) + (ln_ >> 4), slot_ = ln_ & 15; \
              __builtin_amdgcn_global_load_lds((const unsigned*)(vg + row_ * ROWB + ((slot_ ^ swz(row_)) << 4)), (LAS unsigned*)(lds + VI + (w + 8 * n) * 1024), 16, 0, 0); } } \
        { const bf16_t* omp = PROJ + (rowb + t0_ + 16 * w + (ln_ & 15)) * NPROJ + C_OM + h * 128 + 4 * (ln_ >> 4); \
          _Pragma("unroll") for (int vt = 0; vt < 8; ++vt) omr[vt] = *(const u32x2*)(omp + 16 * vt); } \
        conv_store(rawk, t0_ + 4 * rg, cw, cb, 128 + 8 * pcc, 0.08838834764831845f, lds + KI, 4 * rg, pcc); \
        asm volatile("" ::: "memory"); \
        conv_store(rawq, t0_ + 4 * rg, cw, cb, 8 * pcc, 1.f, lds + QI, 4 * rg, pcc); } while (0)
#define ML_RAWLOAD(CI) do { int tl_ = tid; asm volatile("" : "+v"(tl_)); const int rg = tl_ >> 4, pcc = tl_ & 15; const int t_ = (CI) * 128 + 4 * rg; \
        conv_load(PROJ + (rowb + t_) * NPROJ + C_KM + h * 128 + 8 * pcc, t_, rawk); conv_load(PROJ + (rowb + t_) * NPROJ + C_QM + h * 128 + 8 * pcc, t_, rawq); } while (0)
    ML_RAWLOAD(0);
    float mnew = gbl + fmaxf(mcur, gge), sc = __expf(gbl + mcur - mnew);
    ML_STAGE(0);
    { const int n0 = 128; gb = gsc[n0 + tq]; gaa = gsc[SEQ + n0 + tq]; gg = gsc[2 * SEQ + n0 + tq]; gbl = gsc[n0 + 127]; gge = gsc[2 * SEQ + n0 + 127]; }
    for (int ci = 0; ci < 16; ++ci) {
        const int t0 = ci * 128;
        asm volatile("s_waitcnt vmcnt(0) lgkmcnt(0)" ::: "memory"); __builtin_amdgcn_s_barrier(); asm volatile("" ::: "memory");
        ML_LAUNDER();
#define SB() __builtin_amdgcn_sched_barrier(0)
        bf16x8 qf[4], fr[8];
#pragma unroll
        for (int ks = 0; ks < 4; ++ks) qf[ks] = *(const LAS bf16x8*)(lds + QI + off_b(16 * w + l15, 4 * ks + g));
        const float ut = pc_u[16 * w + l15];
#define LDK(buf, ks) do { _Pragma("unroll") for (int st = 0; st < 8; ++st) fr[st] = *(const LAS bf16x8*)(lds + KI + off_b(16 * st + l15, 4 * (ks) + g)); } while (0)
#define LDCB(buf, ks) do { _Pragma("unroll") for (int vt = 0; vt < 8; ++vt) fr[vt] = *(const LAS bf16x8*)(lds + CB + off_b(16 * vt + l15, 4 * (ks) + g)); } while (0)
#define LDV(buf, R0, R1) do { _Pragma("unroll") for (int vt = 0; vt < 8; ++vt) { const s16x4 lo = trrd(lds + VI + off_b((R0) + q, 2 * vt + (p >> 1)) + 8 * (p & 1)), hi = trrd(lds + VI + off_b((R1) + q, 2 * vt + (p >> 1)) + 8 * (p & 1)); \
            fr[vt] = (bf16x8){lo[0], lo[1], lo[2], lo[3], hi[0], hi[1], hi[2], hi[3]}; } } while (0)
        f32x4 sacc[8];
#pragma unroll
        for (int st = 0; st < 8; ++st) sacc[st] = (f32x4){0.f, 0.f, 0.f, 0.f};
#pragma unroll
        for (int ks = 0; ks < 4; ++ks) { LDK(0, ks); SB();
#pragma unroll
            for (int st = 0; st < 8; ++st) sacc[st] = mfma16(fr[st], qf[ks], sacc[st]);
            SB(); }
        bf16x8 smf[4];
#pragma unroll
        for (int i = 0; i < 4; ++i) { float sv[8];
#pragma unroll
            for (int hh = 0; hh < 2; ++hh) { const int st = 2 * i + hh; const f32x4 a4 = *(const LAS f32x4*)(pc_a + 16 * st + 4 * g);
#pragma unroll
                for (int r = 0; r < 4; ++r) { float v = __expf(ut + a4[r]) * sacc[st][r]; if ((16 * st + 4 * g + r) > (16 * w + l15)) v = 0.f; sv[4 * hh + r] = v; } }
            smf[i] = pack8(sv); }
        ML_LAUNDER();
        const float scit = pc_sci[16 * w + l15];
        f32x4 num[9];
#pragma unroll
        for (int vt = 0; vt < 9; ++vt) num[vt] = (f32x4){0.f, 0.f, 0.f, 0.f};
#pragma unroll
        for (int ks = 0; ks < 4; ++ks) { const bf16x8 c8 = *(const LAS bf16x8*)(lds + CB + off_b(128 + l15, 4 * ks + g));
            LDCB(0, ks); SB();
#pragma unroll
            for (int vt = 0; vt < 8; ++vt) num[vt] = mfma16(fr[vt], qf[ks], num[vt]);
            num[8] = mfma16(c8, qf[ks], num[8]); SB(); }
#pragma unroll
        for (int vt = 0; vt < 9; ++vt) num[vt] = num[vt] * scit;
#pragma unroll
        for (int i = 0; i < 4; ++i) { LDV(0, 32 * i + 4 * g, 32 * i + 16 + 4 * g); SB();
#pragma unroll
            for (int vt = 0; vt < 8; ++vt) num[vt] = mfma16(fr[vt], smf[i], num[vt]);
            num[8] = mfma16(onesf, smf[i], num[8]); SB(); }
        { const int t = t0 + 16 * w + l15;
          const float den = __shfl(num[8][0], l15); const float hd = __builtin_amdgcn_rcpf(fmaxf(fabsf(den), pc_emr[16 * w + l15]));
          float ss = 0.f;
#pragma unroll
          for (int vt = 0; vt < 8; ++vt) { const u32x2 ow = omr[vt];
              const float o0 = bf2f(ow.x & 0xffffu), o1 = bf2f(ow.x >> 16), o2 = bf2f(ow.y & 0xffffu), o3 = bf2f(ow.y >> 16);
              f32x4 hv = num[vt] * hd; hv[0] *= __builtin_amdgcn_rcpf(1.f + __expf(-o0)); hv[1] *= __builtin_amdgcn_rcpf(1.f + __expf(-o1)); hv[2] *= __builtin_amdgcn_rcpf(1.f + __expf(-o2)); hv[3] *= __builtin_amdgcn_rcpf(1.f + __expf(-o3));
              num[vt] = hv; ss += (hv[0] * hv[0] + hv[1] * hv[1]) + (hv[2] * hv[2] + hv[3] * hv[3]); }
          ss += __shfl_xor(ss, 16); ss += __shfl_xor(ss, 32);
          const float rs = __builtin_amdgcn_rsqf(ss * (1.f / 128.f) + RMS_EPS);
          bf16_t* op = MIX + (rowb + t) * D + 512 + h * 128 + 4 * g; const float* gp = F.p.mhnorm_g + h * 128 + 4 * g;
#pragma unroll
          for (int vt = 0; vt < 8; ++vt) { const f32x4 gg4 = *(const f32x4*)(gp + 16 * vt); const f32x4 hv = num[vt] * rs * gg4;
              u32x2 ww; ww.x = pg8::cvt_pk_bf16(hv[0], hv[1]); ww.y = pg8::cvt_pk_bf16(hv[2], hv[3]); *(u32x2*)(op + 16 * vt) = ww; } }
        asm volatile("s_waitcnt lgkmcnt(0)" ::: "memory"); __builtin_amdgcn_s_barrier(); asm volatile("" ::: "memory");
        ML_LAUNDER();
        if (ci < 15) ML_RAWLOAD(ci + 1);
        { bf16x8 kf[4];
#pragma unroll
          for (int i = 0; i < 4; ++i) { float kv[8];
#pragma unroll
              for (int t2 = 0; t2 < 2; ++t2) { const s16x4 raw = trrd(lds + KI + off_b(32 * i + 8 * g + 4 * t2 + q, 2 * w + (p >> 1)) + 8 * (p & 1)); const f32x4 w4 = *(const LAS f32x4*)(pc_ws + 32 * i + 8 * g + 4 * t2);
#pragma unroll
                  for (int e = 0; e < 4; ++e) kv[4 * t2 + e] = bf2f((unsigned)(unsigned short)raw[e]) * w4[e]; }
              kf[i] = pack8(kv); }
#pragma unroll
          for (int vt = 0; vt < 9; ++vt) accC[vt] = accC[vt] * sc;
          SB();
#pragma unroll
          for (int i = 0; i < 4; ++i) { LDV(0, 32 * i + 8 * g, 32 * i + 8 * g + 4); SB();
#pragma unroll
              for (int vt = 0; vt < 8; ++vt) accC[vt] = mfma16(kf[i], fr[vt], accC[vt]);
              accC[8] = mfma16(kf[i], onesf, accC[8]); SB(); }
#pragma unroll
          for (int vt = 0; vt < 9; ++vt) { u32x2 ww; ww.x = pg8::cvt_pk_bf16(accC[vt][0], accC[vt][1]); ww.y = pg8::cvt_pk_bf16(accC[vt][2], accC[vt][3]);
              *(LAS u32x2*)(lds + CB + off_b(16 * vt + l15, 2 * w + (g >> 1)) + 8 * (g & 1)) = ww; } }
#undef LDK
#undef LDCB
#undef LDV
#undef SB
        mcur = mnew;
        asm volatile("s_waitcnt lgkmcnt(0)" ::: "memory"); __builtin_amdgcn_s_barrier(); asm volatile("" ::: "memory");
        if (ci < 15) { ML_LAUNDER();
            mnew = gbl + fmaxf(mcur, gge); sc = __expf(gbl + mcur - mnew);
            ML_STAGE(ci + 1);
            if (ci < 14) { const int n0 = t0 + 256; gb = gsc[n0 + tq]; gaa = gsc[SEQ + n0 + tq]; gg = gsc[2 * SEQ + n0 + tq]; gbl = gsc[n0 + 127]; gge = gsc[2 * SEQ + n0 + 127]; } }
    }
#undef ML_STAGE
#undef ML_RAWLOAD
}
}

namespace rt {
constexpr int WROW = 2064;
constexpr int LOGI_OFF = 100352, HIST_OFF = 124928;
__device__ __forceinline__ void router_phase(Frame& F) {
    const Ptrs& p = F.p; LAS unsigned char* lds = F.lds + RING_OFF;
    const int tid = F.tid, lane = F.lane, w = F.wave, l15 = lane & 15, g = lane >> 4;
    const bf16_t* WR = (const bf16_t*)(p.ws + WS_WR); const bf16_t* X1B = (const bf16_t*)(p.ws + WS_X1B);
    int* list = (int*)(p.ws + WS_LIST); float* tokw = (float*)(p.ws + WS_TOKW); float* rstd_o = (float*)(p.ws + WS_RSTD);
    LAS int* hist = (LAS int*)(lds + HIST_OFF); LAS int* base = hist + 32;
    LAS float* lg = (LAS float*)(lds + LOGI_OFF + w * 3072);
    for (int i = tid; i < 48 * 128; i += 512) { const int row = i >> 7, ch = i & 127; *(LAS u32x4*)(lds + row * WROW + ch * 16) = *(const u32x4*)(WR + row * 1024 + ch * 8); }
    for (int blk = F.vcu; blk < T / 128; blk += F.G) {
        if (tid < 32) hist[tid] = 0;
        __syncthreads();
        const int row0 = blk * 128 + 16 * w;
        f32x4 acc[3]; float ss = 0.f;
#pragma unroll
        for (int ct = 0; ct < 3; ++ct) acc[ct] = (f32x4){0.f, 0.f, 0.f, 0.f};
        const bf16_t* ap = X1B + (size_t)(row0 + l15) * D + 8 * g;
#pragma unroll 4
        for (int ks = 0; ks < 32; ++ks) { const bf16x8 a = *(const bf16x8*)(ap + 32 * ks);
#pragma unroll
            for (int e = 0; e < 8; ++e) { const float v = bf2f((unsigned)(unsigned short)a[e]); ss += v * v; }
#pragma unroll
            for (int ct = 0; ct < 3; ++ct) acc[ct] = __builtin_amdgcn_mfma_f32_16x16x32_bf16(a, *(const LAS bf16x8*)(lds + (16 * ct + l15) * WROW + (32 * ks + 8 * g) * 2), acc[ct], 0, 0, 0); }
        ss += __shfl_xor(ss, 16); ss += __shfl_xor(ss, 32);
        const float rstd = 1.f / sqrtf(ss * (1.f / D) + RMS_EPS);
#pragma unroll
        for (int ct = 0; ct < 3; ++ct)
#pragma unroll
            for (int r = 0; r < 4; ++r) lg[(4 * g + r) * 48 + 16 * ct + l15] = acc[ct][r];
        asm volatile("s_waitcnt lgkmcnt(0)" ::: "memory");
        int ea = 0, eb = 0, ra = 0, rb = 0; float w0 = 0.f, w1 = 0.f; const int tok = row0 + lane;
        if (lane < 16) {
            const LAS float* ll = lg + lane * 48;
            float gl[4];
#pragma unroll
            for (int j = 0; j < 4; ++j) gl[j] = ll[j] * rstd + p.b_grp[j];
            int gs = 0; float gm = gl[0];
#pragma unroll
            for (int j = 1; j < 4; ++j) if (gl[j] > gm) { gm = gl[j]; gs = j; }
            float gsum = 0.f;
#pragma unroll
            for (int j = 0; j < 4; ++j) gsum += __expf(gl[j] - gm);
            const float gwt = 1.f / gsum;
            float el[8];
#pragma unroll
            for (int e = 0; e < 8; ++e) el[e] = ll[4 + gs * 8 + e] * rstd + p.b_er[gs * 8 + e];
            int i0 = 0; float v0 = el[0];
#pragma unroll
            for (int e = 1; e < 8; ++e) if (el[e] > v0) { v0 = el[e]; i0 = e; }
            int i1 = 0; float v1 = -INFINITY;
#pragma unroll
            for (int e = 0; e < 8; ++e) if (e != i0 && el[e] > v1) { v1 = el[e]; i1 = e; }
            const float e1 = __expf(v1 - v0); w0 = gwt / (1.f + e1); w1 = gwt * e1 / (1.f + e1);
            ea = gs * 8 + i0; eb = gs * 8 + i1;
            ra = __hip_atomic_fetch_add(hist + ea, 1, __ATOMIC_RELAXED, __HIP_MEMORY_SCOPE_WORKGROUP);
            rb = __hip_atomic_fetch_add(hist + eb, 1, __ATOMIC_RELAXED, __HIP_MEMORY_SCOPE_WORKGROUP);
            rstd_o[tok] = rstd;
        }
        __syncthreads();
        if (tid < 32) base[tid] = (int)__hip_atomic_fetch_add(F.ctl + CW_CNT + 64 * tid, (unsigned)hist[tid], __ATOMIC_RELAXED, __HIP_MEMORY_SCOPE_AGENT);
        __syncthreads();
        if (lane < 16) {
            list[(size_t)ea * LIST_CAP + base[ea] + ra] = tok * 2; list[(size_t)eb * LIST_CAP + base[eb] + rb] = tok * 2 + 1;
            tokw[tok * 2] = w0; tokw[tok * 2 + 1] = w1; }
        __syncthreads();
    }
}
}
#ifndef PROBE_FLAGS
#define PROBE_FLAGS 1
#endif
#ifndef PROBE_REP
#define PROBE_REP -1
#endif
struct Args { Ptrs p; int ph_lo, ph_hi, rep, li; };
constexpr int N_PHASES = 8;
__global__ void __launch_bounds__(NWAVES * 64, 2) mk_fwd(Args args) {
    extern __shared__ __attribute__((aligned(16))) unsigned char lds_raw[];
    Frame F;
    F.lds = (LAS unsigned char*)lds_raw; F.p = args.p;
    F.tid = threadIdx.x; F.lane = F.tid & 63; F.wave = __builtin_amdgcn_readfirstlane(F.tid >> 6);
    F.G = gridDim.x; { const int bx = blockIdx.x; F.vcu = (F.G % 8 == 0) ? (bx % 8) * (F.G / 8) + bx / 8 : bx; }
    F.ctl = (unsigned*)(args.p.ws + WS_CTL);
    for (int u = F.tid; u < (LDS_BYTES - LDSCTL_OFF) / 4; u += NWAVES * 64) ((LAS unsigned*)(F.lds + LDSCTL_OFF))[u] = 0u;
    __syncthreads();
    XcdBarrier bar = xcd_barrier_post(F.ctl + CW_BAR + args.li * XCD_BAR_WORDS, (volatile LAS unsigned*)(F.lds + MISC_OFF) + 8);
    const int lo = args.ph_lo, hi = args.ph_hi;
    unsigned char* ws = args.p.ws;
#define IN(k) (lo <= (k) && (k) < hi)
#define SEAM(k) do { if (IN(k) && IN((k) + 1)) xcd_barrier(bar); } while (0)
#define PH1 { pg8::StaticOrder S; S.init(ws + WS_HB, ws + WS_WIN, T, NPROJ, D, F.G, (int)blockIdx.x); const float* cs = (const float*)(ws + WS_ROPE); \
        pg8::EpiProj E{(bf16_t*)(ws + WS_PROJ), cs, cs + 2048 * 32}; pg8::gemm_phase<pg8::EpiProj, pg8::StaticOrder, true, false>(F.lds + RING_OFF, D, S, E); }
#define PH2(rep) { if (blockIdx.x < BATCH * 4 && !((rep) & 2)) { ml::mlstm_unit(F, (int)blockIdx.x); __syncthreads(); } if (!((rep) & 4)) att::attn_phase(F, CW_QATT + 64 * ((rep) & 1)); }
#define PH3 { pg8::StaticOrder S; S.init(ws + WS_MIX, ws + WS_WOUT, T, D, D, F.G, (int)blockIdx.x); pg8::EpiOut E{F.p.x, (bf16_t*)(ws + WS_X1B)}; \
        pg8::gemm_phase<pg8::EpiOut, pg8::StaticOrder, true, false>(F.lds + RING_OFF, D, S, E); }
#define PH5 { moe_tables(F); \
        pg8::MoeOrder S{(const LAS int*)(F.lds + TAB_OFF), F.G, F.vcu, (const char*)(ws + WS_X1B), (const char*)(ws + WS_W13), (size_t)1024 * 1024 * 2, (size_t)256 * 1024 * 2, 0, true, (const int*)(ws + WS_LIST), D}; \
        pg8::EpiUp E{(bf16_t*)(ws + WS_HD), (const float*)(ws + WS_RSTD), (const int*)(ws + WS_LIST)}; pg8::gemm_phase<pg8::EpiUp, pg8::MoeOrder, true, true>(F.lds + RING_OFF, D, S, E); }
#define PH6 { moe_tables(F); \
        pg8::MoeOrder S{(const LAS int*)(F.lds + TAB_OFF), F.G, F.vcu, (const char*)(ws + WS_HD), (const char*)(ws + WS_W2), (size_t)1024 * 512 * 2, (size_t)256 * 512 * 2, (size_t)DE * 2, false, (const int*)(ws + WS_LIST), DE}; \
        pg8::EpiDown E{(bf16_t*)(ws + WS_Y), (const float*)(ws + WS_TOKW), (const int*)(ws + WS_LIST)}; pg8::gemm_phase<pg8::EpiDown, pg8::MoeOrder, true, false>(F.lds + RING_OFF, DE, S, E); }

    if (IN(0)) p0_prologue(F);
    SEAM(0);
    if (IN(1)) PH1;
    SEAM(1);
    if (IN(2)) PH2(args.rep);
    SEAM(2);
    if (IN(3)) PH3;
    SEAM(3);
    if (IN(4)) rt::router_phase(F);
    SEAM(4);
    if (IN(5)) PH5;
    SEAM(5);
    if (IN(6)) PH6;
    SEAM(6);
    if (IN(7)) final_body(F);
#undef IN
#undef SEAM
}

extern "C" void kernel_launch(void* const* d_in, const int* in_sizes, int n_in, void* d_out, int out_size, void* d_ws, size_t ws_size, hipStream_t stream) {
    static int grid = 0;
    if (grid == 0) {
        if (n_in != 19 || out_size != T * D || ws_size < WS_END) { fprintf(stderr, "kernel_launch: unexpected shapes (n_in %d out %d ws %zu)\n", n_in, out_size, ws_size); grid = -1; return; }
        int dev = 0, cus = 0, per_cu = 0;
        if (hipGetDevice(&dev) != hipSuccess || hipDeviceGetAttribute(&cus, hipDeviceAttributeMultiprocessorCount, dev) != hipSuccess) { grid = -1; return; }
        if (hipFuncSetAttribute((const void*)mk_fwd, hipFuncAttributeMaxDynamicSharedMemorySize, LDS_BYTES) != hipSuccess) { fprintf(stderr, "kernel_launch: hipFuncSetAttribute failed\n"); grid = -1; return; }
        if (hipOccupancyMaxActiveBlocksPerMultiprocessor(&per_cu, (const void*)mk_fwd, NWAVES * 64, LDS_BYTES) != hipSuccess || per_cu < 1) { fprintf(stderr, "kernel_launch: occupancy query says %d\n", per_cu); }
        (void)hipGetLastError();
        grid = cus;
    }
    if (grid < 0) return;
    Args a{};
    Ptrs& p = a.p;
    p.x = (const float*)d_in[0]; p.w_in = (const float*)d_in[1]; p.conv_w = (const float*)d_in[2]; p.conv_b = (const float*)d_in[3]; p.gate_b = (const float*)d_in[4];
    p.lam_qk = (const float*)d_in[5]; p.subln_g = (const float*)d_in[6]; p.mhnorm_g = (const float*)d_in[7]; p.w_out = (const float*)d_in[8]; p.g_mix = (const float*)d_in[9];
    p.g_ffn = (const float*)d_in[10]; p.w_grp = (const float*)d_in[11]; p.b_grp = (const float*)d_in[12]; p.w_er = (const float*)d_in[13]; p.b_er = (const float*)d_in[14];
    p.w1 = (const float*)d_in[15]; p.w3 = (const float*)d_in[16]; p.w2 = (const float*)d_in[17]; p.g_final = (const float*)d_in[18];
    p.out = (float*)d_out; p.ws = (unsigned char*)d_ws;
    if (hipMemsetAsync((char*)d_ws + WS_CTL, 0, CTL_ZERO_BYTES, stream) != hipSuccess) return;
#if PROBE_REP >= 0
    const int cuts[4] = {0, PROBE_REP + 1, PROBE_REP + 1, N_PHASES};
    for (int li = 0; li < 3; ++li) { a.ph_lo = (li == 1) ? PROBE_REP : cuts[li]; a.ph_hi = cuts[li + 1]; a.rep = (li == 1) ? PROBE_FLAGS : 0; a.li = li;
        hipLaunchKernelGGL(mk_fwd, dim3(grid), dim3(NWAVES * 64), LDS_BYTES, stream, a); }
#else
    a.ph_lo = 0; a.ph_hi = N_PHASES; a.rep = 0; a.li = 0;
    hipLaunchKernelGGL(mk_fwd, dim3(grid), dim3(NWAVES * 64), LDS_BYTES, stream, a);
#endif
}
```

```cpp
#include <hip/hip_runtime.h>
#include <cstdio>
#include <cstdint>
#include <type_traits>

constexpr int BATCH = 16, SEQ = 2048, D = 1024, T = BATCH * SEQ;
constexpr int DIN = 3592, NPROJ = 3584;
constexpr int C_QA = 0, C_KA = 512, C_VA = 1024, C_QM = 1536, C_KM = 2048, C_VM = 2560, C_OM = 3072, C_IG = 3584, C_FG = 3588;
constexpr int NE = 32, EPG = 8, DE = 512;
constexpr float RMS_EPS = 1e-6f;
constexpr float LAMBDA_INIT = 0.2f;
constexpr float C2Q = 0.125f * 1.4426950408889634f;
constexpr int LIST_CAP = T;

constexpr size_t MiB = 1u << 20;
constexpr size_t WS_CTL = 0, CTL_ZERO_BYTES = 1 * MiB;
constexpr size_t WS_ROPE = 1 * MiB;
constexpr size_t WS_TOKW = 2 * MiB;
constexpr size_t WS_RSTD = 2 * MiB + 512 * 1024;
constexpr size_t WS_WR = 3 * MiB;
constexpr size_t WS_GSC = 468 * MiB;
constexpr size_t WS_LIST = 4 * MiB;
constexpr size_t WS_SBIN = 9 * MiB;
constexpr size_t WS_SB13 = 9 * MiB + 64 * 1024;
constexpr size_t WS_SA = 9 * MiB + 256 * 1024;
constexpr size_t WS_SX = 9 * MiB + 512 * 1024;
constexpr size_t WS_GATES = 8 * MiB;
constexpr size_t WS_WIN = 10 * MiB;
constexpr size_t WS_WOUT = 17 * MiB;
constexpr size_t WS_W13 = 20 * MiB;
constexpr size_t WS_W2 = 84 * MiB;
constexpr size_t WS_PROJ = 116 * MiB;
constexpr size_t WS_MIX = 340 * MiB;
constexpr size_t WS_X1B = 404 * MiB;
constexpr size_t WS_HB = 404 * MiB;
constexpr size_t WS_HD = 116 * MiB;
constexpr size_t WS_Y = 188 * MiB;
constexpr size_t WS_X1Q = 470 * MiB;
constexpr size_t WS_END = 502 * MiB;
constexpr int CW_TMO = 0, CW_CODE = 1;
constexpr int CW_CNT = 1024;
constexpr int CW_BAR = 4096;
constexpr int CW_QATT = 16384;
constexpr int CW_CMAX_IN = 32768, CW_CMAX_13 = 40960;
#ifndef Q8_PROJ
#define Q8_PROJ 1
#endif
#ifndef Q8_UP
#define Q8_UP 1
#endif

#define LAS __attribute__((address_space(3)))
typedef unsigned short bf16_t;
typedef short bf16x8 __attribute__((ext_vector_type(8)));
typedef float f32x4 __attribute__((ext_vector_type(4)));
typedef unsigned u32x4 __attribute__((ext_vector_type(4)));
typedef unsigned u32x2 __attribute__((ext_vector_type(2)));
typedef int i32x4 __attribute__((ext_vector_type(4)));

__device__ __forceinline__ unsigned f2bf(float f) { unsigned u = __float_as_uint(f); return (u + 0x7fffu + ((u >> 16) & 1u)) >> 16; }
__device__ __forceinline__ unsigned pk2(float lo, float hi) { return f2bf(lo) | (f2bf(hi) << 16); }
__device__ __forceinline__ float bf2f(unsigned b) { return __uint_as_float(b << 16); }
__device__ __forceinline__ float wave_sum(float v) {
#pragma unroll
    for (int o = 1; o < 64; o <<= 1) v += __shfl_xor(v, o);
    return v;
}
__device__ __forceinline__ float sigmoidf_(float x) { return 1.f / (1.f + __expf(-x)); }

struct MapId { __device__ __forceinline__ int operator()(int n) const { return n; } };
struct MapRope {
    __device__ __forceinline__ int operator()(int c) const { if (c >= 1024) return c; const int g = c & ~63, d = c & 63; return g + 8 * ((d & 31) >> 2) + 4 * (d >> 5) + (d & 3); } };
struct MapW1 { __device__ __forceinline__ int operator()(int c) const { return 256 * (c >> 7) + (c & 127); } };
struct MapW3 { __device__ __forceinline__ int operator()(int c) const { return 256 * (c >> 7) + 128 + (c & 127); } };
__device__ __forceinline__ void tile_load(const float* W, int ldw, int k0, int n0, const float* kscale, LAS float* scr, int lane) {
    const int c4 = lane & 7, kr = lane >> 3; f32x4 v[8];
#pragma unroll
    for (int i = 0; i < 8; ++i) v[i] = *(const f32x4*)(W + (size_t)(k0 + 8 * i + kr) * ldw + n0 + 4 * c4);
#pragma unroll
    for (int i = 0; i < 8; ++i) { const int kk = 8 * i + kr; const float ks = kscale ? kscale[k0 + kk] : 1.f; LAS float* d = scr + kk * 33 + 4 * c4; d[0] = v[i][0] * ks; d[1] = v[i][1] * ks; d[2] = v[i][2] * ks; d[3] = v[i][3] * ks; }
    asm volatile("s_waitcnt vmcnt(0) lgkmcnt(0)" ::: "memory");
}
template <class Map>
__device__ __forceinline__ void transpose_item(const float* W, int ldw, bf16_t* WT, int K, int k0, int n0, const Map& map, const float* kscale, LAS float* scr, int lane) {
    tile_load(W, ldw, k0, n0, kscale, scr, lane);
    const int c = lane & 7;
#pragma unroll
    for (int j = 0; j < 4; ++j) { const int n = (lane >> 3) + 8 * j; const LAS float* s = scr + (8 * c) * 33 + n;
        u32x4 o; o.x = pk2(s[0 * 33], s[1 * 33]); o.y = pk2(s[2 * 33], s[3 * 33]); o.z = pk2(s[4 * 33], s[5 * 33]); o.w = pk2(s[6 * 33], s[7 * 33]);
        *(u32x4*)(WT + (size_t)map(n0 + n) * K + k0 + 8 * c) = o; }
    asm volatile("s_waitcnt lgkmcnt(0)" ::: "memory");
}

template <class Map>
__device__ __forceinline__ void colmax_item(const float* W, int ldw, int k0, int nk, int n0, const Map& map, const float* kscale, unsigned* cmax, int lane) {
    const int c4 = lane & 7, kr = lane >> 3; f32x4 mx = (f32x4){0.f, 0.f, 0.f, 0.f};
    for (int kb = 0; kb < nk; kb += 64) { f32x4 v[8];
#pragma unroll
        for (int i = 0; i < 8; ++i) v[i] = *(const f32x4*)(W + (size_t)(k0 + kb + 8 * i + kr) * ldw + n0 + 4 * c4);
#pragma unroll
        for (int i = 0; i < 8; ++i) { const float ks = kscale ? fabsf(kscale[k0 + kb + 8 * i + kr]) : 1.f;
            mx[0] = fmaxf(mx[0], fabsf(v[i][0]) * ks); mx[1] = fmaxf(mx[1], fabsf(v[i][1]) * ks); mx[2] = fmaxf(mx[2], fabsf(v[i][2]) * ks); mx[3] = fmaxf(mx[3], fabsf(v[i][3]) * ks); } }
#pragma unroll
    for (int o = 8; o < 64; o <<= 1) { mx[0] = fmaxf(mx[0], __shfl_xor(mx[0], o)); mx[1] = fmaxf(mx[1], __shfl_xor(mx[1], o)); mx[2] = fmaxf(mx[2], __shfl_xor(mx[2], o)); mx[3] = fmaxf(mx[3], __shfl_xor(mx[3], o)); }
    if (lane < 8) {
#pragma unroll
        for (int i = 0; i < 4; ++i) __hip_atomic_fetch_max(cmax + map(n0 + 4 * c4 + i), __float_as_uint(mx[i]), __ATOMIC_RELAXED, __HIP_MEMORY_SCOPE_AGENT); }
}
__device__ __forceinline__ unsigned q8(float v) { return (unsigned)(int)__builtin_rintf(v) & 0xffu; }
template <class Map>
__device__ __forceinline__ void transpose_item_q8(const float* W, int ldw, signed char* WT, int K, int k0, int n0, const Map& map, const float* kscale, unsigned* cmax, float* sb, bool write_sb, LAS float* scr, int lane) {
    tile_load(W, ldw, k0, n0, kscale, scr, lane);
    const int cq = lane & 3;
#pragma unroll
    for (int j = 0; j < 2; ++j) { const int n = (lane >> 2) + 16 * j; const int dr = map(n0 + n); const float mxv = __uint_as_float(__hip_atomic_load(cmax + dr, __ATOMIC_RELAXED, __HIP_MEMORY_SCOPE_AGENT)); const float inv = mxv > 0.f ? 127.f / mxv : 0.f;
        const LAS float* s = scr + (16 * cq) * 33 + n; u32x4 o;
#pragma unroll
        for (int d = 0; d < 4; ++d) o[d] = q8(s[(4 * d) * 33] * inv) | (q8(s[(4 * d + 1) * 33] * inv) << 8) | (q8(s[(4 * d + 2) * 33] * inv) << 16) | (q8(s[(4 * d + 3) * 33] * inv) << 24);
        *(u32x4*)(WT + (size_t)dr * K + k0 + 16 * cq) = o;
        if (write_sb && cq == 0) sb[dr] = mxv * (1.f / 127.f); }
    asm volatile("s_waitcnt lgkmcnt(0)" ::: "memory");
}

struct Ptrs {
    const float *x, *w_in, *conv_w, *conv_b, *gate_b, *lam_qk, *subln_g, *mhnorm_g, *w_out, *g_mix, *g_ffn, *w_grp, *b_grp, *w_er, *b_er, *w1, *w3, *w2, *g_final;
    float* out; unsigned char* ws;
};


namespace pg8 {
#define PG8_LAS __attribute__((address_space(3)))
constexpr int BM = 256, BK = 64, HALF = 128, HTB = HALF * BK * 2, STAGE_BYTES = 8 * HTB, NXCD = 8, WGM = 8;
__host__ __device__ __forceinline__ int lds_byte(int r, int c) { const int st = (r >> 4) * 2 + (c >> 5), rr = r & 15, cc = c & 31, ob = rr * 64 + cc * 2; return st * 1024 + (ob ^ (((ob >> 9) & 1) << 5)); }
__host__ __device__ __forceinline__ void stage_rc(int b, int& R, int& C) { const int st = b / 1024, sb = b % 1024, swz = sb ^ (((sb >> 9) & 1) << 5); R = (st >> 1) * 16 + swz / 64; C = (st & 1) * 32 + (swz % 64) / 2; }
__host__ __device__ __forceinline__ int perm32(int rho) { const int n = rho >> 4, i = rho & 15; return 8 * (i >> 2) + 4 * n + (i & 3); }

struct Unit { int pm, pn; const char* a; const char* b; int e, cnt, ps; };

struct StaticOrder {
    int nM, nN, nwg, G, c; const char* A; const char* Bt; size_t tstep;
    __device__ void init(const void* A_, const void* Bt_, int M, int N, int Kb, int G_, int c_) { A = (const char*)A_; Bt = (const char*)Bt_; nM = M / BM; nN = N / BM; nwg = nM * nN; G = G_; c = c_; tstep = (size_t)BM * Kb; }
    __device__ bool next(int i, Unit& u) const {
        const long L = (long)i * G + c; if (L >= nwg) return false;
        int wgid = (int)L; { const int q = nwg / NXCD, r = nwg % NXCD, xcd = wgid % NXCD, off = wgid / NXCD; wgid = (xcd < r ? xcd * (q + 1) : r * (q + 1) + (xcd - r) * q) + off; }
        const int nig = WGM * nN, gid = wgid / nig, fm = gid * WGM, gsz = (nM - fm) < WGM ? (nM - fm) : WGM;
        u.pm = fm + ((wgid % nig) % gsz); u.pn = (wgid % nig) / gsz; u.a = A + (size_t)u.pm * tstep; u.b = Bt + (size_t)u.pn * tstep; u.e = 0; u.cnt = 0; u.ps = 0; return true;
    }
    __device__ __forceinline__ unsigned row_off(const Unit&, int) const { return 0u; }
};
struct MoeOrder {
    const PG8_LAS int* tab; int G, vcu; const char* A; const char* Bt; size_t bstep_e, bstep_n, astep; bool gather; const int* list; int Kb;
    __device__ bool next(int i, Unit& u) const {
        const int L = i * G + vcu; if (L >= tab[32]) return false;
        int e = 0;
#pragma unroll 1
        for (int j = 1; j < 32; ++j) e = (L >= tab[j]) ? j : e;
        const int loc = L - tab[e]; u.e = e; u.pn = loc & 3; u.pm = loc >> 2; u.cnt = tab[128 + e]; u.ps = tab[64 + e];
        u.b = Bt + (size_t)e * bstep_e + (size_t)u.pn * bstep_n;
        u.a = gather ? A : A + (size_t)(u.ps + u.pm * BM) * astep;
        return true;
    }
    __device__ __forceinline__ unsigned row_off(const Unit& u, int r) const {
        const int s = u.pm * BM + r; const int a = (s < u.cnt) ? list[(size_t)u.e * LIST_CAP + s] : 0; return (unsigned)(a >> 1) * (unsigned)Kb;
    }
};

typedef float f32x2_t __attribute__((ext_vector_type(2))); typedef __bf16 bf16x2_t __attribute__((ext_vector_type(2)));
__device__ __forceinline__ unsigned cvt_pk_bf16(float lo, float hi) { const f32x2_t v = {lo, hi}; const bf16x2_t b = __builtin_convertvector(v, bf16x2_t); return __builtin_bit_cast(unsigned, b); }

template <bool Q> struct EpiProj {
    static constexpr bool PERM = true; typedef typename std::conditional<Q, i32x4, f32x4>::type acc_t;
    bf16_t* O; const float* cs; const float* sn; const float* sa; const float* sb;
    __device__ __forceinline__ f32x4 deq(const acc_t& a, float ra, const f32x4& cb) const { if constexpr (Q) return (f32x4){(float)a[0], (float)a[1], (float)a[2], (float)a[3]} * ra * cb; else return a; }
    __device__ __forceinline__ void operator()(const acc_t (&acc)[2][2][4][2], const Unit& u, int wr, int wc, int fr, int fq) const {
        const int row0 = u.pm * BM + wr * 64 + fr, colt = u.pn * BM, col0 = colt + wc * 32 + 8 * fq;
        f32x4 cb[2][2];
#pragma unroll
        for (int bj = 0; bj < 2; ++bj)
#pragma unroll
            for (int n = 0; n < 2; ++n) cb[bj][n] = Q ? *(const f32x4*)(sb + col0 + bj * HALF + 4 * n) : (f32x4){1.f, 1.f, 1.f, 1.f};
        if (u.pn < 4) {
            const float sc = (u.pn < 2) ? C2Q : 1.f; const int q8 = 4 * (wc & 1) + fq;
#pragma unroll
            for (int ai = 0; ai < 2; ++ai)
#pragma unroll
                for (int m = 0; m < 4; ++m) { const int row = row0 + ai * HALF + m * 16, pos = row & (SEQ - 1); const float ra = Q ? sa[row] : 1.f;
                    const f32x4 c4 = *(const f32x4*)(cs + pos * 32 + 4 * q8) * sc, s4 = *(const f32x4*)(sn + pos * 32 + 4 * q8) * sc;
                    bf16_t* rowp = O + (size_t)row * NPROJ + colt + 64 * (wc >> 1) + 4 * q8;
#pragma unroll
                    for (int bj = 0; bj < 2; ++bj) { const f32x4 x1 = deq(acc[ai][bj][m][0], ra, cb[bj][0]), x2 = deq(acc[ai][bj][m][1], ra, cb[bj][1]); const f32x4 o1 = x1 * c4 - x2 * s4, o2 = x1 * s4 + x2 * c4;
                        u32x2 w1, w2; w1.x = cvt_pk_bf16(o1[0], o1[1]); w1.y = cvt_pk_bf16(o1[2], o1[3]); w2.x = cvt_pk_bf16(o2[0], o2[1]); w2.y = cvt_pk_bf16(o2[2], o2[3]);
                        *(u32x2*)(rowp + bj * HALF) = w1; *(u32x2*)(rowp + bj * HALF + 32) = w2; } }
        } else {
#pragma unroll
            for (int ai = 0; ai < 2; ++ai)
#pragma unroll
                for (int m = 0; m < 4; ++m) { const int row = row0 + ai * HALF + m * 16; const float ra = Q ? sa[row] : 1.f; bf16_t* rowp = O + (size_t)row * NPROJ + col0;
#pragma unroll
                    for (int bj = 0; bj < 2; ++bj) { const f32x4 v0 = deq(acc[ai][bj][m][0], ra, cb[bj][0]), v1 = deq(acc[ai][bj][m][1], ra, cb[bj][1]);
                        u32x4 w; w.x = cvt_pk_bf16(v0[0], v0[1]); w.y = cvt_pk_bf16(v0[2], v0[3]); w.z = cvt_pk_bf16(v1[0], v1[1]); w.w = cvt_pk_bf16(v1[2], v1[3]);
                        *(u32x4*)(rowp + bj * HALF) = w; } }
        }
    }
};
struct EpiOut { typedef f32x4 acc_t;
    static constexpr bool PERM = true;
    const float* x; bf16_t* X1B;
    __device__ __forceinline__ void operator()(const acc_t (&acc)[2][2][4][2], const Unit& u, int wr, int wc, int fr, int fq) const {
        const int row0 = u.pm * BM + wr * 64 + fr, col0 = u.pn * BM + wc * 32 + 8 * fq;
#pragma unroll
        for (int ai = 0; ai < 2; ++ai)
#pragma unroll
            for (int m = 0; m < 4; ++m) { const size_t off = (size_t)(row0 + ai * HALF + m * 16) * D + col0;
#pragma unroll
                for (int bj = 0; bj < 2; ++bj) { const f32x4 v0 = acc[ai][bj][m][0] + *(const f32x4*)(x + off + bj * HALF), v1 = acc[ai][bj][m][1] + *(const f32x4*)(x + off + bj * HALF + 4);
                    u32x4 w; w.x = cvt_pk_bf16(v0[0], v0[1]); w.y = cvt_pk_bf16(v0[2], v0[3]); w.z = cvt_pk_bf16(v1[0], v1[1]); w.w = cvt_pk_bf16(v1[2], v1[3]);
                    *(u32x4*)(X1B + off + bj * HALF) = w; }
                asm volatile("" ::: "memory"); }
    }
};
template <bool Q> struct EpiUp {
    static constexpr bool PERM = true; typedef typename std::conditional<Q, i32x4, f32x4>::type acc_t;
    bf16_t* HD; const float* rstd; const int* list; const float* sx; const float* sb;
    __device__ __forceinline__ void operator()(const acc_t (&acc)[2][2][4][2], const Unit& u, int wr, int wc, int fr, int fq) const {
        const int r0 = u.pm * BM + wr * 64 + fr, col0 = u.pn * HALF + wc * 32 + 8 * fq;
        f32x4 cb[2][2];
#pragma unroll
        for (int bj = 0; bj < 2; ++bj)
#pragma unroll
            for (int n = 0; n < 2; ++n) cb[bj][n] = Q ? *(const f32x4*)(sb + (size_t)u.e * 1024 + u.pn * BM + bj * HALF + wc * 32 + 8 * fq + 4 * n) : (f32x4){1.f, 1.f, 1.f, 1.f};
#pragma unroll
        for (int ai = 0; ai < 2; ++ai)
#pragma unroll
            for (int m = 0; m < 4; ++m) { const int s = r0 + ai * HALF + m * 16; if (s < u.cnt) { const int tok = list[(size_t)u.e * LIST_CAP + s] >> 1; const float rs = rstd[tok] * (Q ? sx[tok] : 1.f);
                    float h[8];
#pragma unroll
                    for (int n = 0; n < 2; ++n)
#pragma unroll
                        for (int i = 0; i < 4; ++i) { const float a = (float)acc[ai][0][m][n][i] * rs * cb[0][n][i], b = (float)acc[ai][1][m][n][i] * rs * cb[1][n][i]; h[4 * n + i] = a * b * __builtin_amdgcn_rcpf(1.f + __expf(-a)); }
                    u32x4 w; w.x = cvt_pk_bf16(h[0], h[1]); w.y = cvt_pk_bf16(h[2], h[3]); w.z = cvt_pk_bf16(h[4], h[5]); w.w = cvt_pk_bf16(h[6], h[7]);
                    *(u32x4*)(HD + (size_t)(u.ps + s) * DE + col0) = w; } }
    }
};
struct EpiDown { typedef f32x4 acc_t;
    static constexpr bool PERM = true;
    bf16_t* Y; const float* tokw; const int* list;
    __device__ __forceinline__ void operator()(const acc_t (&acc)[2][2][4][2], const Unit& u, int wr, int wc, int fr, int fq) const {
        const int r0 = u.pm * BM + wr * 64 + fr, col0 = u.pn * BM + wc * 32 + 8 * fq;
#pragma unroll
        for (int ai = 0; ai < 2; ++ai)
#pragma unroll
            for (int m = 0; m < 4; ++m) { const int s = r0 + ai * HALF + m * 16; if (s < u.cnt) { const int a = list[(size_t)u.e * LIST_CAP + s]; const float w8 = tokw[a];
                    bf16_t* rowp = Y + (size_t)a * D + col0;
#pragma unroll
                    for (int bj = 0; bj < 2; ++bj) { const f32x4 v0 = acc[ai][bj][m][0] * w8, v1 = acc[ai][bj][m][1] * w8;
                        u32x4 w; w.x = cvt_pk_bf16(v0[0], v0[1]); w.y = cvt_pk_bf16(v0[2], v0[3]); w.z = cvt_pk_bf16(v1[0], v1[1]); w.w = cvt_pk_bf16(v1[2], v1[3]);
                        *(u32x4*)(rowp + bj * HALF) = w; } } }
    }
};

__device__ __forceinline__ f32x4 mma16(bf16x8 a, bf16x8 b, f32x4 c) { return __builtin_amdgcn_mfma_f32_16x16x32_bf16(a, b, c, 0, 0, 0); }
__device__ __forceinline__ i32x4 mma16(bf16x8 a, bf16x8 b, i32x4 c) { return __builtin_amdgcn_mfma_i32_16x16x64_i8(__builtin_bit_cast(i32x4, a), __builtin_bit_cast(i32x4, b), c, 0, 0, 0); }
template <class Epi, class Sched, bool ALIGN_EPI, bool GATHER, bool I8 = false>
__device__ __forceinline__ void gemm_phase(PG8_LAS unsigned char* lds, const int Kb, const Sched& S, const Epi& E) {
    typedef typename Epi::acc_t acc_t;
    const int tid = threadIdx.x, wid = __builtin_amdgcn_readfirstlane(tid >> 6), lane = tid & 63, wr = wid >> 2, wc = wid & 3, fr = lane & 15, fq = lane >> 4;
    const int nt = Kb / (BK * 2);
    unsigned voffB[2], ga[2][2], gn[2][2]; int RA[2], CA[2];
#pragma unroll
    for (int i = 0; i < 2; ++i) { int R, C; stage_rc(tid * 16 + i * 8192, R, C); const int Rb = Epi::PERM ? ((R & ~31) + perm32(R & 31)) : R;
        RA[i] = R; CA[i] = C; voffB[i] = (unsigned)(Rb * Kb) + (unsigned)C * 2u; }
    const size_t kstep = (size_t)(BK * 2);
    const size_t hstep = (size_t)HALF * Kb;
    const unsigned ldsw = (unsigned)wid * 1024u;
    const int aoff = lds_byte(wr * 64 + fr, fq * 8), boff = lds_byte(wc * 32 + fr, fq * 8);
#define PG8_SA(b, h) (((b) * 2 + (h)) * HTB)
#define PG8_SB(b, h) ((4 + (b) * 2 + (h)) * HTB)
#define PG8_STAGE(bufoff, gbase, voff) do { _Pragma("unroll") for (int _i = 0; _i < 2; ++_i) \
        __builtin_amdgcn_global_load_lds((const unsigned*)((const char*)(gbase) + (voff)[_i]), (PG8_LAS unsigned*)(lds + (bufoff) + ldsw + _i * 8192), 16, 0, 0); } while (0)
#define PG8_LDA(dst, b, h) do { _Pragma("unroll") for (int m = 0; m < 4; ++m) _Pragma("unroll") for (int k = 0; k < 2; ++k) dst[m][k] = *(const PG8_LAS bf16x8*)(lds + PG8_SA(b, h) + aoff + m * 2048 + k * 1024); } while (0)
#define PG8_LDB(dst, b, h) do { _Pragma("unroll") for (int n = 0; n < 2; ++n) _Pragma("unroll") for (int k = 0; k < 2; ++k) dst[n][k] = *(const PG8_LAS bf16x8*)(lds + PG8_SB(b, h) + boff + n * 2048 + k * 1024); } while (0)
#define PG8_MMA(ai, bj, At, Bt) do { __builtin_amdgcn_s_setprio(1); _Pragma("unroll") for (int m = 0; m < 4; ++m) _Pragma("unroll") for (int n = 0; n < 2; ++n) _Pragma("unroll") for (int k = 0; k < 2; ++k) \
        acc[ai][bj][m][n] = mma16(Bt[n][k], At[m][k], acc[ai][bj][m][n]); __builtin_amdgcn_s_setprio(0); } while (0)
#define PG8_WAIT_V(n) asm volatile("s_waitcnt vmcnt(" #n ")" ::: "memory")
#define PG8_WAIT_L(n) asm volatile("s_waitcnt lgkmcnt(" #n ")" ::: "memory")
#define PG8_BAR __builtin_amdgcn_s_barrier()
#define PG8_SCHED __builtin_amdgcn_sched_barrier(0)
    Unit cur, nxt; int ui = 0;
    if (!S.next(0, cur)) return;
#pragma unroll
    for (int h = 0; h < 2; ++h)
#pragma unroll
        for (int i = 0; i < 2; ++i) { ga[h][i] = (GATHER ? S.row_off(cur, h * HALF + RA[i]) : (unsigned)((h * HALF + RA[i]) * Kb)) + (unsigned)CA[i] * 2u; gn[h][i] = ga[h][i]; }
    acc_t acc[2][2][4][2];
#pragma unroll
    for (int a = 0; a < 2; ++a)
#pragma unroll
        for (int b = 0; b < 2; ++b)
#pragma unroll
            for (int m = 0; m < 4; ++m)
#pragma unroll
                for (int n = 0; n < 2; ++n) acc[a][b][m][n] = (acc_t){0, 0, 0, 0};
    bf16x8 At[4][2], B0[2][2], B1[2][2];
    const char* cA = cur.a; const char* cB = cur.b;
    PG8_STAGE(PG8_SB(0, 0), cB, voffB); PG8_STAGE(PG8_SB(0, 1), cB + hstep, voffB); PG8_STAGE(PG8_SA(0, 0), cA, ga[0]); PG8_STAGE(PG8_SA(0, 1), cA, ga[1]);
    if (wr == 1) PG8_BAR;
    PG8_WAIT_V(2); PG8_BAR;
    PG8_STAGE(PG8_SB(1, 0), cB + kstep, voffB); PG8_STAGE(PG8_SA(1, 0), cA + kstep, ga[0]); PG8_STAGE(PG8_SB(1, 1), cB + hstep + kstep, voffB);
    PG8_WAIT_V(6); PG8_BAR;
    for (;;) {
        const bool has_next = S.next(ui + 1, nxt);
        const char* nA = has_next ? nxt.a : cA; const char* nB = has_next ? nxt.b : cB;
        if (GATHER && has_next) {
#pragma unroll
            for (int h = 0; h < 2; ++h)
#pragma unroll
                for (int i = 0; i < 2; ++i) gn[h][i] = S.row_off(nxt, h * HALF + RA[i]) + (unsigned)CA[i] * 2u;
        }
        for (int t = 0; t < nt; t += 2) {
            const bool last = (t == nt - 2);
            const char* a1 = cA + (size_t)(t + 1) * kstep;
            const char* a2 = last ? nA : cA + (size_t)(t + 2) * kstep; const char* b2 = last ? nB : cB + (size_t)(t + 2) * kstep;
            const char* a3 = a2 + kstep; const char* b3 = b2 + kstep;
            unsigned g2[2][2];
#pragma unroll
            for (int h = 0; h < 2; ++h)
#pragma unroll
                for (int i = 0; i < 2; ++i) g2[h][i] = (GATHER && last) ? gn[h][i] : ga[h][i];
            PG8_LDB(B0, 0, 0); PG8_LDB(B1, 0, 1); PG8_SCHED; PG8_LDA(At, 0, 0); PG8_STAGE(PG8_SA(1, 1), a1, ga[1]);
            PG8_WAIT_V(8); PG8_WAIT_L(0); PG8_BAR; PG8_MMA(0, 0, At, B0); PG8_MMA(0, 1, At, B1); PG8_BAR; PG8_SCHED;
            PG8_LDA(At, 0, 1); PG8_STAGE(PG8_SB(0, 0), b2, voffB); PG8_STAGE(PG8_SB(0, 1), b2 + hstep, voffB); PG8_STAGE(PG8_SA(0, 0), a2, g2[0]);
            PG8_WAIT_V(8); PG8_WAIT_L(0); PG8_BAR; PG8_MMA(1, 0, At, B0); PG8_MMA(1, 1, At, B1); PG8_BAR; PG8_SCHED;
            PG8_LDB(B0, 1, 0); PG8_LDB(B1, 1, 1); PG8_SCHED; PG8_LDA(At, 1, 0); PG8_STAGE(PG8_SA(0, 1), a2, g2[1]);
            PG8_WAIT_V(8); PG8_WAIT_L(0); PG8_BAR; PG8_MMA(0, 0, At, B0); PG8_MMA(0, 1, At, B1); PG8_BAR; PG8_SCHED;
            PG8_LDA(At, 1, 1); PG8_STAGE(PG8_SB(1, 0), b3, voffB); PG8_STAGE(PG8_SB(1, 1), b3 + hstep, voffB); PG8_STAGE(PG8_SA(1, 0), a3, g2[0]);
            PG8_WAIT_V(8); PG8_WAIT_L(0); PG8_BAR; PG8_MMA(1, 0, At, B0); PG8_MMA(1, 1, At, B1); PG8_BAR; PG8_SCHED;
        }
        if constexpr (ALIGN_EPI) { if (wr == 0) PG8_BAR; }
        E(acc, cur, wr, wc, fr, fq);
        if (!has_next) break;
#pragma unroll
        for (int a = 0; a < 2; ++a)
#pragma unroll
            for (int b = 0; b < 2; ++b)
#pragma unroll
                for (int m = 0; m < 4; ++m)
#pragma unroll
                    for (int n = 0; n < 2; ++n) acc[a][b][m][n] = (acc_t){0, 0, 0, 0};
        cur = nxt; cA = nA; cB = nB; ++ui;
#pragma unroll
        for (int h = 0; h < 2; ++h)
#pragma unroll
            for (int i = 0; i < 2; ++i) ga[h][i] = gn[h][i];
        if constexpr (ALIGN_EPI) { if (wr == 1) PG8_BAR; }
    }
    PG8_WAIT_V(0);
    if constexpr (!ALIGN_EPI) { if (wr == 0) PG8_BAR; }
    PG8_BAR;
#undef PG8_SA
#undef PG8_SB
#undef PG8_STAGE
#undef PG8_LDA
#undef PG8_LDB
#undef PG8_MMA
#undef PG8_WAIT_V
#undef PG8_WAIT_L
#undef PG8_BAR
#undef PG8_SCHED
}
}

constexpr int NWAVES = 8;
constexpr int RING_OFF = 0, RING_BYTES = 143360;
constexpr int LDSCTL_OFF = RING_BYTES;
constexpr int MISC_OFF = LDSCTL_OFF + 64;
constexpr int TAB_OFF = LDSCTL_OFF + 256;
constexpr int LDS_BYTES = RING_BYTES + 2048;

#define GAS __attribute__((address_space(1)))
typedef GAS unsigned gu32;
#define RLX_AGENT __ATOMIC_RELAXED, __HIP_MEMORY_SCOPE_AGENT
#define LDS_WAIT() asm volatile("s_waitcnt lgkmcnt(0)" ::: "memory")
#define VM_WAIT() asm volatile("s_waitcnt vmcnt(0)" ::: "memory")

#define XB_TMO      128
#define XB_XCNT(j)  (256  + 64 * (j))
#define XB_XSUB(j)  (1280 + 64 * (j))
#define XB_XGEN(j)  (2304 + 64 * (j))
#define XB_TOP      3328
#define XB_TOPGEN   3392
#define XCD_BAR_WORDS 3456
#define XB_SPIN_CAP (1u << 18)

__device__ __forceinline__ unsigned xb_ld(unsigned* p)              { return __hip_atomic_load(p, __ATOMIC_RELAXED, __HIP_MEMORY_SCOPE_AGENT); }
__device__ __forceinline__ unsigned xb_add(unsigned* p, unsigned v) { return __hip_atomic_fetch_add(p, v, __ATOMIC_RELAXED, __HIP_MEMORY_SCOPE_AGENT); }
__device__ __forceinline__ unsigned xb_xcc_id() { return (unsigned)__builtin_amdgcn_s_getreg((3 << 11) | 20) & 0xFu; }
#define XB_SPIN(cond, bar) do { unsigned _sp = 0; while (cond) { __builtin_amdgcn_s_sleep(1); \
    if ((++_sp & 255u) == 0u) { if (xb_ld(&(bar)[XB_TMO])) break; if (_sp > XB_SPIN_CAP) { atomicAdd(&(bar)[XB_TMO], 1u); break; } } } } while (0)

struct XcdBarrier { unsigned* bar; unsigned x; volatile LAS unsigned* st; };

__device__ __forceinline__ XcdBarrier xcd_barrier_post(unsigned* bar, volatile LAS unsigned* st) {
    XcdBarrier b; b.bar = bar; b.x = xb_xcc_id(); b.st = st;
    if (threadIdx.x == 0) (void)xb_add(&bar[XB_XCNT(b.x)], 1u);
    return b;
}
__device__ __forceinline__ void xcd_barrier_complete(unsigned* bar, unsigned x, unsigned& nloc, unsigned& nx) {
    const unsigned G = gridDim.x * gridDim.y * gridDim.z;
    unsigned sum, cnt, mine, sp = 0u;
    for (;;) {
        sum = 0u; cnt = 0u; mine = 0u;
#pragma unroll
        for (unsigned j = 0; j < 16; ++j) { const unsigned c = xb_ld(&bar[XB_XCNT(j)]); sum += c; cnt += (c > 0u) ? 1u : 0u; mine = (j == x) ? c : mine; }
        if (sum == G) break;
        __builtin_amdgcn_s_sleep(1);
        if ((++sp & 255u) == 0u) { if (xb_ld(&bar[XB_TMO])) break; if (sp > XB_SPIN_CAP) { atomicAdd(&bar[XB_TMO], 1u); break; } }
    }
    nloc = mine > 0u ? mine : 1u; nx = cnt > 0u ? cnt : 1u;
}
__device__ __forceinline__ void xcd_barrier(const XcdBarrier& b) {
    asm volatile("s_waitcnt vmcnt(0)" ::: "memory");
    __syncthreads();
    if (threadIdx.x == 0) {
        unsigned* bar = b.bar;
        __builtin_amdgcn_s_waitcnt(0);
        unsigned nloc = b.st[0], nx = b.st[1];
        if (nloc == 0u) { xcd_barrier_complete(bar, b.x, nloc, nx); b.st[0] = nloc; b.st[1] = nx; }
        const unsigned old = xb_add(&bar[XB_XSUB(b.x)], 1u);
        const unsigned gen = old / nloc;
        if (old + 1u == (gen + 1u) * nloc) {
            __builtin_amdgcn_fence(__ATOMIC_RELEASE, "agent");
            asm volatile("s_waitcnt vmcnt(0)" ::: "memory");
            const unsigned og = xb_add(&bar[XB_TOP], 1u);
            const unsigned tg = og / nx;
            if (og + 1u == (tg + 1u) * nx) xb_add(&bar[XB_TOPGEN], 1u);
            else XB_SPIN(xb_ld(&bar[XB_TOPGEN]) == tg, bar);
            __builtin_amdgcn_fence(__ATOMIC_ACQUIRE, "agent");
            xb_add(&bar[XB_XGEN(b.x)], 1u);
            asm volatile("s_waitcnt vmcnt(0)" ::: "memory");
        } else {
            XB_SPIN(xb_ld(&bar[XB_XGEN(b.x)]) == gen, bar);
            __builtin_amdgcn_fence(__ATOMIC_ACQUIRE, "agent");
            asm volatile("s_waitcnt vmcnt(0)" ::: "memory");
        }
    }
    __syncthreads();
}

struct Frame {
    LAS unsigned char* lds;
    unsigned* ctl;
    int tid, lane, wave, vcu, G;
    Ptrs p;
};

__device__ __forceinline__ void p0_pass_a(Frame& F) {
    const Ptrs& p = F.p; const int tid = F.tid, lane = F.lane, wave = F.wave;
    LAS float* scr = (LAS float*)(F.lds + RING_OFF) + wave * 64 * 33;
    LAS float* gw = (LAS float*)(F.lds + RING_OFF + 8 * 64 * 33 * 4);
    const int gw_id = F.vcu * NWAVES + wave, NGW = F.G * NWAVES;
    bf16_t* WOUT = (bf16_t*)(p.ws + WS_WOUT); bf16_t* W2 = (bf16_t*)(p.ws + WS_W2);
    for (int i = tid; i < 1024 * 8; i += NWAVES * 64) gw[i] = p.w_in[(size_t)(i >> 3) * DIN + C_IG + (i & 7)];
    __syncthreads();
    constexpr int I_IN = 16 * 112, I_OUT = 16 * 32, I_13 = 16 * 16 * 32, I_2 = 8 * 32 * 32;
    constexpr int C_INN = Q8_PROJ ? 4 * 112 : 0, C_13 = Q8_UP ? 4 * 16 * 32 : 0;
    constexpr int T_IN = Q8_PROJ ? 0 : I_IN, T_13 = Q8_UP ? 0 : I_13;
    constexpr int NITEMS = C_INN + 2 * C_13 + T_IN + 2 * T_13 + I_OUT + I_2;
    for (int it = gw_id; it < NITEMS; it += NGW) {
        int r = it;
        if (r < C_INN) { const int kb = r / 112, nb = r % 112; colmax_item(p.w_in, DIN, 256 * kb, 256, 32 * nb, MapRope(), nullptr, F.ctl + CW_CMAX_IN, lane); continue; } r -= C_INN;
        if (r < C_13) { const int e = r / 64, q = r % 64, kb = q / 16, nb = q % 16; colmax_item(p.w1 + (size_t)e * 1024 * 512, 512, 256 * kb, 256, 32 * nb, MapW1(), p.g_ffn, F.ctl + CW_CMAX_13 + e * 1024, lane); continue; } r -= C_13;
        if (r < C_13) { const int e = r / 64, q = r % 64, kb = q / 16, nb = q % 16; colmax_item(p.w3 + (size_t)e * 1024 * 512, 512, 256 * kb, 256, 32 * nb, MapW3(), p.g_ffn, F.ctl + CW_CMAX_13 + e * 1024, lane); continue; } r -= C_13;
        if (r < T_IN) { const int kb = r / 112, nb = r % 112; transpose_item(p.w_in, DIN, (bf16_t*)(p.ws + WS_WIN), 1024, 64 * kb, 32 * nb, MapRope(), nullptr, scr, lane); continue; } r -= T_IN;
        if (r < T_13) { const int e = r / 256, q = r % 256, kb = q / 16, nb = q % 16; transpose_item(p.w1 + (size_t)e * 1024 * 512, 512, (bf16_t*)(p.ws + WS_W13) + (size_t)e * 1024 * 1024, 1024, 64 * kb, 32 * nb, MapW1(), p.g_ffn, scr, lane); continue; } r -= T_13;
        if (r < T_13) { const int e = r / 256, q = r % 256, kb = q / 16, nb = q % 16; transpose_item(p.w3 + (size_t)e * 1024 * 512, 512, (bf16_t*)(p.ws + WS_W13) + (size_t)e * 1024 * 1024, 1024, 64 * kb, 32 * nb, MapW3(), p.g_ffn, scr, lane); continue; } r -= T_13;
        if (r < I_OUT) { const int kb = r / 32, nb = r % 32; transpose_item(p.w_out, 1024, WOUT, 1024, 64 * kb, 32 * nb, MapId(), nullptr, scr, lane); continue; } r -= I_OUT;
        { const int e = r / 256, q = r % 256, kb = q / 32, nb = q % 32; transpose_item(p.w2 + (size_t)e * 512 * 1024, 1024, W2 + (size_t)e * 1024 * 512, 512, 64 * kb, 32 * nb, MapId(), nullptr, scr, lane); }
    }
    { float* cs = (float*)(p.ws + WS_ROPE); float* sn = cs + 2048 * 32;
      for (int i = blockIdx.x * 512 + tid; i < 2048 * 32; i += F.G * 512) { const int pos = i >> 5, j = i & 31;
          const float inv = 1.0f / exp2f((float)(2 * j) * (1.f / 64.f) * 13.287712379549449f);
          const float ang = (float)pos * inv; const double rev = (double)ang * 0.15915494309189535; const float fr = (float)(rev - rint(rev));
          cs[i] = __builtin_amdgcn_cosf(fr); sn[i] = __builtin_amdgcn_sinf(fr); } }
    { bf16_t* WR = (bf16_t*)(p.ws + WS_WR);
      for (int i = blockIdx.x * 512 + tid; i < 48 * 1024; i += F.G * 512) { const int c = i >> 10, k = i & 1023; float v = 0.f;
          if (c < 4) v = p.w_grp[k * 4 + c]; else if (c < 36) v = p.w_er[((size_t)((c - 4) >> 3) * 1024 + k) * 8 + ((c - 4) & 7)];
          WR[i] = (bf16_t)f2bf(v * p.g_ffn[k]); } }
    float* GATES = (float*)(p.ws + WS_GATES);
    f32x4 nv[4];
    if (gw_id < T) {
#pragma unroll
        for (int j = 0; j < 4; ++j) nv[j] = ((const f32x4*)(p.x + (size_t)gw_id * D) + lane)[64 * j]; }
    for (int m = gw_id; m < T; m += NGW) {
        const f32x4* gr = (const f32x4*)p.g_mix + lane;
        f32x4 v[4]; float s = 0.f;
#pragma unroll
        for (int j = 0; j < 4; ++j) { v[j] = nv[j]; s += (v[j].x * v[j].x + v[j].y * v[j].y) + (v[j].z * v[j].z + v[j].w * v[j].w); }
        if (m + NGW < T) {
#pragma unroll
            for (int j = 0; j < 4; ++j) nv[j] = ((const f32x4*)(p.x + (size_t)(m + NGW) * D) + lane)[64 * j]; }
        const float rstd = 1.f / sqrtf(wave_sum(s) * (1.f / D) + RMS_EPS);
        float ga[8];
#pragma unroll
        for (int e = 0; e < 8; ++e) ga[e] = 0.f;
        float amax = 0.f;
#pragma unroll
        for (int j = 0; j < 4; ++j) { const f32x4 g = gr[64 * j]; const f32x4 h = v[j] * rstd * g; v[j] = h;
            amax = fmaxf(amax, fmaxf(fmaxf(fabsf(h.x), fabsf(h.y)), fmaxf(fabsf(h.z), fabsf(h.w))));
            const int k0 = 256 * j + 4 * lane;
#pragma unroll
            for (int q = 0; q < 4; ++q) { const float hv = h[q]; const LAS float* w = gw + (k0 + q) * 8;
#pragma unroll
                for (int e = 0; e < 8; ++e) ga[e] += hv * w[e]; } }
#if Q8_PROJ
#pragma unroll
        for (int o = 1; o < 64; o <<= 1) amax = fmaxf(amax, __shfl_xor(amax, o));
        { const float inv = amax > 0.f ? 127.f / amax : 0.f; unsigned* o4 = (unsigned*)(p.ws + WS_HB + (size_t)m * D) + lane;
#pragma unroll
          for (int j = 0; j < 4; ++j) o4[64 * j] = q8(v[j].x * inv) | (q8(v[j].y * inv) << 8) | (q8(v[j].z * inv) << 16) | (q8(v[j].w * inv) << 24);
          if (lane == 0) ((float*)(p.ws + WS_SA))[m] = amax * (1.f / 127.f); }
#else
        { unsigned long long* o8 = (unsigned long long*)((bf16_t*)(p.ws + WS_HB) + (size_t)m * D) + lane;
#pragma unroll
          for (int j = 0; j < 4; ++j) o8[64 * j] = (unsigned long long)pk2(v[j].x, v[j].y) | ((unsigned long long)pk2(v[j].z, v[j].w) << 32); }
#endif
#pragma unroll
        for (int e = 0; e < 8; ++e) ga[e] = wave_sum(ga[e]);
        if (lane < 8) { float gv = 0.f;
#pragma unroll
            for (int e = 0; e < 8; ++e) gv = (lane == e) ? ga[e] : gv;
            gv += p.gate_b[lane];
            if (lane >= 4) gv = fminf(gv, 0.f) - log1pf(__expf(-fabsf(gv)));
            GATES[(size_t)m * 8 + lane] = gv; }
    }
}
__device__ __forceinline__ void p0_pass_b(Frame& F) {
    const Ptrs& p = F.p; const int lane = F.lane, wave = F.wave;
    LAS float* scr = (LAS float*)(F.lds + RING_OFF) + wave * 64 * 33;
    const int gw_id = F.vcu * NWAVES + wave, NGW = F.G * NWAVES;
    constexpr int I_IN = Q8_PROJ ? 16 * 112 : 0, I_13 = Q8_UP ? 16 * 16 * 32 : 0;
    for (int it = gw_id; it < I_IN + 2 * I_13; it += NGW) {
        int r = it;
        if (r < I_IN) { const int kb = r / 112, nb = r % 112; transpose_item_q8(p.w_in, DIN, (signed char*)(p.ws + WS_WIN), 1024, 64 * kb, 32 * nb, MapRope(), nullptr, F.ctl + CW_CMAX_IN, (float*)(p.ws + WS_SBIN), kb == 0, scr, lane); continue; } r -= I_IN;
        if (r < I_13) { const int e = r / 256, q = r % 256, kb = q / 16, nb = q % 16; transpose_item_q8(p.w1 + (size_t)e * 1024 * 512, 512, (signed char*)(p.ws + WS_W13) + (size_t)e * 1024 * 1024, 1024, 64 * kb, 32 * nb, MapW1(), p.g_ffn, F.ctl + CW_CMAX_13 + e * 1024, (float*)(p.ws + WS_SB13) + e * 1024, kb == 0, scr, lane); continue; } r -= I_13;
        { const int e = r / 256, q = r % 256, kb = q / 16, nb = q % 16; transpose_item_q8(p.w3 + (size_t)e * 1024 * 512, 512, (signed char*)(p.ws + WS_W13) + (size_t)e * 1024 * 1024, 1024, 64 * kb, 32 * nb, MapW3(), p.g_ffn, F.ctl + CW_CMAX_13 + e * 1024, (float*)(p.ws + WS_SB13) + e * 1024, kb == 0, scr, lane); }
    }
}

__device__ __forceinline__ void final_body(Frame& F) {
    const Ptrs& p = F.p; const int lane = F.lane; const bf16_t* X1B = (const bf16_t*)(p.ws + WS_X1B); const bf16_t* Y = (const bf16_t*)(p.ws + WS_Y);
    for (size_t tok = F.vcu * NWAVES + F.wave; tok < T; tok += F.G * NWAVES) {
        f32x4 v[4]; float s = 0.f;
#pragma unroll
        for (int j = 0; j < 4; ++j) { const u32x2 x = ((const u32x2*)(X1B + tok * D))[lane + 64 * j];
            const u32x2 a = ((const u32x2*)(Y + (2 * tok) * D))[lane + 64 * j], b = ((const u32x2*)(Y + (2 * tok + 1) * D))[lane + 64 * j];
            v[j].x = bf2f(x.x & 0xffffu) + (bf2f(a.x & 0xffffu) + bf2f(b.x & 0xffffu)); v[j].y = bf2f(x.x >> 16) + (bf2f(a.x >> 16) + bf2f(b.x >> 16));
            v[j].z = bf2f(x.y & 0xffffu) + (bf2f(a.y & 0xffffu) + bf2f(b.y & 0xffffu)); v[j].w = bf2f(x.y >> 16) + (bf2f(a.y >> 16) + bf2f(b.y >> 16));
            s += (v[j].x * v[j].x + v[j].y * v[j].y) + (v[j].z * v[j].z + v[j].w * v[j].w); }
        const float rstd = 1.f / sqrtf(wave_sum(s) * (1.f / D) + RMS_EPS);
#pragma unroll
        for (int j = 0; j < 4; ++j) { const f32x4 g = ((const f32x4*)p.g_final)[lane + 64 * j]; ((f32x4*)(p.out + tok * D))[lane + 64 * j] = v[j] * rstd * g; }
    }
}
__device__ __forceinline__ void moe_tables(Frame& F) {
    LAS int* tab = (LAS int*)(F.lds + TAB_OFF);
    if (F.tid == 0) { int us = 0, ps = 0;
        for (int e = 0; e < NE; ++e) { const int c = (int)__hip_atomic_load(F.ctl + CW_CNT + 64 * e, RLX_AGENT); const int nb = (c + 255) >> 8;
            tab[e] = us; tab[64 + e] = ps; tab[128 + e] = c; us += nb * 4; ps += nb * 256; }
        tab[32] = us; tab[96] = ps; }
    __syncthreads();
}


namespace att {
typedef float f32x16 __attribute__((ext_vector_type(16)));
typedef short s16x4 __attribute__((ext_vector_type(4)));
constexpr int STAGE = 32768, VOFF = 16384, XCH_OFF = 65536;
constexpr int ROWB = NPROJ * 2;
__device__ __forceinline__ int crow(int r, int hi) { return (r & 3) + 8 * (r >> 2) + 4 * hi; }
__device__ __forceinline__ unsigned swz(unsigned row) { return ((row & 3u) << 2) | ((row >> 2) & 3u); }
__device__ __forceinline__ s16x4 trrd(const LAS unsigned char* p) { return __builtin_bit_cast(s16x4, __builtin_amdgcn_ds_read_tr16_b64_v4i16((LAS s16x4*)p)); }

__device__ __forceinline__ void attn_unit(Frame& F, int bh, int qb, float lam) {
    LAS unsigned char* lds = F.lds + RING_OFF;
    const int lane = F.lane, wid = F.wave, c = wid >> 2, wq = wid & 3, r32 = lane & 31, hi = lane >> 5;
    const int b = bh >> 2, h = bh & 3, q0 = qb * 128, qlo = q0 + 32 * wq;
    const char* projb = (const char*)(F.p.ws + WS_PROJ) + (size_t)(b * SEQ) * ROWB;
    const char* kg = projb + (C_KA + h * 128) * 2; const char* vg = projb + (C_VA + h * 128) * 2;
    unsigned srcoff[2];
#pragma unroll
    for (int n = 0; n < 2; ++n) { const unsigned row = 4u * (wid + 8 * n) + (lane >> 4), slot = lane & 15; srcoff[n] = row * ROWB + ((slot ^ swz(row)) << 4); }
#define ATT_DMA(t, st) do { _Pragma("unroll") for (int _n = 0; _n < 2; ++_n) { \
        __builtin_amdgcn_global_load_lds((const unsigned*)(kg + (size_t)(t) * 64 * ROWB + srcoff[_n]), (LAS unsigned*)(lds + (st) * STAGE + (wid + 8 * _n) * 1024), 16, 0, 0); \
        __builtin_amdgcn_global_load_lds((const unsigned*)(vg + (size_t)(t) * 64 * ROWB + srcoff[_n]), (LAS unsigned*)(lds + (st) * STAGE + VOFF + (wid + 8 * _n) * 1024), 16, 0, 0); } } while (0)
    bf16x8 qf[4];
    { const bf16_t* qp = (const bf16_t*)(projb + (size_t)(qlo + r32) * ROWB) + C_QA + h * 128 + c * 64 + 8 * hi;
#pragma unroll
      for (int s = 0; s < 4; ++s) qf[s] = *(const bf16x8*)(qp + 16 * s); }
    unsigned kaddr[4], vaddr[2][4];
#pragma unroll
    for (int s = 0; s < 4; ++s) kaddr[s] = 256u * r32 + 16u * ((unsigned)(8 * c + 2 * s + hi) ^ swz(r32));
    { const unsigned blk = (lane >> 4) & 1, q = (lane & 15) >> 2, p = lane & 3;
#pragma unroll
      for (int t2 = 0; t2 < 2; ++t2)
#pragma unroll
          for (int dt = 0; dt < 4; ++dt) { const unsigned row = 8u * t2 + 4u * hi + q; vaddr[t2][dt] = 256u * row + 16u * ((4u * dt + 2u * blk + (p >> 1)) ^ swz(row)) + 8u * (p & 1); } }
    f32x16 o[4];
#pragma unroll
    for (int dt = 0; dt < 4; ++dt)
#pragma unroll
        for (int r = 0; r < 16; ++r) o[dt][r] = 0.f;
    float m = -INFINITY, l = 0.f;
    const int NT = 2 * qb + 2;
    ATT_DMA(0, 0);
    for (int t = 0; t < NT; ++t) {
        asm volatile("s_waitcnt vmcnt(0)" ::: "memory"); __builtin_amdgcn_s_barrier(); asm volatile("" ::: "memory");
        if (t + 1 < NT) ATT_DMA(t + 1, (t + 1) & 1);
        if (64 * t <= qlo + 31) {
            const LAS unsigned char* kb = lds + (t & 1) * STAGE; const LAS unsigned char* vb = kb + VOFF;
            f32x16 p0, p1;
#pragma unroll
            for (int r = 0; r < 16; ++r) { p0[r] = 0.f; p1[r] = 0.f; }
#pragma unroll
            for (int s = 0; s < 4; ++s) { const bf16x8 k0 = *(const LAS bf16x8*)(kb + kaddr[s]), k1 = *(const LAS bf16x8*)(kb + 8192 + kaddr[s]);
                p0 = __builtin_amdgcn_mfma_f32_32x32x16_bf16(k0, qf[s], p0, 0, 0, 0); p1 = __builtin_amdgcn_mfma_f32_32x32x16_bf16(k1, qf[s], p1, 0, 0, 0); }
            if (64 * t + 63 > qlo) { const int qg = qlo + r32;
#pragma unroll
                for (int r = 0; r < 16; ++r) { const int key = 64 * t + crow(r, hi); if (key > qg) p0[r] = -INFINITY; if (key + 32 > qg) p1[r] = -INFINITY; } }
            float rm = fmaxf(p0[0], p1[0]);
#pragma unroll
            for (int r = 1; r < 16; ++r) rm = fmaxf(rm, fmaxf(p0[r], p1[r]));
            rm = fmaxf(rm, __shfl_xor(rm, 32));
            const float mn = fmaxf(m, rm), alpha = __builtin_amdgcn_exp2f(m - mn); m = mn;
            float rs = 0.f;
#pragma unroll
            for (int r = 0; r < 16; ++r) { p0[r] = __builtin_amdgcn_exp2f(p0[r] - mn); p1[r] = __builtin_amdgcn_exp2f(p1[r] - mn); rs += p0[r] + p1[r]; }
            l = l * alpha + rs;
#pragma unroll
            for (int dt = 0; dt < 4; ++dt)
#pragma unroll
                for (int r = 0; r < 16; ++r) o[dt][r] *= alpha;
            bf16x8 pf[4];
#pragma unroll
            for (int ks = 0; ks < 4; ++ks) { u32x4 w;
#pragma unroll
                for (int j = 0; j < 4; ++j) { const int r = 8 * (ks & 1) + 2 * j; w[j] = (ks < 2) ? pg8::cvt_pk_bf16(p0[r], p0[r + 1]) : pg8::cvt_pk_bf16(p1[r], p1[r + 1]); }
                pf[ks] = __builtin_bit_cast(bf16x8, w); }
#pragma unroll
            for (int dt = 0; dt < 4; ++dt)
#pragma unroll
                for (int ks = 0; ks < 4; ++ks) { const s16x4 lo = trrd(vb + vaddr[0][dt] + 4096 * ks), hh = trrd(vb + vaddr[1][dt] + 4096 * ks);
                    const bf16x8 vf = (bf16x8){lo[0], lo[1], lo[2], lo[3], hh[0], hh[1], hh[2], hh[3]};
                    o[dt] = __builtin_amdgcn_mfma_f32_32x32x16_bf16(vf, pf[ks], o[dt], 0, 0, 0); }
        }
    }
    asm volatile("s_waitcnt lgkmcnt(0)" ::: "memory"); __builtin_amdgcn_s_barrier(); asm volatile("" ::: "memory");
    l += __shfl_xor(l, 32);
    const float inv = 1.f / l;
    LAS float* xch = (LAS float*)(lds + XCH_OFF + wq * 16384);
    if (c == 1) {
#pragma unroll
        for (int dt = 0; dt < 4; ++dt)
#pragma unroll
            for (int r = 0; r < 16; ++r) xch[(dt * 16 + r) * 64 + lane] = o[dt][r] * inv;
    }
    asm volatile("s_waitcnt lgkmcnt(0)" ::: "memory"); __builtin_amdgcn_s_barrier(); asm volatile("" ::: "memory");
    if (c == 0) {
        float ss = 0.f;
#pragma unroll
        for (int dt = 0; dt < 4; ++dt)
#pragma unroll
            for (int r = 0; r < 16; ++r) { const float v = o[dt][r] * inv - lam * xch[(dt * 16 + r) * 64 + lane]; o[dt][r] = v; ss += v * v; }
        ss += __shfl_xor(ss, 32);
        const float rsn = (1.f - LAMBDA_INIT) / sqrtf(ss * (1.f / 128.f) + RMS_EPS);
        bf16_t* orow = (bf16_t*)(F.p.ws + WS_MIX) + (size_t)(b * SEQ + qlo + r32) * D + h * 128;
#pragma unroll
        for (int dt = 0; dt < 4; ++dt)
#pragma unroll
            for (int r4 = 0; r4 < 4; ++r4) { const int dv = 32 * dt + 8 * r4 + 4 * hi; const f32x4 g = *(const f32x4*)(F.p.subln_g + dv);
                u32x2 w; w.x = pg8::cvt_pk_bf16(o[dt][4 * r4] * rsn * g[0], o[dt][4 * r4 + 1] * rsn * g[1]); w.y = pg8::cvt_pk_bf16(o[dt][4 * r4 + 2] * rsn * g[2], o[dt][4 * r4 + 3] * rsn * g[3]);
                *(u32x2*)(orow + dv) = w; }
    }
#undef ATT_DMA
}

__device__ __forceinline__ void attn_phase(Frame& F, int qword) {
    const float* lq = F.p.lam_qk; const int lane = F.lane;
    const float lam = __expf(wave_sum(lq[lane] * lq[64 + lane])) - __expf(wave_sum(lq[128 + lane] * lq[192 + lane])) + LAMBDA_INIT;
    volatile LAS unsigned* qw = (volatile LAS unsigned*)(F.lds + LDSCTL_OFF + 32);
    for (;;) {
        if (F.tid == 0) *qw = __hip_atomic_fetch_add(F.ctl + qword, 1u, __ATOMIC_RELAXED, __HIP_MEMORY_SCOPE_AGENT);
        __syncthreads();
        const unsigned u = (unsigned)__builtin_amdgcn_readfirstlane((int)*qw);
        if (u >= 1024u) break;
        attn_unit(F, (int)(u & 63u), 15 - (int)(u >> 6), lam);
    }
}
}

namespace ml {
typedef short s16x4 __attribute__((ext_vector_type(4)));
constexpr int KI = 0, VI = 32768, CB = 65536, QI = 102400, PC = 135168, CWL = 137728, ML_END = 142848;
constexpr int ROWB = NPROJ * 2;
__device__ __forceinline__ unsigned swz(unsigned row) { return ((row & 3u) << 2) | ((row >> 2) & 3u); }
__device__ __forceinline__ unsigned off_b(unsigned row, unsigned ch) { return 256u * row + 16u * (ch ^ swz(row)); }
__device__ __forceinline__ s16x4 trrd(const LAS unsigned char* p) { return __builtin_bit_cast(s16x4, __builtin_amdgcn_ds_read_tr16_b64_v4i16((LAS s16x4*)p)); }
__device__ __forceinline__ f32x4 mfma16(bf16x8 a, bf16x8 b, f32x4 c) { return __builtin_amdgcn_mfma_f32_16x16x32_bf16(a, b, c, 0, 0, 0); }

__device__ __forceinline__ void conv_load(const bf16_t* src, int t, u32x4 (&raw)[7]) {
#pragma unroll
    for (int jj = 0; jj < 7; ++jj) raw[jj] = *(const u32x4*)(src + (ptrdiff_t)((t - 3 + jj >= 0) ? (jj - 3) : 0) * NPROJ);
}
__device__ __forceinline__ void conv_store(const u32x4 (&raw)[7], int t, const LAS float* cw, const LAS float* cb, int lc, float scale, LAS unsigned char* img, int row0, int pc) {
    f32x4 wt[4][2];
#pragma unroll
    for (int j = 0; j < 4; ++j) { wt[j][0] = *(const LAS f32x4*)(cw + j * 256 + lc); wt[j][1] = *(const LAS f32x4*)(cw + j * 256 + lc + 4); }
    const f32x4 b0 = *(const LAS f32x4*)(cb + lc), b1 = *(const LAS f32x4*)(cb + lc + 4);
    float x[7][8];
#pragma unroll
    for (int jj = 0; jj < 7; ++jj) { const float ok = (t - 3 + jj >= 0) ? 1.f : 0.f;
        x[jj][0] = ok * bf2f(raw[jj].x & 0xffffu); x[jj][1] = ok * bf2f(raw[jj].x >> 16); x[jj][2] = ok * bf2f(raw[jj].y & 0xffffu); x[jj][3] = ok * bf2f(raw[jj].y >> 16);
        x[jj][4] = ok * bf2f(raw[jj].z & 0xffffu); x[jj][5] = ok * bf2f(raw[jj].z >> 16); x[jj][6] = ok * bf2f(raw[jj].w & 0xffffu); x[jj][7] = ok * bf2f(raw[jj].w >> 16); }
#pragma unroll
    for (int rr = 0; rr < 4; ++rr) { float y[8];
#pragma unroll
        for (int e = 0; e < 8; ++e) { float a = (e < 4) ? b0[e & 3] : b1[e & 3];
#pragma unroll
            for (int j = 0; j < 4; ++j) a += ((e < 4) ? wt[j][0][e & 3] : wt[j][1][e & 3]) * x[rr + j][e];
            y[e] = a * scale * __builtin_amdgcn_rcpf(1.f + __expf(-a)); }
        u32x4 w; w.x = pg8::cvt_pk_bf16(y[0], y[1]); w.y = pg8::cvt_pk_bf16(y[2], y[3]); w.z = pg8::cvt_pk_bf16(y[4], y[5]); w.w = pg8::cvt_pk_bf16(y[6], y[7]);
        *(LAS u32x4*)(img + off_b(row0 + rr, pc)) = w; }
}
__device__ __forceinline__ bf16x8 pack8(const float (&v)[8]) { u32x4 w; w.x = pg8::cvt_pk_bf16(v[0], v[1]); w.y = pg8::cvt_pk_bf16(v[2], v[3]); w.z = pg8::cvt_pk_bf16(v[4], v[5]); w.w = pg8::cvt_pk_bf16(v[6], v[7]); return __builtin_bit_cast(bf16x8, w); }

__device__ __forceinline__ void mlstm_unit(Frame& F, int bh, int pf) {
    LAS unsigned char* lds = F.lds + RING_OFF;
    const int tid = F.tid, lane = F.lane, w = F.wave; int l15 = lane & 15, g = lane >> 4, q = l15 >> 2, p = lane & 3;
    const int b = bh >> 2, h = bh & 3; const size_t rowb = (size_t)b * SEQ;
    const bf16_t* PROJ = (const bf16_t*)(F.p.ws + WS_PROJ); const float* GATES = (const float*)(F.p.ws + WS_GATES); bf16_t* MIX = (bf16_t*)(F.p.ws + ((pf & 8) ? WS_HB : WS_MIX));
    float* gsc = (float*)(F.p.ws + WS_GSC) + (size_t)bh * 3 * SEQ;
    LAS float* pc_u = (LAS float*)(lds + PC); LAS float* pc_sci = pc_u + 128; LAS float* pc_ws = pc_u + 256; LAS float* pc_emr = pc_u + 384; LAS float* pc_a = pc_u + 512;
    LAS float* cw = (LAS float*)(lds + CWL); LAS float* cb = cw + 1024;
    for (int i = tid; i < 36864 / 16; i += 512) *(LAS u32x4*)(lds + CB + 16 * i) = (u32x4){0u, 0u, 0u, 0u};
    for (int i = tid; i < 1024; i += 512) { const int j = i >> 8, lc = i & 255; const int cc = (lc < 128) ? h * 128 + lc : 512 + h * 128 + (lc - 128); cw[i] = F.p.conv_w[j * 1024 + cc]; if (j == 0) cb[lc] = F.p.conv_b[cc]; }
#pragma unroll
    for (int cc2 = 0; cc2 < 2; ++cc2) { const int i0 = (2 * w + cc2) * 128 + 2 * lane;
        const float li0 = GATES[(rowb + i0) * 8 + h], lf0 = GATES[(rowb + i0) * 8 + 4 + h], li1 = GATES[(rowb + i0 + 1) * 8 + h], lf1 = GATES[(rowb + i0 + 1) * 8 + 4 + h];
        float s = lf0 + lf1;
#pragma unroll
        for (int o = 1; o < 64; o <<= 1) { const float y = __shfl_up(s, o); if (lane >= o) s += y; }
        const float b1v = s, b0v = s - lf1, a0 = li0 - b0v, a1 = li1 - b1v;
        float mx = fmaxf(a0, a1);
#pragma unroll
        for (int o = 1; o < 64; o <<= 1) { const float y = __shfl_up(mx, o); if (lane >= o) mx = fmaxf(mx, y); }
        float mprev = __shfl_up(mx, 1); if (lane == 0) mprev = -INFINITY;
        gsc[i0] = b0v; gsc[i0 + 1] = b1v; gsc[SEQ + i0] = a0; gsc[SEQ + i0 + 1] = a1; gsc[2 * SEQ + i0] = fmaxf(mprev, a0); gsc[2 * SEQ + i0 + 1] = mx; }
    __threadfence_block();
    asm volatile("s_waitcnt vmcnt(0)" ::: "memory");
    __syncthreads();
    f32x4 accC[9];
#pragma unroll
    for (int vt = 0; vt < 9; ++vt) accC[vt] = (f32x4){0.f, 0.f, 0.f, 0.f};
    float mcur = 0.f;
    const bf16x8 onesf = (l15 == 0) ? (bf16x8){0x3F80, 0x3F80, 0x3F80, 0x3F80, 0x3F80, 0x3F80, 0x3F80, 0x3F80} : (bf16x8){0, 0, 0, 0, 0, 0, 0, 0};
    const int tq = tid & 127;
    float gb = gsc[tq], gaa = gsc[SEQ + tq], gg = gsc[2 * SEQ + tq], gbl = gsc[127], gge = gsc[2 * SEQ + 127];

#define ML_LAUNDER() asm volatile("" : "+v"(l15), "+v"(g), "+v"(q), "+v"(p))
    u32x4 rawk[7], rawq[7]; u32x2 omr[8];
#define ML_STAGE(CI) do { const int t0_ = (CI) * 128; int tl_ = tid; asm volatile("" : "+v"(tl_)); const int rg = tl_ >> 4, pcc = tl_ & 15, ln_ = tl_ & 63; \
        { const float bL_ = gbl, mnew_ = bL_ + fmaxf(mcur, gge); \
          if (tl_ < 128) { const float bt = gb, mrow = bt + fmaxf(mcur, gg); \
              pc_u[tl_] = bt - mrow; pc_sci[tl_] = __expf(bt + mcur - mrow); pc_ws[tl_] = __expf(bL_ - mnew_ + gaa); pc_emr[tl_] = __expf(-mrow); pc_a[tl_] = gaa; } } \
        { const char* vg = (const char*)(PROJ + (rowb + t0_) * NPROJ + C_VM + h * 128); \
          _Pragma("unroll") for (int n = 0; n < 4; ++n) { const unsigned row_ = 4u * (w + 8 * n) + (ln_ >> 4), slot_ = ln_ & 15; \
              __builtin_amdgcn_global_load_lds((const unsigned*)(vg + row_ * ROWB + ((slot_ ^ swz(row_)) << 4)), (LAS unsigned*)(lds + VI + (w + 8 * n) * 1024), 16, 0, 0); } } \
        { const bf16_t* omp = PROJ + (rowb + t0_ + 16 * w + (ln_ & 15)) * NPROJ + C_OM + h * 128 + 4 * (ln_ >> 4); \
          _Pragma("unroll") for (int vt = 0; vt < 8; ++vt) omr[vt] = *(const u32x2*)(omp + 16 * vt); } \
        if (!(pf & 64)) { conv_store(rawk, t0_ + 4 * rg, cw, cb, 128 + 8 * pcc, 0.08838834764831845f, lds + KI, 4 * rg, pcc); \
        asm volatile("" ::: "memory"); \
        conv_store(rawq, t0_ + 4 * rg, cw, cb, 8 * pcc, 1.f, lds + QI, 4 * rg, pcc); } } while (0)
#define ML_RAWLOAD(CI) do { int tl_ = tid; asm volatile("" : "+v"(tl_)); const int rg = tl_ >> 4, pcc = tl_ & 15; const int t_ = (CI) * 128 + 4 * rg; \
        if (!(pf & 256)) { conv_load(PROJ + (rowb + t_) * NPROJ + C_KM + h * 128 + 8 * pcc, t_, rawk); conv_load(PROJ + (rowb + t_) * NPROJ + C_QM + h * 128 + 8 * pcc, t_, rawq); } } while (0)
    ML_RAWLOAD(0);
    float mnew = gbl + fmaxf(mcur, gge), sc = __expf(gbl + mcur - mnew);
    ML_STAGE(0);
    { const int n0 = 128; gb = gsc[n0 + tq]; gaa = gsc[SEQ + n0 + tq]; gg = gsc[2 * SEQ + n0 + tq]; gbl = gsc[n0 + 127]; gge = gsc[2 * SEQ + n0 + 127]; }
    for (int ci = 0; ci < 16; ++ci) {
        const int t0 = ci * 128;
        asm volatile("s_waitcnt vmcnt(0) lgkmcnt(0)" ::: "memory"); __builtin_amdgcn_s_barrier(); asm volatile("" ::: "memory");
        ML_LAUNDER();
#define SB() __builtin_amdgcn_sched_barrier(0)
        bf16x8 qf[4], fr[8];
#pragma unroll
        for (int ks = 0; ks < 4; ++ks) qf[ks] = *(const LAS bf16x8*)(lds + QI + off_b(16 * w + l15, 4 * ks + g));
        const float ut = pc_u[16 * w + l15];
#define LDK(buf, ks) do { _Pragma("unroll") for (int st = 0; st < 8; ++st) fr[st] = *(const LAS bf16x8*)(lds + KI + off_b(16 * st + l15, 4 * (ks) + g)); } while (0)
#define LDCB(buf, ks) do { _Pragma("unroll") for (int vt = 0; vt < 8; ++vt) fr[vt] = *(const LAS bf16x8*)(lds + CB + off_b(16 * vt + l15, 4 * (ks) + g)); } while (0)
#define LDV(buf, R0, R1) do { _Pragma("unroll") for (int vt = 0; vt < 8; ++vt) { const s16x4 lo = trrd(lds + VI + off_b((R0) + q, 2 * vt + (p >> 1)) + 8 * (p & 1)), hi = trrd(lds + VI + off_b((R1) + q, 2 * vt + (p >> 1)) + 8 * (p & 1)); \
            fr[vt] = (bf16x8){lo[0], lo[1], lo[2], lo[3], hi[0], hi[1], hi[2], hi[3]}; } } while (0)
        f32x4 sacc[8];
#pragma unroll
        for (int st = 0; st < 8; ++st) sacc[st] = (f32x4){0.f, 0.f, 0.f, 0.f};
        if (!(pf & 16))
#pragma unroll
        for (int ks = 0; ks < 4; ++ks) { LDK(0, ks); SB();
#pragma unroll
            for (int st = 0; st < 8; ++st) sacc[st] = mfma16(fr[st], qf[ks], sacc[st]);
            SB(); }
        bf16x8 smf[4];
#pragma unroll
        for (int i = 0; i < 4; ++i) { float sv[8];
#pragma unroll
            for (int hh = 0; hh < 2; ++hh) { const int st = 2 * i + hh; const f32x4 a4 = *(const LAS f32x4*)(pc_a + 16 * st + 4 * g);
#pragma unroll
                for (int r = 0; r < 4; ++r) { float v = __expf(ut + a4[r]) * sacc[st][r]; if ((16 * st + 4 * g + r) > (16 * w + l15)) v = 0.f; sv[4 * hh + r] = v; } }
            smf[i] = pack8(sv); }
        ML_LAUNDER();
        const float scit = pc_sci[16 * w + l15];
        f32x4 num[9];
#pragma unroll
        for (int vt = 0; vt < 9; ++vt) num[vt] = (f32x4){0.f, 0.f, 0.f, 0.f};
        if (!(pf & 16)) {
#pragma unroll
        for (int ks = 0; ks < 4; ++ks) { const bf16x8 c8 = *(const LAS bf16x8*)(lds + CB + off_b(128 + l15, 4 * ks + g));
            LDCB(0, ks); SB();
#pragma unroll
            for (int vt = 0; vt < 8; ++vt) num[vt] = mfma16(fr[vt], qf[ks], num[vt]);
            num[8] = mfma16(c8, qf[ks], num[8]); SB(); }
#pragma unroll
        for (int vt = 0; vt < 9; ++vt) num[vt] = num[vt] * scit;
#pragma unroll
        for (int i = 0; i < 4; ++i) { LDV(0, 32 * i + 4 * g, 32 * i + 16 + 4 * g); SB();
#pragma unroll
            for (int vt = 0; vt < 8; ++vt) num[vt] = mfma16(fr[vt], smf[i], num[vt]);
            num[8] = mfma16(onesf, smf[i], num[8]); SB(); } }
        if (!(pf & 128)) { const int t = t0 + 16 * w + l15;
          const float den = __shfl(num[8][0], l15); const float hd = __builtin_amdgcn_rcpf(fmaxf(fabsf(den), pc_emr[16 * w + l15]));
          float ss = 0.f;
#pragma unroll
          for (int vt = 0; vt < 8; ++vt) { const u32x2 ow = omr[vt];
              const float o0 = bf2f(ow.x & 0xffffu), o1 = bf2f(ow.x >> 16), o2 = bf2f(ow.y & 0xffffu), o3 = bf2f(ow.y >> 16);
              f32x4 hv = num[vt] * hd; hv[0] *= __builtin_amdgcn_rcpf(1.f + __expf(-o0)); hv[1] *= __builtin_amdgcn_rcpf(1.f + __expf(-o1)); hv[2] *= __builtin_amdgcn_rcpf(1.f + __expf(-o2)); hv[3] *= __builtin_amdgcn_rcpf(1.f + __expf(-o3));
              num[vt] = hv; ss += (hv[0] * hv[0] + hv[1] * hv[1]) + (hv[2] * hv[2] + hv[3] * hv[3]); }
          ss += __shfl_xor(ss, 16); ss += __shfl_xor(ss, 32);
          const float rs = __builtin_amdgcn_rsqf(ss * (1.f / 128.f) + RMS_EPS);
          bf16_t* op = MIX + (rowb + t) * D + 512 + h * 128 + 4 * g; const float* gp = F.p.mhnorm_g + h * 128 + 4 * g;
#pragma unroll
          for (int vt = 0; vt < 8; ++vt) { const f32x4 gg4 = *(const f32x4*)(gp + 16 * vt); const f32x4 hv = num[vt] * rs * gg4;
              u32x2 ww; ww.x = pg8::cvt_pk_bf16(hv[0], hv[1]); ww.y = pg8::cvt_pk_bf16(hv[2], hv[3]); *(u32x2*)(op + 16 * vt) = ww; } }
        asm volatile("s_waitcnt lgkmcnt(0)" ::: "memory"); __builtin_amdgcn_s_barrier(); asm volatile("" ::: "memory");
        ML_LAUNDER();
        if (ci < 15) ML_RAWLOAD(ci + 1);
        { bf16x8 kf[4];
#pragma unroll
          for (int i = 0; i < 4; ++i) { float kv[8];
#pragma unroll
              for (int t2 = 0; t2 < 2; ++t2) { const s16x4 raw = trrd(lds + KI + off_b(32 * i + 8 * g + 4 * t2 + q, 2 * w + (p >> 1)) + 8 * (p & 1)); const f32x4 w4 = *(const LAS f32x4*)(pc_ws + 32 * i + 8 * g + 4 * t2);
#pragma unroll
                  for (int e = 0; e < 4; ++e) kv[4 * t2 + e] = bf2f((unsigned)(unsigned short)raw[e]) * w4[e]; }
              kf[i] = pack8(kv); }
#pragma unroll
          for (int vt = 0; vt < 9; ++vt) accC[vt] = accC[vt] * sc;
          SB();
          if (!(pf & 32))
#pragma unroll
          for (int i = 0; i < 4; ++i) { LDV(0, 32 * i + 8 * g, 32 * i + 8 * g + 4); SB();
#pragma unroll
              for (int vt = 0; vt < 8; ++vt) accC[vt] = mfma16(kf[i], fr[vt], accC[vt]);
              accC[8] = mfma16(kf[i], onesf, accC[8]); SB(); }
#pragma unroll
          for (int vt = 0; vt < 9; ++vt) { u32x2 ww; ww.x = pg8::cvt_pk_bf16(accC[vt][0], accC[vt][1]); ww.y = pg8::cvt_pk_bf16(accC[vt][2], accC[vt][3]);
              *(LAS u32x2*)(lds + CB + off_b(16 * vt + l15, 2 * w + (g >> 1)) + 8 * (g & 1)) = ww; } }
#undef LDK
#undef LDCB
#undef LDV
#undef SB
        mcur = mnew;
        asm volatile("s_waitcnt lgkmcnt(0)" ::: "memory"); __builtin_amdgcn_s_barrier(); asm volatile("" ::: "memory");
        if (ci < 15) { ML_LAUNDER();
            mnew = gbl + fmaxf(mcur, gge); sc = __expf(gbl + mcur - mnew);
            ML_STAGE(ci + 1);
            if (ci < 14) { const int n0 = t0 + 256; gb = gsc[n0 + tq]; gaa = gsc[SEQ + n0 + tq]; gg = gsc[2 * SEQ + n0 + tq]; gbl = gsc[n0 + 127]; gge = gsc[2 * SEQ + n0 + 127]; } }
    }
#undef ML_STAGE
#undef ML_RAWLOAD
}
}

namespace rt {
constexpr int WROW = 2064;
constexpr int LOGI_OFF = 100352, HIST_OFF = 124928;
__device__ __forceinline__ void router_phase(Frame& F) {
    const Ptrs& p = F.p; LAS unsigned char* lds = F.lds + RING_OFF;
    const int tid = F.tid, lane = F.lane, w = F.wave, l15 = lane & 15, g = lane >> 4;
    const bf16_t* WR = (const bf16_t*)(p.ws + WS_WR); const bf16_t* X1B = (const bf16_t*)(p.ws + WS_X1B);
    int* list = (int*)(p.ws + WS_LIST); float* tokw = (float*)(p.ws + WS_TOKW); float* rstd_o = (float*)(p.ws + WS_RSTD);
    LAS int* hist = (LAS int*)(lds + HIST_OFF); LAS int* base = hist + 32;
    LAS float* lg = (LAS float*)(lds + LOGI_OFF + w * 3072);
    for (int i = tid; i < 48 * 128; i += 512) { const int row = i >> 7, ch = i & 127; *(LAS u32x4*)(lds + row * WROW + ch * 16) = *(const u32x4*)(WR + row * 1024 + ch * 8); }
    for (int blk = F.vcu; blk < T / 128; blk += F.G) {
        if (tid < 32) hist[tid] = 0;
        __syncthreads();
        const int row0 = blk * 128 + 16 * w;
        f32x4 acc[3]; float ss = 0.f, amax = 0.f;
#pragma unroll
        for (int ct = 0; ct < 3; ++ct) acc[ct] = (f32x4){0.f, 0.f, 0.f, 0.f};
        const bf16_t* ap = X1B + (size_t)(row0 + l15) * D + 8 * g;
#pragma unroll 4
        for (int ks = 0; ks < 32; ++ks) { const bf16x8 a = *(const bf16x8*)(ap + 32 * ks);
#pragma unroll
            for (int e = 0; e < 8; ++e) { const float v = bf2f((unsigned)(unsigned short)a[e]); ss += v * v; amax = fmaxf(amax, fabsf(v)); }
#pragma unroll
            for (int ct = 0; ct < 3; ++ct) acc[ct] = __builtin_amdgcn_mfma_f32_16x16x32_bf16(a, *(const LAS bf16x8*)(lds + (16 * ct + l15) * WROW + (32 * ks + 8 * g) * 2), acc[ct], 0, 0, 0); }
        ss += __shfl_xor(ss, 16); ss += __shfl_xor(ss, 32);
        const float rstd = 1.f / sqrtf(ss * (1.f / D) + RMS_EPS);
#if Q8_UP
        amax = fmaxf(amax, __shfl_xor(amax, 16)); amax = fmaxf(amax, __shfl_xor(amax, 32));
        { signed char* X1Q = (signed char*)(p.ws + WS_X1Q);
          for (int rr = 0; rr < 16; ++rr) { const float mx = __shfl(amax, rr); const float inv = mx > 0.f ? 127.f / mx : 0.f;
              const bf16_t* src = X1B + (size_t)(row0 + rr) * D + lane * 16; const u32x4 lo = *(const u32x4*)src, hi = *(const u32x4*)(src + 8); u32x4 o;
#pragma unroll
              for (int d = 0; d < 2; ++d) { o[d] = q8(bf2f(lo[2 * d] & 0xffffu) * inv) | (q8(bf2f(lo[2 * d] >> 16) * inv) << 8) | (q8(bf2f(lo[2 * d + 1] & 0xffffu) * inv) << 16) | (q8(bf2f(lo[2 * d + 1] >> 16) * inv) << 24);
                  o[2 + d] = q8(bf2f(hi[2 * d] & 0xffffu) * inv) | (q8(bf2f(hi[2 * d] >> 16) * inv) << 8) | (q8(bf2f(hi[2 * d + 1] & 0xffffu) * inv) << 16) | (q8(bf2f(hi[2 * d + 1] >> 16) * inv) << 24); }
              *(u32x4*)(X1Q + (size_t)(row0 + rr) * D + lane * 16) = o; }
          if (lane < 16) ((float*)(p.ws + WS_SX))[row0 + lane] = amax * (1.f / 127.f); }
#endif
#pragma unroll
        for (int ct = 0; ct < 3; ++ct)
#pragma unroll
            for (int r = 0; r < 4; ++r) lg[(4 * g + r) * 48 + 16 * ct + l15] = acc[ct][r];
        asm volatile("s_waitcnt lgkmcnt(0)" ::: "memory");
        int ea = 0, eb = 0, ra = 0, rb = 0; float w0 = 0.f, w1 = 0.f; const int tok = row0 + lane;
        if (lane < 16) {
            const LAS float* ll = lg + lane * 48;
            float gl[4];
#pragma unroll
            for (int j = 0; j < 4; ++j) gl[j] = ll[j] * rstd + p.b_grp[j];
            int gs = 0; float gm = gl[0];
#pragma unroll
            for (int j = 1; j < 4; ++j) if (gl[j] > gm) { gm = gl[j]; gs = j; }
            float gsum = 0.f;
#pragma unroll
            for (int j = 0; j < 4; ++j) gsum += __expf(gl[j] - gm);
            const float gwt = 1.f / gsum;
            float el[8];
#pragma unroll
            for (int e = 0; e < 8; ++e) el[e] = ll[4 + gs * 8 + e] * rstd + p.b_er[gs * 8 + e];
            int i0 = 0; float v0 = el[0];
#pragma unroll
            for (int e = 1; e < 8; ++e) if (el[e] > v0) { v0 = el[e]; i0 = e; }
            int i1 = 0; float v1 = -INFINITY;
#pragma unroll
            for (int e = 0; e < 8; ++e) if (e != i0 && el[e] > v1) { v1 = el[e]; i1 = e; }
            const float e1 = __expf(v1 - v0); w0 = gwt / (1.f + e1); w1 = gwt * e1 / (1.f + e1);
            ea = gs * 8 + i0; eb = gs * 8 + i1;
            ra = __hip_atomic_fetch_add(hist + ea, 1, __ATOMIC_RELAXED, __HIP_MEMORY_SCOPE_WORKGROUP);
            rb = __hip_atomic_fetch_add(hist + eb, 1, __ATOMIC_RELAXED, __HIP_MEMORY_SCOPE_WORKGROUP);
            rstd_o[tok] = rstd;
        }
        __syncthreads();
        if (tid < 32) base[tid] = (int)__hip_atomic_fetch_add(F.ctl + CW_CNT + 64 * tid, (unsigned)hist[tid], __ATOMIC_RELAXED, __HIP_MEMORY_SCOPE_AGENT);
        __syncthreads();
        if (lane < 16) {
            list[(size_t)ea * LIST_CAP + base[ea] + ra] = tok * 2; list[(size_t)eb * LIST_CAP + base[eb] + rb] = tok * 2 + 1;
            tokw[tok * 2] = w0; tokw[tok * 2 + 1] = w1; }
        __syncthreads();
    }
}
}
#ifndef PROBE_FLAGS
#define PROBE_FLAGS 1
#endif
#ifndef PROBE_REP
#define PROBE_REP -1
#endif
struct Args { Ptrs p; int ph_lo, ph_hi, rep, li; };
constexpr int N_PHASES = 8;
__global__ void __launch_bounds__(NWAVES * 64, 2) mk_fwd(Args args) {
    extern __shared__ __attribute__((aligned(16))) unsigned char lds_raw[];
    Frame F;
    F.lds = (LAS unsigned char*)lds_raw; F.p = args.p;
    F.tid = threadIdx.x; F.lane = F.tid & 63; F.wave = __builtin_amdgcn_readfirstlane(F.tid >> 6);
    F.G = gridDim.x; { const int bx = blockIdx.x; F.vcu = (F.G % 8 == 0) ? (bx % 8) * (F.G / 8) + bx / 8 : bx; }
    F.ctl = (unsigned*)(args.p.ws + WS_CTL);
    for (int u = F.tid; u < (LDS_BYTES - LDSCTL_OFF) / 4; u += NWAVES * 64) ((LAS unsigned*)(F.lds + LDSCTL_OFF))[u] = 0u;
    __syncthreads();
    XcdBarrier bar = xcd_barrier_post(F.ctl + CW_BAR + args.li * XCD_BAR_WORDS, (volatile LAS unsigned*)(F.lds + MISC_OFF) + 8);
    const int lo = args.ph_lo, hi = args.ph_hi;
    unsigned char* ws = args.p.ws;
#define IN(k) (lo <= (k) && (k) < hi)
#define SEAM(k) do { if (IN(k) && IN((k) + 1)) xcd_barrier(bar); } while (0)
#define PH1 { pg8::StaticOrder S; S.init(ws + WS_HB, ws + WS_WIN, T, NPROJ, Q8_PROJ ? D : 2 * D, F.G, (int)blockIdx.x); const float* cs = (const float*)(ws + WS_ROPE); \
        pg8::EpiProj<Q8_PROJ> E{(bf16_t*)(ws + WS_PROJ), cs, cs + 2048 * 32, (const float*)(ws + WS_SA), (const float*)(ws + WS_SBIN)}; \
        pg8::gemm_phase<pg8::EpiProj<Q8_PROJ>, pg8::StaticOrder, true, false, Q8_PROJ>(F.lds + RING_OFF, Q8_PROJ ? D : 2 * D, S, E); }
#define PH2(rep) { if (blockIdx.x < BATCH * 4 && !((rep) & 2)) { ml::mlstm_unit(F, (int)blockIdx.x, (rep) >> 3 << 3); __syncthreads(); } if (!((rep) & 4)) att::attn_phase(F, CW_QATT + 64 * ((rep) & 1)); }
#define PH3 { pg8::StaticOrder S; S.init(ws + WS_MIX, ws + WS_WOUT, T, D, 2 * D, F.G, (int)blockIdx.x); pg8::EpiOut E{F.p.x, (bf16_t*)(ws + WS_X1B)}; \
        pg8::gemm_phase<pg8::EpiOut, pg8::StaticOrder, true, false>(F.lds + RING_OFF, 2 * D, S, E); }
#define PH5 { moe_tables(F); \
        pg8::MoeOrder S{(const LAS int*)(F.lds + TAB_OFF), F.G, F.vcu, (const char*)(ws + (Q8_UP ? WS_X1Q : WS_X1B)), (const char*)(ws + WS_W13), (size_t)1024 * 1024 * (Q8_UP ? 1 : 2), (size_t)256 * 1024 * (Q8_UP ? 1 : 2), 0, true, (const int*)(ws + WS_LIST), Q8_UP ? D : 2 * D}; \
        pg8::EpiUp<Q8_UP> E{(bf16_t*)(ws + WS_HD), (const float*)(ws + WS_RSTD), (const int*)(ws + WS_LIST), (const float*)(ws + WS_SX), (const float*)(ws + WS_SB13)}; \
        pg8::gemm_phase<pg8::EpiUp<Q8_UP>, pg8::MoeOrder, true, true, Q8_UP>(F.lds + RING_OFF, Q8_UP ? D : 2 * D, S, E); }
#define PH6 { moe_tables(F); \
        pg8::MoeOrder S{(const LAS int*)(F.lds + TAB_OFF), F.G, F.vcu, (const char*)(ws + WS_HD), (const char*)(ws + WS_W2), (size_t)1024 * 512 * 2, (size_t)256 * 512 * 2, (size_t)DE * 2, false, (const int*)(ws + WS_LIST), 2 * DE}; \
        pg8::EpiDown E{(bf16_t*)(ws + WS_Y), (const float*)(ws + WS_TOKW), (const int*)(ws + WS_LIST)}; pg8::gemm_phase<pg8::EpiDown, pg8::MoeOrder, true, false>(F.lds + RING_OFF, 2 * DE, S, E); }

    if (IN(0)) { p0_pass_a(F); if (Q8_PROJ || Q8_UP) { xcd_barrier(bar); p0_pass_b(F); } }
    SEAM(0);
    if (IN(1)) PH1;
    SEAM(1);
    if (IN(2)) PH2(args.rep);
    SEAM(2);
    if (IN(3)) PH3;
    SEAM(3);
    if (IN(4)) rt::router_phase(F);
    SEAM(4);
    if (IN(5)) PH5;
    SEAM(5);
    if (IN(6)) PH6;
    SEAM(6);
    if (IN(7)) final_body(F);
#undef IN
#undef SEAM
}

extern "C" void kernel_launch(void* const* d_in, const int* in_sizes, int n_in, void* d_out, int out_size, void* d_ws, size_t ws_size, hipStream_t stream) {
    static int grid = 0;
    if (grid == 0) {
        if (n_in != 19 || out_size != T * D || ws_size < WS_END) { fprintf(stderr, "kernel_launch: unexpected shapes (n_in %d out %d ws %zu)\n", n_in, out_size, ws_size); grid = -1; return; }
        int dev = 0, cus = 0, per_cu = 0;
        if (hipGetDevice(&dev) != hipSuccess || hipDeviceGetAttribute(&cus, hipDeviceAttributeMultiprocessorCount, dev) != hipSuccess) { grid = -1; return; }
        if (hipFuncSetAttribute((const void*)mk_fwd, hipFuncAttributeMaxDynamicSharedMemorySize, LDS_BYTES) != hipSuccess) { fprintf(stderr, "kernel_launch: hipFuncSetAttribute failed\n"); grid = -1; return; }
        if (hipOccupancyMaxActiveBlocksPerMultiprocessor(&per_cu, (const void*)mk_fwd, NWAVES * 64, LDS_BYTES) != hipSuccess || per_cu < 1) { fprintf(stderr, "kernel_launch: occupancy query says %d\n", per_cu); }
        (void)hipGetLastError();
        grid = cus;
    }
    if (grid < 0) return;
    Args a{};
    Ptrs& p = a.p;
    p.x = (const float*)d_in[0]; p.w_in = (const float*)d_in[1]; p.conv_w = (const float*)d_in[2]; p.conv_b = (const float*)d_in[3]; p.gate_b = (const float*)d_in[4];
    p.lam_qk = (const float*)d_in[5]; p.subln_g = (const float*)d_in[6]; p.mhnorm_g = (const float*)d_in[7]; p.w_out = (const float*)d_in[8]; p.g_mix = (const float*)d_in[9];
    p.g_ffn = (const float*)d_in[10]; p.w_grp = (const float*)d_in[11]; p.b_grp = (const float*)d_in[12]; p.w_er = (const float*)d_in[13]; p.b_er = (const float*)d_in[14];
    p.w1 = (const float*)d_in[15]; p.w3 = (const float*)d_in[16]; p.w2 = (const float*)d_in[17]; p.g_final = (const float*)d_in[18];
    p.out = (float*)d_out; p.ws = (unsigned char*)d_ws;
    if (hipMemsetAsync((char*)d_ws + WS_CTL, 0, CTL_ZERO_BYTES, stream) != hipSuccess) return;
#if PROBE_REP >= 0
    const int cuts[4] = {0, PROBE_REP + 1, PROBE_REP + 1, N_PHASES};
    for (int li = 0; li < 3; ++li) { a.ph_lo = (li == 1) ? PROBE_REP : cuts[li]; a.ph_hi = cuts[li + 1]; a.rep = (li == 1) ? PROBE_FLAGS : 0; a.li = li;
        hipLaunchKernelGGL(mk_fwd, dim3(grid), dim3(NWAVES * 64), LDS_BYTES, stream, a); }
#else
    a.ph_lo = 0; a.ph_hi = N_PHASES; a.rep = 0; a.li = 0;
    hipLaunchKernelGGL(mk_fwd, dim3(grid), dim3(NWAVES * 64), LDS_BYTES, stream, a);
#endif
}
```
